# Optimizing an MI355X kernel written in HIP

```python
import jax, jax.numpy as jnp
from jax import lax
import numpy as np

D_MODEL = 2048
BATCH = 4
SEQ = 2048
DEPTH = 1

D_MIX = D_MODEL
CHUNK = 128
SGU_GROUPS = 8
SGU_DIM = (D_MIX // 2) // SGU_GROUPS
SGU_WIDTH = SGU_GROUPS * SGU_DIM
HEAD_DIM = 64
N_Q_HEADS = (D_MIX // 2) // HEAD_DIM
N_KV_HEADS = 2
WINDOW = 128
ATTN_WIDTH = N_Q_HEADS * HEAD_DIM
KV_WIDTH = N_KV_HEADS * HEAD_DIM
IN_WIDTH = 2 * SGU_WIDTH + ATTN_WIDTH + 2 * KV_WIDTH
PEER_HEADS = 8
N_KEYS = 128
N_EXPERTS = N_KEYS * N_KEYS
PEER_TOPK = 16
D_QUERY = 256
EXPERT_BLOCK = 128
EPS = 1e-6

kernel_name = "hybrid_gmlp_swa_sink_peer_block"


def rmsnorm(x, g):
    xf = x.astype(jnp.float32)
    y = xf * lax.rsqrt(jnp.mean(xf * xf, axis=-1, keepdims=True) + EPS)
    return (y * g.astype(jnp.float32)).astype(x.dtype)


def chunked_spatial_gating(u, v, ln_g, ln_b, w_s, b_s):
    B, S, _ = u.shape
    nc = S // CHUNK
    u = u.reshape(B, nc, CHUNK, SGU_GROUPS, SGU_DIM)
    v = v.reshape(B, nc, CHUNK, SGU_GROUPS, SGU_DIM)
    vf = v.astype(jnp.float32)
    mu = jnp.mean(vf, axis=-1, keepdims=True)
    var = jnp.mean(jnp.square(vf - mu), axis=-1, keepdims=True)
    vn = ((vf - mu) * lax.rsqrt(var + EPS) * ln_g.astype(jnp.float32) + ln_b.astype(jnp.float32)).astype(u.dtype)
    causal = jnp.tril(jnp.ones((CHUNK, CHUNK), dtype=bool))
    w = jnp.where(causal[None], w_s, jnp.zeros_like(w_s))
    s = jnp.einsum('gts,bcsgd->bctgd', w, vn) + b_s.T[None, None, :, :, None]
    return (u * s).reshape(B, S, SGU_WIDTH)


def sliding_window_attention(q, k, v, sinks):
    B, S = q.shape[0], q.shape[1]
    nb = S // WINDOW
    G = N_Q_HEADS // N_KV_HEADS
    qb = q.reshape(B, nb, WINDOW, N_KV_HEADS, G, HEAD_DIM)
    kb = k.reshape(B, nb, WINDOW, N_KV_HEADS, HEAD_DIM)
    vb = v.reshape(B, nb, WINDOW, N_KV_HEADS, HEAD_DIM)
    pad = ((0, 0), (1, 0), (0, 0), (0, 0), (0, 0))
    kk = jnp.concatenate([jnp.pad(kb[:, :-1], pad), kb], axis=2)
    vv = jnp.concatenate([jnp.pad(vb[:, :-1], pad), vb], axis=2)
    scores = jnp.einsum('bnqhgd,bnkhd->bnhgqk', qb, kk).astype(jnp.float32) * (HEAD_DIM ** -0.5)
    i = jnp.arange(WINDOW)[:, None]
    j = jnp.arange(2 * WINDOW)[None, :]
    band = (j >= i + 1) & (j <= i + WINDOW)
    blk = jnp.arange(nb)[:, None, None]
    mask = band[None] & ((blk > 0) | (j >= WINDOW)[None])
    scores = jnp.where(mask[None, :, None, None], scores, -jnp.inf)
    sink = sinks.astype(jnp.float32).reshape(N_KV_HEADS, G)[None, None, :, :, None, None]
    m = jnp.maximum(jnp.max(scores, axis=-1, keepdims=True), sink)
    p = jnp.exp(scores - m)
    denom = jnp.sum(p, axis=-1, keepdims=True) + jnp.exp(sink - m)
    probs = (p / denom).astype(v.dtype)
    out = jnp.einsum('bnhgqk,bnkhd->bnqhgd', probs, vv)
    return out.reshape(B, S, ATTN_WIDTH)


def peer(h, w_query, sub_keys, expert_down, expert_up):
    B, S, D = h.shape
    T = B * S
    xf = h.reshape(T, D)
    q = (xf @ w_query).reshape(T, PEER_HEADS, 2, D_QUERY // 2)
    s1 = jnp.einsum('thd,kd->thk', q[:, :, 0], sub_keys[0]).astype(jnp.float32)
    s2 = jnp.einsum('thd,kd->thk', q[:, :, 1], sub_keys[1]).astype(jnp.float32)
    v1, i1 = lax.top_k(s1, PEER_TOPK)
    v2, i2 = lax.top_k(s2, PEER_TOPK)
    cand = (v1[..., :, None] + v2[..., None, :]).reshape(T, PEER_HEADS, PEER_TOPK * PEER_TOPK)
    top_v, flat = lax.top_k(cand, PEER_TOPK)
    e1 = jnp.take_along_axis(i1, flat // PEER_TOPK, axis=-1)
    e2 = jnp.take_along_axis(i2, flat % PEER_TOPK, axis=-1)
    experts = e1 * N_KEYS + e2
    gates = jax.nn.softmax(top_v, axis=-1).astype(h.dtype)
    nblk = T // EXPERT_BLOCK

    def block(args):
        xc, ec, gc = args
        u = jnp.take(expert_down, ec, axis=0)
        a = jax.nn.gelu(jnp.einsum('cd,chkd->chk', xc, u), approximate=False)
        vt = jnp.take(expert_up, ec, axis=0)
        return jnp.einsum('chk,chkd->cd', gc * a, vt)

    out = lax.map(block, (xf.reshape(nblk, EXPERT_BLOCK, D),
                          experts.reshape(nblk, EXPERT_BLOCK, PEER_HEADS, PEER_TOPK),
                          gates.reshape(nblk, EXPERT_BLOCK, PEER_HEADS, PEER_TOPK)))
    return out.reshape(B, S, D)


def setup_inputs(seed: int = 0) -> dict:
    key = jax.random.key(seed)
    ks = jax.random.split(key, 16)
    L = DEPTH

    def nrm(k, shape, scale):
        return jax.random.normal(k, shape, jnp.float32) * scale

    return {
        "x": nrm(ks[0], (BATCH, SEQ, D_MODEL), 1.0),
        "norm1_g": 1.0 + nrm(ks[1], (L, D_MODEL), 0.01),
        "w_in": nrm(ks[2], (L, D_MODEL, IN_WIDTH), D_MODEL ** -0.5),
        "sgu_ln_g": 1.0 + nrm(ks[3], (L, SGU_GROUPS, SGU_DIM), 0.01),
        "sgu_ln_b": nrm(ks[4], (L, SGU_GROUPS, SGU_DIM), 0.01),
        "w_spatial": nrm(ks[5], (L, SGU_GROUPS, CHUNK, CHUNK), CHUNK ** -0.5),
        "b_spatial": 1.0 + nrm(ks[6], (L, SGU_GROUPS, CHUNK), 0.01),
        "attn_sinks": nrm(ks[7], (L, N_Q_HEADS), 0.5),
        "w_out": nrm(ks[8], (L, D_MIX, D_MODEL), D_MIX ** -0.5),
        "norm2_g": 1.0 + nrm(ks[9], (L, D_MODEL), 0.01),
        "w_query": nrm(ks[10], (L, D_MODEL, PEER_HEADS * D_QUERY), D_MODEL ** -0.5),
        "sub_keys": nrm(ks[11], (L, 2, N_KEYS, D_QUERY // 2), (D_QUERY // 2) ** -0.5),
        "expert_down": nrm(ks[12], (L, N_EXPERTS, D_MODEL), D_MODEL ** -0.5),
        "expert_up": nrm(ks[13], (L, N_EXPERTS, D_MODEL), PEER_HEADS ** -0.5),
        "norm_f_g": 1.0 + nrm(ks[14], (D_MODEL,), 0.01),
    }


def reference(x, norm1_g, w_in, sgu_ln_g, sgu_ln_b, w_spatial, b_spatial, attn_sinks,
              w_out, norm2_g, w_query, sub_keys, expert_down, expert_up, norm_f_g):
    B, S, _ = x.shape
    splits = [SGU_WIDTH, 2 * SGU_WIDTH, 2 * SGU_WIDTH + ATTN_WIDTH,
              2 * SGU_WIDTH + ATTN_WIDTH + KV_WIDTH]
    for l in range(DEPTH):
        h = rmsnorm(x, norm1_g[l])
        z = h @ w_in[l]
        zu, zv, zq, zk, zvv = jnp.split(z, splits, axis=-1)
        a_out = chunked_spatial_gating(jax.nn.gelu(zu, approximate=False),
                                       jax.nn.gelu(zv, approximate=False),
                                       sgu_ln_g[l], sgu_ln_b[l], w_spatial[l], b_spatial[l])
        b_out = sliding_window_attention(zq.reshape(B, S, N_Q_HEADS, HEAD_DIM),
                                         zk.reshape(B, S, N_KV_HEADS, HEAD_DIM),
                                         zvv.reshape(B, S, N_KV_HEADS, HEAD_DIM),
                                         attn_sinks[l])
        x = x + jnp.concatenate([a_out, b_out], axis=-1) @ w_out[l]
        h2 = rmsnorm(x, norm2_g[l])
        x = x + peer(h2, w_query[l], sub_keys[l], expert_down[l], expert_up[l])
    return rmsnorm(x, norm_f_g)
```

```cpp
#include <hip/hip_runtime.h>
#include <cstdio>
#include <cstdint>
#include <math.h>
namespace pg8 {
#define PG8_LAS __attribute__((address_space(3)))
typedef unsigned short bf16_t;
typedef short bf16x8 __attribute__((ext_vector_type(8)));
typedef float f32x4 __attribute__((ext_vector_type(4)));
typedef unsigned u32x4 __attribute__((ext_vector_type(4)));
constexpr int BM = 256, BK = 64, HALF = 128, HTB = HALF * BK * 2  , STAGE_BYTES = 8 * HTB, NXCD = 8, WGM = 8;

__host__ __device__ __forceinline__ int lds_byte(int r, int c) { const int st = (r >> 4) * 2 + (c >> 5), rr = r & 15, cc = c & 31, ob = rr * 64 + cc * 2; return st * 1024 + (ob ^ (((ob >> 9) & 1) << 5)); }
__host__ __device__ __forceinline__ void stage_rc(int b, int& R, int& C) { const int st = b / 1024, sb = b % 1024, swz = sb ^ (((sb >> 9) & 1) << 5); R = (st >> 1) * 16 + swz / 64; C = (st & 1) * 32 + (swz % 64) / 2; }
__host__ __device__ __forceinline__ int perm32(int rho) { const int n = rho >> 4, i = rho & 15; return 8 * (i >> 2) + 4 * n + (i & 3); }

struct Unit { int pm, pn; };
struct Gemm { const bf16_t* A; const bf16_t* Bt; int M, N, K; };

struct StaticOrder {
    int nM, nN, nwg, G, c;
    __host__ __device__ void init(int M, int N, int G_, int c_) { nM = M / BM; nN = N / BM; nwg = nM * nN; G = G_; c = c_; }
    __host__ __device__ bool next(int i, Unit& u) const {
        const long L = (long)i * G + c; if (L >= nwg) return false;
        int wgid = (int)L; { const int q = nwg / NXCD, r = nwg % NXCD, xcd = wgid % NXCD, off = wgid / NXCD; wgid = (xcd < r ? xcd * (q + 1) : r * (q + 1) + (xcd - r) * q) + off; }
        const int nig = WGM * nN, gid = wgid / nig, fm = gid * WGM, gsz = (nM - fm) < WGM ? (nM - fm) : WGM;
        u.pm = fm + ((wgid % nig) % gsz); u.pn = (wgid % nig) / gsz; return true;
    }
    __device__ __forceinline__ void a_ready(const Unit&) const {}
    __device__ __forceinline__ void done(const Unit&) const {}
};

__device__ __forceinline__ unsigned cvt_pk_bf16(float lo, float hi) { unsigned r; asm volatile("v_cvt_pk_bf16_f32 %0, %1, %2" : "=v"(r) : "v"(lo), "v"(hi)); return r; }
typedef float f32x2 __attribute__((ext_vector_type(2)));
__device__ __forceinline__ f32x2 gelu_pk(f32x2 v) {
    const f32x2 av = __builtin_elementwise_abs(v), d = av * 0.2316418882f + 1.0f;
    f32x2 t; t.x = __builtin_amdgcn_rcpf(d.x); t.y = __builtin_amdgcn_rcpf(d.y);
    f32x2 q = t * 0.5307027145f + (-0.7265760135f); q = q * t + 0.7107068705f; q = q * t + (-0.142248368f); q = q * t + 0.127414796f; q = q * t;
    const f32x2 s = (v * v) * (-0.72134752044f);
    f32x2 e; e.x = __builtin_amdgcn_exp2f(s.x); e.y = __builtin_amdgcn_exp2f(s.y);
    const f32x2 m = v * (q * e), r = v - m;
    f32x2 o; o.x = v.x < 0.f ? m.x : r.x; o.y = v.y < 0.f ? m.y : r.y; return o;
}
struct EpiZ {
    static constexpr bool PERM = true, AFTER_DRAIN = false;
    bf16_t* O; int ldc; int gelu_tiles;
    __device__ __forceinline__ void operator()(const f32x4 (&acc)[2][2][4][2], const Unit& u, int wr, int wc, int fr, int fq) const {
        const int row0 = u.pm * BM + wr * 64 + fr, col0 = u.pn * BM + wc * 32 + 8 * fq;
        const bool act = u.pn < gelu_tiles;
#pragma unroll
        for (int ai = 0; ai < 2; ++ai)
#pragma unroll
            for (int m = 0; m < 4; ++m) { bf16_t* rowp = O + (size_t)(row0 + ai * HALF + m * 16) * ldc + col0;
#pragma unroll
                for (int bj = 0; bj < 2; ++bj) { f32x4 v0 = acc[ai][bj][m][0], v1 = acc[ai][bj][m][1];
                    if (act) { f32x2 a = gelu_pk((f32x2){v0[0], v0[1]}), b = gelu_pk((f32x2){v0[2], v0[3]}), c = gelu_pk((f32x2){v1[0], v1[1]}), d = gelu_pk((f32x2){v1[2], v1[3]});
                        v0 = (f32x4){a.x, a.y, b.x, b.y}; v1 = (f32x4){c.x, c.y, d.x, d.y}; }
                    u32x4 w; w.x = cvt_pk_bf16(v0[0], v0[1]); w.y = cvt_pk_bf16(v0[2], v0[3]); w.z = cvt_pk_bf16(v1[0], v1[1]); w.w = cvt_pk_bf16(v1[2], v1[3]);
                    *(u32x4*)(rowp + bj * HALF) = w; } }
    }
};
template <bool RES> struct EpiF32 {
    static constexpr bool PERM = false, AFTER_DRAIN = false;
    const float* base; float* C; int ldc;
    __device__ __forceinline__ void operator()(const f32x4 (&acc)[2][2][4][2], const Unit& u, int wr, int wc, int fr, int fq) const {
        const int row0 = u.pm * BM + wr * 64 + fr, col0 = u.pn * BM + wc * 32 + 4 * fq;
#pragma unroll
        for (int ai = 0; ai < 2; ++ai)
#pragma unroll
            for (int m = 0; m < 4; ++m) { const size_t off = (size_t)(row0 + ai * HALF + m * 16) * ldc + col0;
#pragma unroll
                for (int bj = 0; bj < 2; ++bj)
#pragma unroll
                    for (int n = 0; n < 2; ++n) { const size_t o = off + bj * HALF + n * 16; f32x4 v = acc[ai][bj][m][n];
                        if (RES) v = v + *(const f32x4*)(base + o);
                        *(f32x4*)(C + o) = v; } }
    }
};
struct EpiX1 {
    static constexpr bool PERM = false, AFTER_DRAIN = false;
    const float* base; bf16_t* X1; bf16_t* Hg; const float* g; float* rowss; int ldc;
    __device__ __forceinline__ void operator()(const f32x4 (&acc)[2][2][4][2], const Unit& u, int wr, int wc, int fr, int fq) const {
        const int row0 = u.pm * BM + wr * 64 + fr, col0 = u.pn * BM + wc * 32 + 4 * fq;
        f32x4 gv[2][2];
#pragma unroll
        for (int bj = 0; bj < 2; ++bj)
#pragma unroll
            for (int n = 0; n < 2; ++n) gv[bj][n] = *(const f32x4*)(g + col0 + bj * HALF + n * 16);
#pragma unroll
        for (int ai = 0; ai < 2; ++ai)
#pragma unroll
            for (int m = 0; m < 4; ++m) { const int row = row0 + ai * HALF + m * 16; const size_t off = (size_t)row * ldc + col0; float ss = 0.f;
#pragma unroll
                for (int bj = 0; bj < 2; ++bj)
#pragma unroll
                    for (int n = 0; n < 2; ++n) { const size_t o = off + bj * HALF + n * 16; const f32x4 v = acc[ai][bj][m][n] + *(const f32x4*)(base + o);
                        ss += (v[0] * v[0] + v[1] * v[1]) + (v[2] * v[2] + v[3] * v[3]);
                        typedef __bf16 bf2 __attribute__((ext_vector_type(2)));
                        typedef unsigned u2 __attribute__((ext_vector_type(2)));
                        { f32x2 lo = {v[0], v[1]}, hi = {v[2], v[3]}; u2 pk; pk.x = __builtin_bit_cast(unsigned, __builtin_convertvector(lo, bf2)); pk.y = __builtin_bit_cast(unsigned, __builtin_convertvector(hi, bf2)); *(u2*)(X1 + o) = pk; }
                        const f32x4 w = v * gv[bj][n]; f32x2 lo = {w[0], w[1]}, hi = {w[2], w[3]};
                        u2 pk; pk.x = __builtin_bit_cast(unsigned, __builtin_convertvector(lo, bf2)); pk.y = __builtin_bit_cast(unsigned, __builtin_convertvector(hi, bf2));
                        *(u2*)(Hg + o) = pk; }
                ss += __shfl_xor(ss, 16); ss += __shfl_xor(ss, 32);
                if (fq == 0) atomicAdd(rowss + row, ss); }
    }
};
struct EpiRowScale {
    static constexpr bool PERM = false, AFTER_DRAIN = false;
    float* C; const float* rowss; int ldc; float inv_n, eps;
    __device__ __forceinline__ void operator()(const f32x4 (&acc)[2][2][4][2], const Unit& u, int wr, int wc, int fr, int fq) const {
        const int row0 = u.pm * BM + wr * 64 + fr, col0 = u.pn * BM + wc * 32 + 4 * fq;
#pragma unroll
        for (int ai = 0; ai < 2; ++ai)
#pragma unroll
            for (int m = 0; m < 4; ++m) { const int row = row0 + ai * HALF + m * 16; const size_t off = (size_t)row * ldc + col0;
                const float r = __builtin_amdgcn_rsqf(__hip_atomic_load(rowss + row, __ATOMIC_RELAXED, __HIP_MEMORY_SCOPE_AGENT) * inv_n + eps);
#pragma unroll
                for (int bj = 0; bj < 2; ++bj)
#pragma unroll
                    for (int n = 0; n < 2; ++n) *(f32x4*)(C + off + bj * HALF + n * 16) = acc[ai][bj][m][n] * r; }
    }
};
template <class Epi, class Sched, bool ALIGN_EPI = false, bool SP2 = false>
__device__ __forceinline__ void gemm_phase(PG8_LAS unsigned char* lds, const Gemm g, const Sched& S, const Epi& E) {
    const int tid = threadIdx.x, wid = __builtin_amdgcn_readfirstlane(tid >> 6), lane = tid & 63, wr = wid >> 2, wc = wid & 3, fr = lane & 15, fq = lane >> 4;
    const int K = g.K, nt = K / BK;
    unsigned voffA[2], voffB[2];
#pragma unroll
    for (int i = 0; i < 2; ++i) { int R, C; stage_rc(tid * 16 + i * 8192, R, C); const int Rb = Epi::PERM ? ((R & ~31) + perm32(R & 31)) : R;
        voffA[i] = (unsigned)(R * K + C) * 2u; voffB[i] = (unsigned)(Rb * K + C) * 2u; }
    const size_t kstep = (size_t)(BK * 2);
    const size_t hstep = (size_t)HALF * K * 2;
    const size_t tstep = 2 * hstep;
    const unsigned ldsw = (unsigned)wid * 1024u;
    const int aoff = lds_byte(wr * 64 + fr, fq * 8), boff = lds_byte(wc * 32 + fr, fq * 8);
#define PG8_SA(b, h) (((b) * 2 + (h)) * HTB)
#define PG8_SB(b, h) ((4 + (b) * 2 + (h)) * HTB)
#define PG8_STAGE(bufoff, gbase, voff) do { _Pragma("unroll") for (int _i = 0; _i < 2; ++_i) \
        __builtin_amdgcn_global_load_lds((const unsigned*)((const char*)(gbase) + (voff)[_i]), (PG8_LAS unsigned*)(lds + (bufoff) + ldsw + _i * 8192), 16, 0, 0); } while (0)
#define PG8_LDA(dst, b, h) do { _Pragma("unroll") for (int m = 0; m < 4; ++m) _Pragma("unroll") for (int k = 0; k < 2; ++k) dst[m][k] = *(const PG8_LAS bf16x8*)(lds + PG8_SA(b, h) + aoff + m * 2048 + k * 1024); } while (0)
#define PG8_LDB(dst, b, h) do { _Pragma("unroll") for (int n = 0; n < 2; ++n) _Pragma("unroll") for (int k = 0; k < 2; ++k) dst[n][k] = *(const PG8_LAS bf16x8*)(lds + PG8_SB(b, h) + boff + n * 2048 + k * 1024); } while (0)
#define PG8_MMA(ai, bj, At, Bt) do { __builtin_amdgcn_s_setprio(1); _Pragma("unroll") for (int m = 0; m < 4; ++m) _Pragma("unroll") for (int n = 0; n < 2; ++n) _Pragma("unroll") for (int k = 0; k < 2; ++k) \
        acc[ai][bj][m][n] = __builtin_amdgcn_mfma_f32_16x16x32_bf16(Bt[n][k], At[m][k], acc[ai][bj][m][n], 0, 0, 0); __builtin_amdgcn_s_setprio(0); } while (0)
#define PG8_WAIT_V(n) asm volatile("s_waitcnt vmcnt(" #n ")" ::: "memory")
#define PG8_WAIT_L(n) asm volatile("s_waitcnt lgkmcnt(" #n ")" ::: "memory")
#define PG8_BAR __builtin_amdgcn_s_barrier()
#define PG8_SCHED __builtin_amdgcn_sched_barrier(0)
    Unit cur, nxt; int ui = 0;
    if (!S.next(0, cur)) return;
    f32x4 acc[2][2][4][2];
#pragma unroll
    for (int a = 0; a < 2; ++a)
#pragma unroll
        for (int b = 0; b < 2; ++b)
#pragma unroll
            for (int m = 0; m < 4; ++m)
#pragma unroll
                for (int n = 0; n < 2; ++n) acc[a][b][m][n] = (f32x4){0.f, 0.f, 0.f, 0.f};
    bf16x8 At[4][2], B0[2][2], B1[2][2];
    const char* cA = (const char*)g.A + (size_t)cur.pm * tstep; const char* cB = (const char*)g.Bt + (size_t)cur.pn * tstep;
    S.a_ready(cur);
    if constexpr (SP2) {
        PG8_STAGE(PG8_SB(0, 0), cB, voffB); PG8_STAGE(PG8_SB(0, 1), cB + hstep, voffB); PG8_STAGE(PG8_SA(0, 0), cA, voffA); PG8_STAGE(PG8_SA(0, 1), cA + hstep, voffA);
        if (wr == 1) PG8_BAR;
        PG8_WAIT_V(2); PG8_BAR;
        PG8_STAGE(PG8_SB(1, 0), cB + kstep, voffB); PG8_STAGE(PG8_SA(1, 0), cA + kstep, voffA); PG8_STAGE(PG8_SB(1, 1), cB + hstep + kstep, voffB);
        PG8_WAIT_V(6); PG8_BAR;
    } else {
        PG8_STAGE(PG8_SB(0, 0), cB, voffB); PG8_STAGE(PG8_SA(0, 0), cA, voffA); PG8_STAGE(PG8_SB(0, 1), cB + hstep, voffB); PG8_STAGE(PG8_SA(0, 1), cA + hstep, voffA);
        if (wr == 1) PG8_BAR;
        PG8_WAIT_V(4); PG8_BAR;
        PG8_STAGE(PG8_SB(1, 0), cB + kstep, voffB); PG8_STAGE(PG8_SA(1, 0), cA + kstep, voffA); PG8_STAGE(PG8_SB(1, 1), cB + hstep + kstep, voffB);
        PG8_WAIT_V(6); PG8_BAR;
    }
    for (;;) {
        const bool has_next = S.next(ui + 1, nxt);
        const char* nA = has_next ? (const char*)g.A + (size_t)nxt.pm * tstep : cA; const char* nB = has_next ? (const char*)g.Bt + (size_t)nxt.pn * tstep : cB;
        for (int t = 0; t < nt; t += 2) {
            const bool last = (t == nt - 2);
            const char* a1 = cA + (size_t)(t + 1) * kstep;
            const char* a2 = last ? nA : cA + (size_t)(t + 2) * kstep; const char* b2 = last ? nB : cB + (size_t)(t + 2) * kstep;
            const char* a3 = a2 + kstep; const char* b3 = b2 + kstep;
            if (last && has_next) S.a_ready(nxt);
            if constexpr (SP2) {
            PG8_LDB(B0, 0, 0); PG8_LDB(B1, 0, 1); PG8_SCHED; PG8_LDA(At, 0, 0); PG8_STAGE(PG8_SA(1, 1), a1 + hstep, voffA);
            PG8_WAIT_V(8); PG8_WAIT_L(0); PG8_BAR; PG8_MMA(0, 0, At, B0); PG8_MMA(0, 1, At, B1); PG8_BAR; PG8_SCHED;
            PG8_LDA(At, 0, 1); PG8_STAGE(PG8_SB(0, 0), b2, voffB); PG8_STAGE(PG8_SB(0, 1), b2 + hstep, voffB); PG8_STAGE(PG8_SA(0, 0), a2, voffA);
            PG8_WAIT_V(8); PG8_WAIT_L(0); PG8_BAR; PG8_MMA(1, 0, At, B0); PG8_MMA(1, 1, At, B1); PG8_BAR; PG8_SCHED;
            PG8_LDB(B0, 1, 0); PG8_LDB(B1, 1, 1); PG8_SCHED; PG8_LDA(At, 1, 0); PG8_STAGE(PG8_SA(0, 1), a2 + hstep, voffA);
            PG8_WAIT_V(8); PG8_WAIT_L(0); PG8_BAR; PG8_MMA(0, 0, At, B0); PG8_MMA(0, 1, At, B1); PG8_BAR; PG8_SCHED;
            PG8_LDA(At, 1, 1); PG8_STAGE(PG8_SB(1, 0), b3, voffB); PG8_STAGE(PG8_SB(1, 1), b3 + hstep, voffB); PG8_STAGE(PG8_SA(1, 0), a3, voffA);
            PG8_WAIT_V(8); PG8_WAIT_L(0); PG8_BAR; PG8_MMA(1, 0, At, B0); PG8_MMA(1, 1, At, B1); PG8_BAR; PG8_SCHED;
            } else {
            PG8_LDB(B0, 0, 0); PG8_SCHED; PG8_LDA(At, 0, 0); PG8_STAGE(PG8_SA(1, 1), a1 + hstep, voffA);
            PG8_WAIT_L(8); PG8_BAR; PG8_WAIT_L(0); PG8_MMA(0, 0, At, B0); PG8_BAR; PG8_SCHED;
            PG8_LDB(B1, 0, 1); PG8_STAGE(PG8_SB(0, 0), b2, voffB);
            PG8_BAR; PG8_WAIT_L(0); PG8_MMA(0, 1, At, B1); PG8_BAR;
            PG8_LDA(At, 0, 1); PG8_STAGE(PG8_SA(0, 0), a2, voffA);
            PG8_BAR; PG8_WAIT_L(0); PG8_MMA(1, 0, At, B0); PG8_BAR; PG8_SCHED;
            PG8_STAGE(PG8_SB(0, 1), b2 + hstep, voffB);
            PG8_WAIT_V(6); PG8_BAR; PG8_MMA(1, 1, At, B1); PG8_BAR;
            PG8_LDB(B0, 1, 0); PG8_SCHED; PG8_LDA(At, 1, 0); PG8_STAGE(PG8_SA(0, 1), a2 + hstep, voffA);
            PG8_WAIT_L(8); PG8_BAR; PG8_WAIT_L(0); PG8_MMA(0, 0, At, B0); PG8_BAR; PG8_SCHED;
            PG8_LDB(B1, 1, 1); PG8_STAGE(PG8_SB(1, 0), b3, voffB);
            PG8_BAR; PG8_WAIT_L(0); PG8_MMA(0, 1, At, B1); PG8_BAR;
            PG8_LDA(At, 1, 1); PG8_STAGE(PG8_SA(1, 0), a3, voffA);
            PG8_BAR; PG8_WAIT_L(0); PG8_MMA(1, 0, At, B0); PG8_BAR; PG8_SCHED;
            PG8_STAGE(PG8_SB(1, 1), b3 + hstep, voffB);
            PG8_WAIT_V(6); PG8_BAR; PG8_MMA(1, 1, At, B1); PG8_BAR;
            }
        }
        if constexpr (ALIGN_EPI) { if (wr == 0) PG8_BAR; }
        if constexpr (!Epi::AFTER_DRAIN) { E(acc, cur, wr, wc, fr, fq); S.done(cur); }
        if (!has_next) break;
#pragma unroll
        for (int a = 0; a < 2; ++a)
#pragma unroll
            for (int b = 0; b < 2; ++b)
#pragma unroll
                for (int m = 0; m < 4; ++m)
#pragma unroll
                    for (int n = 0; n < 2; ++n) acc[a][b][m][n] = (f32x4){0.f, 0.f, 0.f, 0.f};
        cur = nxt; cA = nA; cB = nB; ++ui;
        if constexpr (ALIGN_EPI) { if (wr == 1) PG8_BAR; }
    }
    PG8_WAIT_V(0);
    if constexpr (!ALIGN_EPI) { if (wr == 0) PG8_BAR; }
    PG8_BAR;
    if constexpr (Epi::AFTER_DRAIN) { E.fused(acc, cur, wr, wc, fr, fq, lds, wid, lane); S.done(cur); }
#undef PG8_SA
#undef PG8_SB
#undef PG8_STAGE
#undef PG8_LDA
#undef PG8_LDB
#undef PG8_MMA
#undef PG8_WAIT_V
#undef PG8_WAIT_L
#undef PG8_BAR
#undef PG8_SCHED
}
}
#ifndef REP_P5
#define REP_P5 1
#endif
#ifndef REP_P0
#define REP_P0 1
#endif
#ifndef REP_P1
#define REP_P1 1
#endif
#ifndef REP_P4
#define REP_P4 1
#endif
#ifndef REP_P0B
#define REP_P0B 1
#endif
#ifndef REP_P0C
#define REP_P0C 1
#endif
#ifndef REP_P2
#define REP_P2 1
#endif
constexpr int T = 8192, D = 2048, NIN = 3328, SEQ = 2048, NE = 16384;
constexpr float EPS = 1e-6f;
constexpr int NWAVES = 8, NTHR = 512;
constexpr size_t MiB = 1u << 20;
constexpr size_t WS_CTL = 0, CTL_ZERO_BYTES = 1 * MiB;
constexpr size_t WS_WIN = 2 * MiB;
constexpr size_t WS_WOUT = 16 * MiB;
constexpr size_t WS_WEFF = 24 * MiB;
constexpr size_t WS_H = 32 * MiB;
constexpr size_t WS_Z = 64 * MiB;
constexpr size_t WS_MIX = 116 * MiB;
constexpr size_t WS_X1 = 148 * MiB;
constexpr size_t WS_SC = 212 * MiB;
constexpr size_t WS_ED = 284 * MiB;
constexpr size_t WS_EU = 316 * MiB;
constexpr int ROWB = 1536;
constexpr size_t WS_SD = 348 * MiB;
constexpr size_t WS_SU = 348 * MiB + 65536;
constexpr size_t WS_RSS = 348 * MiB + 131072;
constexpr size_t WS_END = 349 * MiB;
constexpr int CW_TMO = 0, CW_BAR = 4096;
constexpr int RING_OFF = 0, RING_BYTES = 131072;
constexpr int LDSCTL_OFF = RING_BYTES, MISC_OFF = LDSCTL_OFF + 320;
constexpr int LDS_BYTES = 163840;

#define GAS __attribute__((address_space(1)))
#define LAS __attribute__((address_space(3)))
typedef unsigned short bf16;
typedef unsigned v4u __attribute__((ext_vector_type(4)));
typedef unsigned v2u __attribute__((ext_vector_type(2)));
typedef float f32x4 __attribute__((ext_vector_type(4)));
typedef GAS unsigned gu32;
#define LDS_WAIT() asm volatile("s_waitcnt lgkmcnt(0)" ::: "memory")
#define VM_WAIT() asm volatile("s_waitcnt vmcnt(0)" ::: "memory")
__device__ __forceinline__ unsigned f2bf(float f) { unsigned u = __builtin_bit_cast(unsigned, f); return (u + 0x7fffu + ((u >> 16) & 1u)) >> 16; }
__device__ __forceinline__ unsigned pk2(float lo, float hi) { return f2bf(lo) | (f2bf(hi) << 16); }
__device__ __forceinline__ float bf2f(bf16 h) { return __uint_as_float(((unsigned)h) << 16); }
__device__ __forceinline__ float bflo(unsigned w) { return __uint_as_float(w << 16); }
__device__ __forceinline__ float bfhi(unsigned w) { return __uint_as_float(w & 0xffff0000u); }
__device__ __forceinline__ float gelu_erf(float v) { return 0.5f * v * (1.0f + erff(v * 0.70710678118654752f)); }
__device__ __forceinline__ float wave_sum(float v) {
#pragma unroll
    for (int o = 1; o < 64; o <<= 1) v += __shfl_xor(v, o);
    return v;
}

#define XB_TMO      128
#define XB_XCNT(j)  (256  + 64 * (j))
#define XB_XSUB(j)  (1280 + 64 * (j))
#define XB_XGEN(j)  (2304 + 64 * (j))
#define XB_TOP      3328
#define XB_TOPGEN   3392
#define XCD_BAR_WORDS 3456
#define XB_SPIN_CAP (1u << 18)

__device__ __forceinline__ unsigned xb_ld(unsigned* p)              { return __hip_atomic_load(p, __ATOMIC_RELAXED, __HIP_MEMORY_SCOPE_AGENT); }
__device__ __forceinline__ unsigned xb_add(unsigned* p, unsigned v) { return __hip_atomic_fetch_add(p, v, __ATOMIC_RELAXED, __HIP_MEMORY_SCOPE_AGENT); }
__device__ __forceinline__ unsigned xb_xcc_id() { return (unsigned)__builtin_amdgcn_s_getreg((3 << 11) | 20) & 0xFu; }
#define XB_SPIN(cond, bar) do { unsigned _sp = 0; while (cond) { __builtin_amdgcn_s_sleep(1); \
    if ((++_sp & 255u) == 0u) { if (xb_ld(&(bar)[XB_TMO])) break; if (_sp > XB_SPIN_CAP) { atomicAdd(&(bar)[XB_TMO], 1u); break; } } } } while (0)

struct XcdBarrier {
    unsigned* bar; unsigned x;
    volatile LAS unsigned* st;
};

__device__ __forceinline__ XcdBarrier xcd_barrier_post(unsigned* bar, volatile LAS unsigned* st) {
    XcdBarrier b; b.bar = bar; b.x = xb_xcc_id(); b.st = st;
    if (threadIdx.x == 0) (void)xb_add(&bar[XB_XCNT(b.x)], 1u);
    return b;
}
__device__ __forceinline__ void xcd_barrier_complete(unsigned* bar, unsigned x, unsigned& nloc, unsigned& nx) {
    const unsigned G = gridDim.x * gridDim.y * gridDim.z;
    unsigned sum, cnt, mine, sp = 0u;
    for (;;) {
        sum = 0u; cnt = 0u; mine = 0u;
#pragma unroll
        for (unsigned j = 0; j < 16; ++j) { const unsigned c = xb_ld(&bar[XB_XCNT(j)]); sum += c; cnt += (c > 0u) ? 1u : 0u; mine = (j == x) ? c : mine; }
        if (sum == G) break;
        __builtin_amdgcn_s_sleep(1);
        if ((++sp & 255u) == 0u) { if (xb_ld(&bar[XB_TMO])) break; if (sp > XB_SPIN_CAP) { atomicAdd(&bar[XB_TMO], 1u); break; } }
    }
    nloc = mine > 0u ? mine : 1u; nx = cnt > 0u ? cnt : 1u;
}

__device__ __forceinline__ void xcd_barrier(const XcdBarrier& b) {
    asm volatile("s_waitcnt vmcnt(0)" ::: "memory");
    __syncthreads();
    if (threadIdx.x == 0) {
        unsigned* bar = b.bar;
        __builtin_amdgcn_s_waitcnt(0);
        unsigned nloc = b.st[0], nx = b.st[1];
        if (nloc == 0u) { xcd_barrier_complete(bar, b.x, nloc, nx); b.st[0] = nloc; b.st[1] = nx; }
        const unsigned old = xb_add(&bar[XB_XSUB(b.x)], 1u);
        const unsigned gen = old / nloc;
        if (old + 1u == (gen + 1u) * nloc) {
            __builtin_amdgcn_fence(__ATOMIC_RELEASE, "agent");
            asm volatile("s_waitcnt vmcnt(0)" ::: "memory");
            const unsigned og = xb_add(&bar[XB_TOP], 1u);
            const unsigned tg = og / nx;
            if (og + 1u == (tg + 1u) * nx) xb_add(&bar[XB_TOPGEN], 1u);
            else XB_SPIN(xb_ld(&bar[XB_TOPGEN]) == tg, bar);
            __builtin_amdgcn_fence(__ATOMIC_ACQUIRE, "agent");
            xb_add(&bar[XB_XGEN(b.x)], 1u);
            asm volatile("s_waitcnt vmcnt(0)" ::: "memory");
        } else {
            XB_SPIN(xb_ld(&bar[XB_XGEN(b.x)]) == gen, bar);
            __builtin_amdgcn_fence(__ATOMIC_ACQUIRE, "agent");
            asm volatile("s_waitcnt vmcnt(0)" ::: "memory");
        }
    }
    __syncthreads();
}

struct Ctx { LAS unsigned char* lds; int tid, lane, wave, G, bid; };

__device__ __forceinline__ void p0_transpose_item(const float* W, int K, int N, bf16* WT, LAS float* scr, int item, int lane) {
    const int nblk = N / 32, kb = item / nblk, nb = item % nblk, k0 = 64 * kb, n0 = 32 * nb;
#pragma unroll 8
    for (int i = 0; i < 32; ++i) { const int kk = 2 * i + (lane >> 5); scr[kk * 33 + (lane & 31)] = W[(size_t)(k0 + kk) * N + n0 + (lane & 31)]; }
    LDS_WAIT(); asm volatile("" ::: "memory");
    const int c = lane & 7;
#pragma unroll
    for (int j = 0; j < 4; ++j) { const int n = (lane >> 3) + 8 * j; const LAS float* s = scr + (8 * c) * 33 + n;
        v4u o; o.x = pk2(s[0 * 33], s[1 * 33]); o.y = pk2(s[2 * 33], s[3 * 33]); o.z = pk2(s[4 * 33], s[5 * 33]); o.w = pk2(s[6 * 33], s[7 * 33]);
        *(v4u*)(WT + (size_t)(n0 + n) * K + k0 + 8 * c) = o; }
    LDS_WAIT(); asm volatile("" ::: "memory");
}
__device__ __forceinline__ void rms_row_to_bf16(const float* xr, const float* g, bf16* orow, int lane) {
    f32x4 v[8]; float s = 0.f;
#pragma unroll
    for (int j = 0; j < 8; ++j) { v[j] = *(const f32x4*)(xr + j * 256 + lane * 4); s += (v[j].x * v[j].x + v[j].y * v[j].y) + (v[j].z * v[j].z + v[j].w * v[j].w); }
    const float r = rsqrtf(wave_sum(s) * (1.f / D) + EPS);
#pragma unroll
    for (int j = 0; j < 8; ++j) { const f32x4 gg = *(const f32x4*)(g + j * 256 + lane * 4);
        v2u o; o.x = pk2(v[j].x * r * gg.x, v[j].y * r * gg.y); o.y = pk2(v[j].z * r * gg.z, v[j].w * r * gg.w);
        *(v2u*)(orow + j * 256 + lane * 4) = o; }
}
typedef float f32x2 __attribute__((ext_vector_type(2)));
typedef __bf16 bf16x2v __attribute__((ext_vector_type(2)));
__device__ __forceinline__ unsigned cvtpk(float lo, float hi) { const f32x2 v = {lo, hi}; return __builtin_bit_cast(unsigned, __builtin_convertvector(v, bf16x2v)); }
typedef short bf16x8 __attribute__((ext_vector_type(8)));
typedef float f32x16 __attribute__((ext_vector_type(16)));
__device__ __forceinline__ bf16x8 pack8(float a0, float a1, float a2, float a3, float a4, float a5, float a6, float a7) {
    v4u w; w.x = cvtpk(a0, a1); w.y = cvtpk(a2, a3); w.z = cvtpk(a4, a5); w.w = cvtpk(a6, a7); return __builtin_bit_cast(bf16x8, w); }
__device__ __forceinline__ void split8(const f32x4 a0, const f32x4 a1, bf16x8& hi, bf16x8& lo) {
    hi = pack8(a0[0], a0[1], a0[2], a0[3], a1[0], a1[1], a1[2], a1[3]);
    const v4u w = __builtin_bit_cast(v4u, hi);
    lo = pack8(a0[0] - bflo(w[0]), a0[1] - bfhi(w[0]), a0[2] - bflo(w[1]), a0[3] - bfhi(w[1]), a1[0] - bflo(w[2]), a1[1] - bfhi(w[2]), a1[2] - bflo(w[3]), a1[3] - bfhi(w[3]));
}
typedef __bf16 bf16x32 __attribute__((ext_vector_type(32)));
typedef unsigned v6u __attribute__((ext_vector_type(6)));
typedef float f32x32 __attribute__((ext_vector_type(32)));
__device__ __forceinline__ void p0_rows_to_fp8(const float* ra, const float* rb, unsigned char* da, unsigned char* db, float* ia, float* ib, int lane) {
    f32x4 va[8], vb[8]; float ma = 0.f, mb = 0.f;
#pragma unroll
    for (int j = 0; j < 2; ++j)
#pragma unroll
        for (int q = 0; q < 4; ++q) { va[4 * j + q] = __builtin_nontemporal_load((const f32x4*)(ra + j * 1024 + lane * 16 + 4 * q)); vb[4 * j + q] = __builtin_nontemporal_load((const f32x4*)(rb + j * 1024 + lane * 16 + 4 * q)); }
#pragma unroll
    for (int i = 0; i < 8; ++i) { const f32x4 t = va[i], u = vb[i];
        ma = fmaxf(fmaxf(ma, fmaxf(fabsf(t.x), fabsf(t.y))), fmaxf(fabsf(t.z), fabsf(t.w))); mb = fmaxf(fmaxf(mb, fmaxf(fabsf(u.x), fabsf(u.y))), fmaxf(fabsf(u.z), fabsf(u.w))); }
#pragma unroll
    for (int o = 1; o < 64; o <<= 1) { ma = fmaxf(ma, __shfl_xor(ma, o)); mb = fmaxf(mb, __shfl_xor(mb, o)); }
    const float sa = ma > 0.f ? 7.f / ma : 0.f, sb = mb > 0.f ? 7.f / mb : 0.f;
    bf16x32 xa, xb;
#pragma unroll
    for (int k = 0; k < 32; ++k) { xa[k] = (__bf16)(va[k >> 2][k & 3] * sa); xb[k] = (__bf16)(vb[k >> 2][k & 3] * sb); }
    const v6u pa = __builtin_amdgcn_cvt_scalef32_pk32_fp6_bf16(xa, 1.0f), pb = __builtin_amdgcn_cvt_scalef32_pk32_fp6_bf16(xb, 1.0f);
#pragma unroll
    for (int q = 0; q < 3; ++q) { *(v2u*)(da + 24 * lane + 8 * q) = (v2u){pa[2 * q], pa[2 * q + 1]}; *(v2u*)(db + 24 * lane + 8 * q) = (v2u){pb[2 * q], pb[2 * q + 1]}; }
    if (lane == 0) { *ia = ma * (1.f / 7.f); *ib = mb * (1.f / 7.f); }
}
constexpr int CONV_SPLIT = 24064;
__device__ __forceinline__ void convert_rows(const float* e_down, const float* e_up, unsigned char* ED, unsigned char* EU, float* SD, float* SU, int r_lo, int r_hi, int w, int nw, int lane) {
    for (int r = r_lo + 2 * w; r < r_hi; r += 2 * nw) {
        const bool up = r >= NE; const int row = up ? r - NE : r;
        const float* s = (up ? e_up : e_down) + (size_t)row * D; unsigned char* d = (up ? EU : ED) + (size_t)row * ROWB; float* iv = (up ? SU : SD) + row;
        p0_rows_to_fp8(s, s + D, d, d + ROWB, iv, iv + 1, lane);
    }
}
__device__ __forceinline__ void p0_prologue(const Ctx& F, const float* x, const float* g1, const float* w_in, const float* w_out, const float* wq, const float* sk,
                                            const float* e_down, const float* e_up, bf16* WinT, bf16* WoutT, bf16* WeffT, bf16* H, unsigned char* ED, unsigned char* EU, float* SD, float* SU, float* rowss) {
    const int gw = F.bid * NWAVES + F.wave, NGW = F.G * NWAVES;
    {
        LAS float* scr = (LAS float*)(F.lds + RING_OFF + F.wave * 16384);
        constexpr int I_IN = (D / 64) * (NIN / 32), I_OUT = (D / 64) * (D / 32);
        for (int it = gw; it < I_IN + I_OUT; it += NGW) {
            if (it < I_IN) p0_transpose_item(w_in, D, NIN, WinT, scr, it, F.lane);
            else p0_transpose_item(w_out, D, D, WoutT, scr, it - I_IN, F.lane);
        }
    }
    __syncthreads();
    for (int it = gw; it < 16 * 64 * 2; it += NGW) {
        const int g = it & 15, dtile = (it >> 4) & 63, kh = it >> 10, p = g & 1, c = F.lane & 31, h = F.lane >> 5;
        const float* arow = wq + (size_t)(dtile * 32 + c) * 2048 + g * 128 + 8 * h;
        bf16x8 ah[8], al[8];
#pragma unroll
        for (int ks = 0; ks < 8; ++ks) { const f32x4 a0 = *(const f32x4*)(arow + 16 * ks), a1 = *(const f32x4*)(arow + 16 * ks + 4); split8(a0, a1, ah[ks], al[ks]); }
#pragma unroll 1
        for (int kt = 0; kt < 2; ++kt) {
            const int k0 = (kh * 2 + kt) * 32;
            const float* brow = sk + (size_t)(p * 128 + k0 + c) * 128 + 8 * h;
            f32x16 acc;
#pragma unroll
            for (int i = 0; i < 16; ++i) acc[i] = 0.f;
#pragma unroll
            for (int ks = 0; ks < 8; ++ks) { const f32x4 b0 = *(const f32x4*)(brow + 16 * ks), b1 = *(const f32x4*)(brow + 16 * ks + 4); bf16x8 bh, bl; split8(b0, b1, bh, bl);
                acc = __builtin_amdgcn_mfma_f32_32x32x16_bf16(al[ks], bh, acc, 0, 0, 0); acc = __builtin_amdgcn_mfma_f32_32x32x16_bf16(ah[ks], bl, acc, 0, 0, 0);
                acc = __builtin_amdgcn_mfma_f32_32x32x16_bf16(ah[ks], bh, acc, 0, 0, 0); }
            bf16* orow = WeffT + (size_t)(g * 128 + k0 + c) * 2048 + dtile * 32 + 4 * h;
#pragma unroll
            for (int q = 0; q < 4; ++q) { v2u o; o.x = cvtpk(acc[4 * q], acc[4 * q + 1]); o.y = cvtpk(acc[4 * q + 2], acc[4 * q + 3]); *(v2u*)(orow + 8 * q) = o; }
        }
    }
    for (int rep_ = 0; rep_ < REP_P0C; ++rep_) convert_rows(e_down, e_up, ED, EU, SD, SU, 0, CONV_SPLIT, gw, NGW, F.lane);
    for (int i = F.bid * NTHR + F.tid; i < T; i += F.G * NTHR) __hip_atomic_store(rowss + i, 0.f, __ATOMIC_RELAXED, __HIP_MEMORY_SCOPE_AGENT);
    for (int m = gw; m < T; m += NGW) rms_row_to_bf16(x + (size_t)m * D, g1, H + (size_t)m * D, F.lane);
}

constexpr int SGU_VS = 136;
__device__ __forceinline__ void p2_sgu(const Ctx& F, const bf16* Z, const float* ln_g, const float* ln_b, const float* w_s, const float* b_s, bf16* MIX) {
    LAS bf16* vnT = (LAS bf16*)(F.lds + RING_OFF);
    LAS float* ps = (LAS float*)(F.lds + RING_OFF + 128 * SGU_VS * 2);
    LAS float* pq = ps + 512;
    const int s = F.tid & 127, dq = F.tid >> 7;
    const int c = F.lane & 31, h = F.lane >> 5, tt = F.wave >> 1;
    for (int unit = F.bid; unit < 512; unit += F.G) {
        const int g = unit & 7, t0 = (unit >> 3) * 128;
        __syncthreads();
        float v[32];
        { const bf16* vr = Z + (size_t)(t0 + s) * NIN + 1024 + g * 128 + dq * 32;
#pragma unroll
          for (int j = 0; j < 4; ++j) { const v4u q = *(const v4u*)(vr + 8 * j);
#pragma unroll
              for (int e = 0; e < 4; ++e) { v[8 * j + 2 * e] = bflo(q[e]); v[8 * j + 2 * e + 1] = bfhi(q[e]); } } }
        float sm = 0.f;
#pragma unroll
        for (int j = 0; j < 32; ++j) sm += v[j];
        ps[dq * 128 + s] = sm;
        __syncthreads();
        const float mean = (ps[s] + ps[128 + s] + ps[256 + s] + ps[384 + s]) * (1.f / 128.f);
        float sq = 0.f;
#pragma unroll
        for (int j = 0; j < 32; ++j) { v[j] -= mean; sq += v[j] * v[j]; }
        pq[dq * 128 + s] = sq;
        __syncthreads();
        const float rstd = rsqrtf((pq[s] + pq[128 + s] + pq[256 + s] + pq[384 + s]) * (1.f / 128.f) + EPS);
#pragma unroll
        for (int j = 0; j < 32; ++j) { const int d = dq * 32 + j; vnT[d * SGU_VS + s] = (bf16)f2bf(v[j] * rstd * ln_g[g * 128 + d] + ln_b[g * 128 + d]); }
        __syncthreads();
        f32x16 acc[2];
#pragma unroll
        for (int a = 0; a < 2; ++a)
#pragma unroll
            for (int i = 0; i < 16; ++i) acc[a][i] = 0.f;
        const int trow = 32 * tt + c;
        const float* wrow = w_s + ((size_t)g * 128 + trow) * 128;
        const int dt0 = 2 * (F.wave & 1);
        for (int ks = 0; ks < 2 * (tt + 1); ++ks) {
            const int s0 = 16 * ks + 8 * h;
            const f32x4 w0 = *(const f32x4*)(wrow + s0), w1 = *(const f32x4*)(wrow + s0 + 4);
            float w[8] = {w0[0], w0[1], w0[2], w0[3], w1[0], w1[1], w1[2], w1[3]};
#pragma unroll
            for (int j = 0; j < 8; ++j) w[j] = (s0 + j <= trow) ? w[j] : 0.f;
            const bf16x8 bf = pack8(w[0], w[1], w[2], w[3], w[4], w[5], w[6], w[7]);
#pragma unroll
            for (int a = 0; a < 2; ++a) { const bf16x8 af = *(const LAS bf16x8*)(vnT + (32 * (dt0 + a) + c) * SGU_VS + s0);
                acc[a] = __builtin_amdgcn_mfma_f32_32x32x16_bf16(af, bf, acc[a], 0, 0, 0); }
        }
        const float bias = b_s[g * 128 + trow];
        const size_t tok = (size_t)(t0 + trow);
#pragma unroll
        for (int a = 0; a < 2; ++a)
#pragma unroll
            for (int q = 0; q < 4; ++q) { const int d0 = 32 * (dt0 + a) + 8 * q + 4 * h;
                const v2u uu = *(const v2u*)(Z + tok * NIN + g * 128 + d0);
                v2u o; o.x = cvtpk(bflo(uu.x) * (acc[a][4 * q] + bias), bfhi(uu.x) * (acc[a][4 * q + 1] + bias));
                o.y = cvtpk(bflo(uu.y) * (acc[a][4 * q + 2] + bias), bfhi(uu.y) * (acc[a][4 * q + 3] + bias));
                *(v2u*)(MIX + tok * D + g * 128 + d0) = o; }
    }
}
constexpr int ATT_KS = 72, ATT_VS = 264;
__device__ __forceinline__ void p2_attn(const Ctx& F, const bf16* Z, const float* sinks, bf16* MIX) {
    LAS bf16* Ks = (LAS bf16*)(F.lds + RING_OFF);
    LAS bf16* Vt = (LAS bf16*)(F.lds + RING_OFF + 256 * ATT_KS * 2);
    const int c = F.lane & 31, h = F.lane >> 5;
    for (int unit = F.bid; unit < 256; unit += F.G) {
        const int hg = unit & 1, hk = (unit >> 1) & 1, n = (unit >> 2) & 15, b = unit >> 6;
        __syncthreads();
        for (int e = F.tid; e < 256 * 8; e += NTHR) {
            const int j = e >> 3, ch = e & 7, pos = (n - 1) * 128 + j;
            v4u kv = (v4u){0u, 0u, 0u, 0u}, vv = (v4u){0u, 0u, 0u, 0u};
            if (pos >= 0) { const bf16* row = Z + ((size_t)b * SEQ + pos) * NIN; kv = *(const v4u*)(row + 3072 + hk * 64 + ch * 8); vv = *(const v4u*)(row + 3200 + hk * 64 + ch * 8); }
            *(LAS v4u*)(Ks + j * ATT_KS + ch * 8) = kv;
#pragma unroll
            for (int jj = 0; jj < 8; ++jj) Vt[(ch * 8 + jj) * ATT_VS + j] = (bf16)((vv[jj >> 1] >> (16 * (jj & 1))) & 0xffffu);
        }
        __syncthreads();
        for (int tk = 0; tk < 2; ++tk) {
            const int hq = hk * 8 + hg * 4 + (F.wave >> 1), i0 = 32 * (2 * (F.wave & 1) + tk);
            const size_t tok = (size_t)b * SEQ + n * 128 + i0 + c;
            const bf16* qrow = Z + tok * NIN + 2048 + hq * 64;
            bf16x8 qf[4];
#pragma unroll
            for (int ks = 0; ks < 4; ++ks) qf[ks] = *(const bf16x8*)(qrow + 16 * ks + 8 * h);
            f32x16 sT[5];
#pragma unroll
            for (int kt = 0; kt < 5; ++kt) {
#pragma unroll
                for (int i = 0; i < 16; ++i) sT[kt][i] = 0.f;
#pragma unroll
                for (int ks = 0; ks < 4; ++ks) { const bf16x8 kf = *(const LAS bf16x8*)(Ks + (i0 + 32 * kt + c) * ATT_KS + 16 * ks + 8 * h);
                    sT[kt] = __builtin_amdgcn_mfma_f32_32x32x16_bf16(kf, qf[ks], sT[kt], 0, 0, 0); }
            }
            const float sink = sinks[hq]; float m = sink;
#pragma unroll
            for (int kt = 0; kt < 5; ++kt) {
                const bool tile_ok = (n > 0) || (i0 + 32 * kt >= 128);
#pragma unroll
                for (int i = 0; i < 16; ++i) { const int jj = (i & 3) + 8 * (i >> 2) + 4 * h;
                    bool ok = tile_ok; if (kt == 0) ok = ok && (jj > c); if (kt == 4) ok = ok && (jj <= c);
                    const float x = ok ? sT[kt][i] * 0.125f : -INFINITY; sT[kt][i] = x; m = fmaxf(m, x); }
            }
            m = fmaxf(m, __shfl_xor(m, 32));
            float l = 0.f;
#pragma unroll
            for (int kt = 0; kt < 5; ++kt)
#pragma unroll
                for (int i = 0; i < 16; ++i) { const float p = __expf(sT[kt][i] - m); sT[kt][i] = p; l += p; }
            l += __shfl_xor(l, 32); l += __expf(sink - m);
            f32x16 o[2];
#pragma unroll
            for (int a = 0; a < 2; ++a)
#pragma unroll
                for (int i = 0; i < 16; ++i) o[a][i] = 0.f;
#pragma unroll
            for (int kt = 0; kt < 5; ++kt)
#pragma unroll
                for (int st = 0; st < 2; ++st) {
                    const bf16x8 pf = pack8(sT[kt][8 * st], sT[kt][8 * st + 1], sT[kt][8 * st + 2], sT[kt][8 * st + 3], sT[kt][8 * st + 4], sT[kt][8 * st + 5], sT[kt][8 * st + 6], sT[kt][8 * st + 7]);
                    const int key0 = i0 + 32 * kt + 16 * st + 4 * h;
#pragma unroll
                    for (int a = 0; a < 2; ++a) { const LAS bf16* vp = Vt + (32 * a + c) * ATT_VS + key0;
                        const v2u lo = *(const LAS v2u*)vp, hi = *(const LAS v2u*)(vp + 8);
                        const v4u vw = (v4u){lo.x, lo.y, hi.x, hi.y};
                        o[a] = __builtin_amdgcn_mfma_f32_32x32x16_bf16(__builtin_bit_cast(bf16x8, vw), pf, o[a], 0, 0, 0); }
                }
            const float inv = 1.f / l;
#pragma unroll
            for (int a = 0; a < 2; ++a)
#pragma unroll
                for (int q = 0; q < 4; ++q) { const int d0 = 32 * a + 8 * q + 4 * h;
                    v2u w; w.x = cvtpk(o[a][4 * q] * inv, o[a][4 * q + 1] * inv); w.y = cvtpk(o[a][4 * q + 2] * inv, o[a][4 * q + 3] * inv);
                    *(v2u*)(MIX + tok * D + 1024 + hq * 64 + d0) = w; }
        }
    }
}

typedef __bf16 bf16x2_t __attribute__((ext_vector_type(2)));
constexpr int P5_TOK = 32;
constexpr int P5_WL = 2048;
__device__ __forceinline__ unsigned fkey(float f) { const unsigned u = __float_as_uint(f); return (u & 0x80000000u) ? ~u : (u | 0x80000000u); }
__device__ __forceinline__ float dot2bf(unsigned a, unsigned b, float c) { return __builtin_amdgcn_fdot2_f32_bf16(__builtin_bit_cast(bf16x2_t, a), __builtin_bit_cast(bf16x2_t, b), c, false); }
template <int CTRL, int RM, bool BC> __device__ __forceinline__ float dpp_f(float v) { return __builtin_bit_cast(float, __builtin_amdgcn_update_dpp(0, __builtin_bit_cast(int, v), CTRL, RM, 0xf, BC)); }
struct WaveLds { LAS int* eid; LAS float* gate; LAS float* sv; LAS float* tv; LAS int* ti; LAS int* ctab; };
template <int CTRL> __device__ __forceinline__ unsigned dppx_u(unsigned v) { return (unsigned)__builtin_amdgcn_update_dpp(0, (int)v, CTRL, 0xf, 0xf, true); }
template <int CTRL> __device__ __forceinline__ float dppx_f(float v) { return __builtin_bit_cast(float, __builtin_amdgcn_update_dpp(0, __builtin_bit_cast(int, v), CTRL, 0xf, 0xf, true)); }
__device__ __forceinline__ unsigned umax(unsigned a, unsigned b) { return a > b ? a : b; }
__device__ __forceinline__ unsigned umin(unsigned a, unsigned b) { return a < b ? a : b; }
__device__ __forceinline__ unsigned row_allmax_u(unsigned m) {
    m = umax(m, dppx_u<0xB1>(m)); m = umax(m, dppx_u<0x4E>(m)); m = umax(m, dppx_u<0x141>(m)); m = umax(m, dppx_u<0x140>(m)); return m; }
__device__ __forceinline__ float row_allmax_f(float m) { m = fmaxf(m, dppx_f<0xB1>(m)); m = fmaxf(m, dppx_f<0x4E>(m)); m = fmaxf(m, dppx_f<0x141>(m)); m = fmaxf(m, dppx_f<0x140>(m)); return m; }
__device__ __forceinline__ float row_allsum_f(float m) { m += dppx_f<0xB1>(m); m += dppx_f<0x4E>(m); m += dppx_f<0x141>(m); m += dppx_f<0x140>(m); return m; }
#define P5_CE(a, b) do { const unsigned _h = umax(a, b), _l = umin(a, b); a = _h; b = _l; } while (0)
__device__ __forceinline__ int cand_pair(int c) {
    return c < 16 ? c : c < 24 ? (1 << 4) | (c - 16) : c < 29 ? (2 << 4) | (c - 24) : c < 33 ? (3 << 4) | (c - 29) : c < 36 ? (4 << 4) | (c - 33) : c < 38 ? (5 << 4) | (c - 36)
         : c < 40 ? (6 << 4) | (c - 38) : c < 42 ? (7 << 4) | (c - 40) : c < 50 ? ((c - 34) << 4) : 0xff;
}
__device__ __forceinline__ void p5_topk_token(const WaveLds& W, const float* sc  , int lane) {
    const int r = lane >> 4, l15 = lane & 15;
#pragma unroll 1
    for (int pp = 0; pp < 2; ++pp) {
        unsigned k[2][8]; unsigned top[2] = {0u, 0u};
#pragma unroll
        for (int u = 0; u < 2; ++u) {
            const int L = 4 * (2 * pp + u) + r;
            const f32x4 v0 = __builtin_nontemporal_load((const f32x4*)(sc + L * 128 + 8 * l15)), v1 = __builtin_nontemporal_load((const f32x4*)(sc + L * 128 + 8 * l15 + 4));
            *(LAS f32x4*)(W.sv + L * 128 + 8 * l15) = v0; *(LAS f32x4*)(W.sv + L * 128 + 8 * l15 + 4) = v1;
#pragma unroll
            for (int j = 0; j < 4; ++j) { k[u][j] = (fkey(v0[j]) & ~127u) | (unsigned)(127 - (8 * l15 + j)); k[u][4 + j] = (fkey(v1[j]) & ~127u) | (unsigned)(127 - (8 * l15 + 4 + j)); }
            P5_CE(k[u][0], k[u][1]); P5_CE(k[u][2], k[u][3]); P5_CE(k[u][4], k[u][5]); P5_CE(k[u][6], k[u][7]);
            P5_CE(k[u][0], k[u][2]); P5_CE(k[u][1], k[u][3]); P5_CE(k[u][4], k[u][6]); P5_CE(k[u][5], k[u][7]);
            P5_CE(k[u][1], k[u][2]); P5_CE(k[u][5], k[u][6]);
            P5_CE(k[u][0], k[u][4]); P5_CE(k[u][1], k[u][5]); P5_CE(k[u][2], k[u][6]); P5_CE(k[u][3], k[u][7]);
            P5_CE(k[u][2], k[u][4]); P5_CE(k[u][3], k[u][5]);
            P5_CE(k[u][1], k[u][2]); P5_CE(k[u][3], k[u][4]); P5_CE(k[u][5], k[u][6]);
        }
#pragma unroll 4
        for (int it = 0; it < 16; ++it) {
#pragma unroll
            for (int u = 0; u < 2; ++u) {
                const unsigned m = row_allmax_u(k[u][0]); const bool sel = k[u][0] == m;
                top[u] = (l15 == it) ? m : top[u];
#pragma unroll
                for (int j = 0; j < 7; ++j) k[u][j] = sel ? k[u][j + 1] : k[u][j];
                k[u][7] = sel ? 0u : k[u][7];
            }
        }
        LDS_WAIT(); __builtin_amdgcn_wave_barrier();
#pragma unroll
        for (int u = 0; u < 2; ++u) { const int L = 4 * (2 * pp + u) + r; const int idx = 127 - (int)(top[u] & 127u);
            W.tv[L * 16 + l15] = W.sv[L * 128 + idx]; W.ti[L * 16 + l15] = idx; }
    }
    LDS_WAIT(); __builtin_amdgcn_wave_barrier();
    int cij[4];
#pragma unroll
    for (int j = 0; j < 4; ++j) cij[j] = cand_pair(4 * l15 + j);
    unsigned ck[2][4]; unsigned top2[2] = {0u, 0u};
#pragma unroll
    for (int u = 0; u < 2; ++u) {
        const int hd = 4 * u + r; const LAS float* tv0 = W.tv + (2 * hd) * 16; const LAS float* tv1 = tv0 + 16;
#pragma unroll
        for (int j = 0; j < 4; ++j) { const float cs = tv0[(cij[j] >> 4) & 15] + tv1[cij[j] & 15]; const int s = 4 * l15 + j;
            ck[u][j] = (s < 50) ? ((fkey(cs) & ~63u) | (unsigned)(63 - s)) : 0u; }
        P5_CE(ck[u][0], ck[u][1]); P5_CE(ck[u][2], ck[u][3]); P5_CE(ck[u][0], ck[u][2]); P5_CE(ck[u][1], ck[u][3]); P5_CE(ck[u][1], ck[u][2]);
    }
#pragma unroll 4
    for (int it = 0; it < 16; ++it) {
#pragma unroll
        for (int u = 0; u < 2; ++u) {
            const unsigned m = row_allmax_u(ck[u][0]); const bool sel = ck[u][0] == m;
            top2[u] = (l15 == it) ? m : top2[u];
            ck[u][0] = sel ? ck[u][1] : ck[u][0]; ck[u][1] = sel ? ck[u][2] : ck[u][1]; ck[u][2] = sel ? ck[u][3] : ck[u][2]; ck[u][3] = sel ? 0u : ck[u][3];
        }
    }
#pragma unroll
    for (int u = 0; u < 2; ++u) {
        const int hd = 4 * u + r; const LAS float* tv0 = W.tv + (2 * hd) * 16; const LAS float* tv1 = tv0 + 16; const LAS int* ti0 = W.ti + (2 * hd) * 16; const LAS int* ti1 = ti0 + 16;
        const int ij = W.ctab[63 - (int)(top2[u] & 63u)];
        const int i1 = (ij >> 4) & 15, j1 = ij & 15;
        const float vs = tv0[i1] + tv1[j1]; const int e = ti0[i1] * 128 + ti1[j1];
        const float mx = row_allmax_f(vs), ex = __expf(vs - mx), sm = row_allsum_f(ex);
        W.gate[hd * 16 + l15] = ex / sm; W.eid[hd * 16 + l15] = e;
    }
    LDS_WAIT(); __builtin_amdgcn_wave_barrier();
}
constexpr int P5_R = 9, P5_P = 8;
constexpr int P5_NSL = 16, P5_SLSH = 10;
#ifndef REP_TOPK
#define REP_TOPK 1
#endif
#ifndef REP_DS
#define REP_DS 1
#endif
constexpr int P5_WL2 = 20480;
struct SweepLds { LAS unsigned char* ring; LAS int* feid; LAS float* fcf; LAS float* raw; };
__device__ __forceinline__ int mbcnt64(unsigned long long m) { return __builtin_amdgcn_mbcnt_hi((unsigned)(m >> 32), __builtin_amdgcn_mbcnt_lo((unsigned)m, 0u)); }
template <int CTRL, int RM, bool BC> __device__ __forceinline__ int dpp_i(int v) { return __builtin_amdgcn_update_dpp(0, v, CTRL, RM, 0xf, BC); }
__device__ __forceinline__ float wave_total63(float v) {
    v += dpp_f<0x111, 0xf, true>(v); v += dpp_f<0x112, 0xf, true>(v); v += dpp_f<0x114, 0xf, true>(v); v += dpp_f<0x118, 0xf, true>(v);
    v += dpp_f<0x142, 0xa, false>(v); v += dpp_f<0x143, 0xc, false>(v); return v; }
__device__ __forceinline__ int wave_incl_scan(int v) {
    v += dpp_i<0x111, 0xf, true>(v); v += dpp_i<0x112, 0xf, true>(v); v += dpp_i<0x114, 0xf, true>(v); v += dpp_i<0x118, 0xf, true>(v);
    v += dpp_i<0x142, 0xa, false>(v); v += dpp_i<0x143, 0xc, false>(v); return v; }
#define P5_WRAP(x) ((x) + 1 == P5_R ? 0 : (x) + 1)
#define P5_ISSUE(tab, id_) do { const unsigned char* _gp = (tab) + (size_t)(id_) * ROWB + lane * 16; LAS unsigned char* _lp = L.ring + pslot * ROWB; \
    __builtin_amdgcn_global_load_lds((const unsigned*)_gp, (LAS unsigned*)_lp, 16, 0, 0);                         \
    if (lane < 32) __builtin_amdgcn_global_load_lds((const unsigned*)(_gp + 1024), (LAS unsigned*)(_lp + 1024), 16, 0, 0);     \
    pslot = P5_WRAP(pslot); } while (0)
#define P5_ROWREAD(dst_, slot_) do { const LAS unsigned char* _rp = L.ring + (slot_) * ROWB + lane * 24; const v2u _a = *(const LAS v2u*)_rp, _b = *(const LAS v2u*)(_rp + 8), _c = *(const LAS v2u*)(_rp + 16); \
    dst_ = (v6u){_a.x, _a.y, _b.x, _b.y, _c.x, _c.y}; } while (0)
#define P5_FEID(i_) __builtin_amdgcn_readfirstlane(L.feid[(i_) > 511 ? 511 : (i_)])
typedef _Float16 f16x32 __attribute__((ext_vector_type(32)));
typedef _Float16 f16x2v __attribute__((ext_vector_type(2)));
__device__ __forceinline__ void wave_total63x2(float& a, float& b) {
    a += dpp_f<0x111, 0xf, true>(a); b += dpp_f<0x111, 0xf, true>(b); a += dpp_f<0x112, 0xf, true>(a); b += dpp_f<0x112, 0xf, true>(b);
    a += dpp_f<0x114, 0xf, true>(a); b += dpp_f<0x114, 0xf, true>(b); a += dpp_f<0x118, 0xf, true>(a); b += dpp_f<0x118, 0xf, true>(b);
    a += dpp_f<0x142, 0xa, false>(a); b += dpp_f<0x142, 0xa, false>(b); a += dpp_f<0x143, 0xc, false>(a); b += dpp_f<0x143, 0xc, false>(b);
}
template <bool UP> __device__ __forceinline__ void p5_sweep(const SweepLds& L, const unsigned char* tab, unsigned (&hp)[4][16], int lenv0, int lenv1, int lane) {
    const LAS int* cbits = (const LAS int*)L.fcf;
    int pslot = 0, cslot = 2, idx = 0;
    for (int i = 0; i < P5_R; ++i) { const int id = P5_FEID(i); P5_ISSUE(tab, id); }
    int nv0 = L.feid[P5_R], nv1 = L.feid[P5_R + 1];
    asm volatile("s_waitcnt vmcnt(14)" ::: "memory");
    v6u ra, rb; P5_ROWREAD(ra, 0); P5_ROWREAD(rb, 1);
    int cav = 0, cbv = 0; if (UP) { cav = cbits[0]; cbv = cbits[1]; }
    for (int s = 0; s < P5_NSL; ++s) {
        const int lenv = s < 16 ? lenv0 : lenv1;
#pragma unroll
        for (int tok = 0; tok < 4; ++tok) {
            const int n = __builtin_amdgcn_readlane(lenv, (s & 15) * 4 + tok);
            int i = 0;
            for (; i + 1 < n; i += 2) {
                const f16x32 xa = __builtin_amdgcn_cvt_scalef32_pk32_f16_fp6(ra, 1.0f), xb = __builtin_amdgcn_cvt_scalef32_pk32_f16_fp6(rb, 1.0f);
                const f16x2v ca = __builtin_bit_cast(f16x2v, __builtin_amdgcn_readfirstlane(cav)), cb = __builtin_bit_cast(f16x2v, __builtin_amdgcn_readfirstlane(cbv));
                { const int id0 = __builtin_amdgcn_readfirstlane(nv0), id1 = __builtin_amdgcn_readfirstlane(nv1); P5_ISSUE(tab, id0); P5_ISSUE(tab, id1); }
                nv0 = L.feid[idx + 2 + P5_R > 511 ? 511 : idx + 2 + P5_R]; nv1 = L.feid[idx + 3 + P5_R > 511 ? 511 : idx + 3 + P5_R];
                if (UP) { cav = cbits[idx + 2 > 511 ? 511 : idx + 2]; cbv = cbits[idx + 3 > 511 ? 511 : idx + 3]; }
                asm volatile("s_waitcnt vmcnt(14)" ::: "memory");
                const int cs1 = P5_WRAP(cslot);
                P5_ROWREAD(ra, cslot); P5_ROWREAD(rb, cs1);
                cslot = P5_WRAP(cs1);
                __builtin_amdgcn_sched_barrier(0);
                if (!UP) {
                    float a0 = 0.f, a1 = 0.f, b0 = 0.f, b1 = 0.f;
#pragma unroll
                    for (int k = 0; k < 8; ++k) { const f16x2v h0 = __builtin_bit_cast(f16x2v, hp[tok][2 * k]), h1 = __builtin_bit_cast(f16x2v, hp[tok][2 * k + 1]);
                        a0 = __builtin_amdgcn_fdot2((f16x2v){xa[4 * k], xa[4 * k + 1]}, h0, a0, false); b0 = __builtin_amdgcn_fdot2((f16x2v){xb[4 * k], xb[4 * k + 1]}, h0, b0, false);
                        a1 = __builtin_amdgcn_fdot2((f16x2v){xa[4 * k + 2], xa[4 * k + 3]}, h1, a1, false); b1 = __builtin_amdgcn_fdot2((f16x2v){xb[4 * k + 2], xb[4 * k + 3]}, h1, b1, false); }
                    float ta = a0 + a1, tb = b0 + b1; wave_total63x2(ta, tb);
                    L.raw[idx] = __builtin_bit_cast(float, __builtin_amdgcn_readlane(__builtin_bit_cast(int, ta), 63));
                    L.raw[idx + 1] = __builtin_bit_cast(float, __builtin_amdgcn_readlane(__builtin_bit_cast(int, tb), 63));
                } else {
#pragma unroll
                    for (int k = 0; k < 16; ++k) hp[tok][k] = __builtin_bit_cast(unsigned, __builtin_elementwise_fma((f16x2v){xa[2 * k], xa[2 * k + 1]}, ca, __builtin_bit_cast(f16x2v, hp[tok][k])));
                    __builtin_amdgcn_sched_barrier(0);
#pragma unroll
                    for (int k = 0; k < 16; ++k) hp[tok][k] = __builtin_bit_cast(unsigned, __builtin_elementwise_fma((f16x2v){xb[2 * k], xb[2 * k + 1]}, cb, __builtin_bit_cast(f16x2v, hp[tok][k])));
                }
                idx += 2;
            }
            if (i < n) {
                const f16x32 xa = __builtin_amdgcn_cvt_scalef32_pk32_f16_fp6(ra, 1.0f);
                const f16x2v ca = __builtin_bit_cast(f16x2v, __builtin_amdgcn_readfirstlane(cav));
                ra = rb; cav = cbv;
                { const int id0 = __builtin_amdgcn_readfirstlane(nv0); P5_ISSUE(tab, id0); }
                nv0 = nv1; nv1 = L.feid[idx + 2 + P5_R > 511 ? 511 : idx + 2 + P5_R];
                if (UP) cbv = cbits[idx + 2 > 511 ? 511 : idx + 2];
                asm volatile("s_waitcnt vmcnt(14)" ::: "memory");
                P5_ROWREAD(rb, cslot);
                cslot = P5_WRAP(cslot);
                __builtin_amdgcn_sched_barrier(0);
                if (!UP) {
                    float a0 = 0.f, a1 = 0.f;
#pragma unroll
                    for (int k = 0; k < 8; ++k) { a0 = __builtin_amdgcn_fdot2((f16x2v){xa[4 * k], xa[4 * k + 1]}, __builtin_bit_cast(f16x2v, hp[tok][2 * k]), a0, false);
                        a1 = __builtin_amdgcn_fdot2((f16x2v){xa[4 * k + 2], xa[4 * k + 3]}, __builtin_bit_cast(f16x2v, hp[tok][2 * k + 1]), a1, false); }
                    const float ta = wave_total63(a0 + a1);
                    L.raw[idx] = __builtin_bit_cast(float, __builtin_amdgcn_readlane(__builtin_bit_cast(int, ta), 63));
                } else {
#pragma unroll
                    for (int k = 0; k < 16; ++k) hp[tok][k] = __builtin_bit_cast(unsigned, __builtin_elementwise_fma((f16x2v){xa[2 * k], xa[2 * k + 1]}, ca, __builtin_bit_cast(f16x2v, hp[tok][k])));
                }
                idx += 1;
            }
        }
    }
    asm volatile("s_waitcnt vmcnt(0)" ::: "memory");
}
__device__ __forceinline__ void p5_wave(LAS unsigned char* wl, const float* SC, const bf16* H2, const bf16* X1, const unsigned char* ED, const unsigned char* EU, const float* SD, const float* SU,
                                        const float* gf, float* out, int t0, int lane, const float* RSS) {
    SweepLds L; L.ring = wl; L.feid = (LAS int*)(wl + 14336); L.fcf = (LAS float*)(wl + 14336 + 2048); L.raw = (LAS float*)(wl + 14336 + 4096);
    { LAS int* ctab = (LAS int*)(wl + 14336); ctab[lane] = cand_pair(lane); }
    LDS_WAIT(); __builtin_amdgcn_wave_barrier();
    for (int rep_ = 0; rep_ < REP_TOPK; ++rep_)
    for (int tk = 0; tk < 4; ++tk) {
        WaveLds W; W.eid = (LAS int*)(wl + 1024 * tk); W.gate = (LAS float*)(wl + 1024 * tk + 512);
        W.sv = (LAS float*)(wl + 4096); W.tv = (LAS float*)(wl + 12288); W.ti = (LAS int*)(wl + 13312); W.ctab = (LAS int*)(wl + 14336);
        p5_topk_token(W, SC + (size_t)(t0 + 8 * tk) * 2048, lane);
    }
    int lenv0 = 0, lenv1 = 0;
#pragma unroll
    for (int tk = 0; tk < 4; ++tk) {
        const LAS int* ue = (const LAS int*)(wl + 1024 * tk); const int sl0 = ue[lane] >> P5_SLSH, sl1 = ue[lane + 64] >> P5_SLSH;
        for (int k = 0; k < P5_NSL; ++k) { const int c = __popcll(__ballot(sl0 == k)) + __popcll(__ballot(sl1 == k));
            if (lane == (k & 15) * 4 + tk) { if (k < 16) lenv0 = c; else lenv1 = c; } }
    }
    const int incl0 = wave_incl_scan(lenv0), tot0 = __builtin_amdgcn_readlane(incl0, 63);
    const int base0 = incl0 - lenv0, base1 = wave_incl_scan(lenv1) - lenv1 + tot0;
#pragma unroll
    for (int tk = 0; tk < 4; ++tk) {
        const LAS int* ue = (const LAS int*)(wl + 1024 * tk); const LAS float* ug = (const LAS float*)(wl + 1024 * tk + 512);
        const int e0 = ue[lane], e1 = ue[lane + 64], sl0 = e0 >> P5_SLSH, sl1 = e1 >> P5_SLSH; const float g0 = ug[lane], g1 = ug[lane + 64];
        int r0 = 0, r1 = 0;
        for (int k = 0; k < P5_NSL; ++k) { const unsigned long long m0 = __ballot(sl0 == k), m1 = __ballot(sl1 == k);
            if (sl0 == k) r0 = mbcnt64(m0);
            if (sl1 == k) r1 = __popcll(m0) + mbcnt64(m1); }
        const int b00 = __shfl(base0, (sl0 & 15) * 4 + tk), b01 = __shfl(base1, (sl0 & 15) * 4 + tk), b10 = __shfl(base0, (sl1 & 15) * 4 + tk), b11 = __shfl(base1, (sl1 & 15) * 4 + tk);
        const int p0 = (sl0 < 16 ? b00 : b01) + r0, p1 = (sl1 < 16 ? b10 : b11) + r1;
        L.feid[p0] = e0; L.fcf[p0] = g0; L.feid[p1] = e1; L.fcf[p1] = g1;
    }
    LDS_WAIT(); __builtin_amdgcn_wave_barrier();
    unsigned hp[4][16];
#pragma unroll
    for (int tk = 0; tk < 4; ++tk) {
        const float rs = __builtin_amdgcn_rsqf(__hip_atomic_load(RSS + t0 + 8 * tk, __ATOMIC_RELAXED, __HIP_MEMORY_SCOPE_AGENT) * (1.f / D) + EPS);
#pragma unroll
        for (int j = 0; j < 2; ++j)
#pragma unroll
            for (int p = 0; p < 2; ++p) { const v4u q = *(const v4u*)(H2 + (size_t)(t0 + 8 * tk) * D + j * 1024 + lane * 16 + 8 * p);
#pragma unroll
                for (int e = 0; e < 4; ++e) { const f16x2v h = {(_Float16)(bflo(q[e]) * rs), (_Float16)(bfhi(q[e]) * rs)}; hp[tk][8 * j + 4 * p + e] = __builtin_bit_cast(unsigned, h); } }
    }
    asm volatile("s_waitcnt vmcnt(0)" ::: "memory");
    for (int rep_ = 0; rep_ < REP_DS; ++rep_) p5_sweep<false>(L, ED, hp, lenv0, lenv1, lane);
    LDS_WAIT(); __builtin_amdgcn_wave_barrier();
    float cmax = 0.f;
#pragma unroll 1
    for (int i = lane; i < 512; i += 64) { const int id = L.feid[i]; const float c = gelu_erf(L.raw[i] * SD[id]) * L.fcf[i] * SU[id]; L.fcf[i] = c; cmax = fmaxf(cmax, fabsf(c)); }
#pragma unroll
    for (int o = 1; o < 64; o <<= 1) cmax = fmaxf(cmax, __shfl_xor(cmax, o));
    { const float cinv = cmax > 0.f ? 1.f / cmax : 0.f;
#pragma unroll 1
      for (int i = lane; i < 512; i += 64) { const _Float16 h = (_Float16)(L.fcf[i] * cinv); ((LAS unsigned*)L.fcf)[i] = __builtin_bit_cast(unsigned, (f16x2v){h, h}); } }
    LDS_WAIT(); __builtin_amdgcn_wave_barrier();
    asm volatile("s_waitcnt vmcnt(0)" ::: "memory");
#pragma unroll
    for (int tk = 0; tk < 4; ++tk)
#pragma unroll
        for (int q = 0; q < 16; ++q) hp[tk][q] = 0u;
    p5_sweep<true>(L, EU, hp, lenv0, lenv1, lane);
    int le = lane; asm volatile("" : "+v"(le));
#pragma unroll
    for (int tk = 0; tk < 4; ++tk) {
        const size_t ro = (size_t)(t0 + 8 * tk) * D; float ss = 0.f; float st[32];
#pragma unroll
        for (int j = 0; j < 2; ++j)
#pragma unroll
            for (int q = 0; q < 2; ++q) { const v4u xa = __builtin_nontemporal_load((const v4u*)(X1 + ro + j * 1024 + le * 16 + 8 * q));
#pragma unroll
                for (int c = 0; c < 4; ++c) { const int k = 16 * j + 8 * q + 2 * c; const f16x2v a = __builtin_bit_cast(f16x2v, hp[tk][k >> 1]);
                    st[k] = (float)a.x * cmax + bflo(xa[c]); st[k + 1] = (float)a.y * cmax + bfhi(xa[c]); ss += st[k] * st[k] + st[k + 1] * st[k + 1]; } }
        const float r = rsqrtf(wave_sum(ss) * (1.f / D) + EPS);
#pragma unroll
        for (int j = 0; j < 2; ++j)
#pragma unroll
            for (int q = 0; q < 4; ++q) { const f32x4 g = *(const f32x4*)(gf + j * 1024 + le * 16 + 4 * q); f32x4 a;
#pragma unroll
                for (int c = 0; c < 4; ++c) a[c] = st[16 * j + 4 * q + c] * r * g[c];
                __builtin_nontemporal_store(a, (f32x4*)(out + ro + j * 1024 + le * 16 + 4 * q)); }
    }
}
__device__ __forceinline__ void p5_peer(const Ctx& F, const float* SC, const bf16* H2, const bf16* X1, const unsigned char* ED, const unsigned char* EU, const float* SD, const float* SU, const float* gf, float* out, const float* RSS) {
    for (int tile = F.bid; tile < T / P5_TOK; tile += F.G)
        p5_wave(F.lds + F.wave * P5_WL2, SC, H2, X1, ED, EU, SD, SU, gf, out, tile * P5_TOK + F.wave, F.lane, RSS);
}

struct Args { const float* in[15]; float* out; unsigned char* ws; };
__global__ void __launch_bounds__(NTHR, 2) mega_fwd(Args args) {
    extern __shared__ __attribute__((aligned(16))) unsigned char lds_raw[];
    Ctx F; F.lds = (LAS unsigned char*)lds_raw; F.tid = threadIdx.x; F.lane = F.tid & 63; F.wave = __builtin_amdgcn_readfirstlane(F.tid >> 6); F.G = gridDim.x; F.bid = blockIdx.x;
    volatile LAS unsigned* MISC = (volatile LAS unsigned*)(F.lds + MISC_OFF);
    unsigned char* ws = args.ws; unsigned* ctl = (unsigned*)(ws + WS_CTL);
    const float* x = args.in[0]; const float* norm1_g = args.in[1]; const float* w_in = args.in[2]; const float* sgu_ln_g = args.in[3]; const float* sgu_ln_b = args.in[4];
    const float* w_spatial = args.in[5]; const float* b_spatial = args.in[6]; const float* attn_sinks = args.in[7]; const float* w_out = args.in[8]; const float* norm2_g = args.in[9];
    const float* w_query = args.in[10]; const float* sub_keys = args.in[11]; const float* expert_down = args.in[12]; const float* expert_up = args.in[13]; const float* norm_f_g = args.in[14];
    bf16* WinT = (bf16*)(ws + WS_WIN); bf16* WoutT = (bf16*)(ws + WS_WOUT); bf16* WeffT = (bf16*)(ws + WS_WEFF); bf16* H = (bf16*)(ws + WS_H);
    bf16* Z = (bf16*)(ws + WS_Z); bf16* MIX = (bf16*)(ws + WS_MIX); bf16* X1 = (bf16*)(ws + WS_X1); float* SC = (float*)(ws + WS_SC);
    unsigned char* ED = ws + WS_ED; unsigned char* EU = ws + WS_EU; float* SD = (float*)(ws + WS_SD); float* SU = (float*)(ws + WS_SU); float* RSS = (float*)(ws + WS_RSS);
    for (int u = F.tid; u < (LDS_BYTES - LDSCTL_OFF) / 4; u += NTHR) ((LAS unsigned*)(F.lds + LDSCTL_OFF))[u] = 0u;
    __syncthreads();
    XcdBarrier bar = xcd_barrier_post(ctl + CW_BAR, MISC + 8);

    for (int rep = 0; rep < REP_P0; ++rep) p0_prologue(F, x, norm1_g, w_in, w_out, w_query, sub_keys, expert_down, expert_up, WinT, WoutT, WeffT, H, ED, EU, SD, SU, RSS);
    xcd_barrier(bar);
    for (int rep_ = 0; rep_ < REP_P1; ++rep_)
    {   pg8::Gemm g{H, WinT, T, NIN, D}; pg8::StaticOrder S; S.init(T, NIN, F.G, F.bid);
        pg8::EpiZ E{Z, NIN, 8};
        pg8::gemm_phase<pg8::EpiZ, pg8::StaticOrder, true, true>(F.lds + RING_OFF, g, S, E); }
    {
        const int nU = (T / 256) * (NIN / 256), maxu = (nU + F.G - 1) / F.G, nfull = nU - (maxu - 1) * F.G;
        const bool all = nfull == F.G; const int nidle = all ? F.G : F.G - nfull, q = all ? F.bid : F.bid - nfull;
        if (q >= 0) convert_rows(expert_down, expert_up, ED, EU, SD, SU, CONV_SPLIT, 2 * NE, q * NWAVES + F.wave, nidle * NWAVES, F.lane);
    }
    xcd_barrier(bar);
    for (int rep = 0; rep < REP_P2; ++rep) { p2_sgu(F, Z, sgu_ln_g, sgu_ln_b, w_spatial, b_spatial, MIX); p2_attn(F, Z, attn_sinks, MIX); }
    xcd_barrier(bar);
    {   pg8::Gemm g{MIX, WoutT, T, D, D}; pg8::StaticOrder S; S.init(T, D, F.G, F.bid);
        pg8::EpiX1 E{x, X1, H, norm2_g, RSS, D};
        pg8::gemm_phase<pg8::EpiX1, pg8::StaticOrder, true, true>(F.lds + RING_OFF, g, S, E); }
    xcd_barrier(bar);
    {   pg8::Gemm g{H, WeffT, T, D, D}; pg8::StaticOrder S; S.init(T, D, F.G, F.bid);
        pg8::EpiRowScale E{SC, RSS, D, 1.f / D, EPS};
        pg8::gemm_phase<pg8::EpiRowScale, pg8::StaticOrder, true, true>(F.lds + RING_OFF, g, S, E); }
    xcd_barrier(bar);
    for (int rep = 0; rep < REP_P5; ++rep) p5_peer(F, SC, H, X1, ED, EU, SD, SU, norm_f_g, args.out, RSS);
}

extern "C" void kernel_launch(void* const* d_in, const int* in_sizes, int n_in, void* d_out, int out_size, void* d_ws, size_t ws_size, hipStream_t stream) {
    static int grid = 0;
    if (grid == 0) {
        if (n_in != 15 || ws_size < WS_END) { fprintf(stderr, "kernel_launch: unexpected inputs / workspace\n"); grid = -1; return; }
        int dev = 0, cus = 0, per_cu = 0;
        if (hipGetDevice(&dev) != hipSuccess || hipDeviceGetAttribute(&cus, hipDeviceAttributeMultiprocessorCount, dev) != hipSuccess) { grid = -1; return; }
        if (hipFuncSetAttribute((const void*)mega_fwd, hipFuncAttributeMaxDynamicSharedMemorySize, LDS_BYTES) != hipSuccess) { fprintf(stderr, "kernel_launch: hipFuncSetAttribute failed\n"); grid = -1; return; }
        if (hipOccupancyMaxActiveBlocksPerMultiprocessor(&per_cu, (const void*)mega_fwd, NTHR, LDS_BYTES) != hipSuccess || per_cu < 1)
            fprintf(stderr, "kernel_launch: note: occupancy query reports %d workgroups per CU\n", per_cu);
        (void)hipGetLastError();
        grid = cus;
    }
    if (grid < 0) return;
    if (hipMemsetAsync((char*)d_ws + WS_CTL, 0, CTL_ZERO_BYTES, stream) != hipSuccess) return;
    Args a{};
    for (int i = 0; i < 15; ++i) a.in[i] = (const float*)d_in[i];
    a.out = (float*)d_out; a.ws = (unsigned char*)d_ws;
    hipLaunchKernelGGL(mega_fwd, dim3(grid), dim3(NTHR), LDS_BYTES, stream, a);
}
```

```cpp
#include <hip/hip_runtime.h>
#include <cstdio>
#include <cstdint>
#include <math.h>
namespace pg8 {
#define PG8_LAS __attribute__((address_space(3)))
typedef unsigned short bf16_t;
typedef short bf16x8 __attribute__((ext_vector_type(8)));
typedef float f32x4 __attribute__((ext_vector_type(4)));
typedef unsigned u32x4 __attribute__((ext_vector_type(4)));
constexpr int BM = 256, BK = 64, HALF = 128, HTB = HALF * BK * 2  , STAGE_BYTES = 8 * HTB, NXCD = 8, WGM = 8;

__host__ __device__ __forceinline__ int lds_byte(int r, int c) { const int st = (r >> 4) * 2 + (c >> 5), rr = r & 15, cc = c & 31, ob = rr * 64 + cc * 2; return st * 1024 + (ob ^ (((ob >> 9) & 1) << 5)); }
__host__ __device__ __forceinline__ void stage_rc(int b, int& R, int& C) { const int st = b / 1024, sb = b % 1024, swz = sb ^ (((sb >> 9) & 1) << 5); R = (st >> 1) * 16 + swz / 64; C = (st & 1) * 32 + (swz % 64) / 2; }
__host__ __device__ __forceinline__ int perm32(int rho) { const int n = rho >> 4, i = rho & 15; return 8 * (i >> 2) + 4 * n + (i & 3); }

struct Unit { int pm, pn; };
struct Gemm { const bf16_t* A; const bf16_t* Bt; int M, N, K; };

struct StaticOrder {
    int nM, nN, nwg, G, c;
    __host__ __device__ void init(int M, int N, int G_, int c_) { nM = M / BM; nN = N / BM; nwg = nM * nN; G = G_; c = c_; }
    __host__ __device__ bool next(int i, Unit& u) const {
        const long L = (long)i * G + c; if (L >= nwg) return false;
        int wgid = (int)L; { const int q = nwg / NXCD, r = nwg % NXCD, xcd = wgid % NXCD, off = wgid / NXCD; wgid = (xcd < r ? xcd * (q + 1) : r * (q + 1) + (xcd - r) * q) + off; }
        const int nig = WGM * nN, gid = wgid / nig, fm = gid * WGM, gsz = (nM - fm) < WGM ? (nM - fm) : WGM;
        u.pm = fm + ((wgid % nig) % gsz); u.pn = (wgid % nig) / gsz; return true;
    }
    __device__ __forceinline__ void a_ready(const Unit&) const {}
    __device__ __forceinline__ void done(const Unit&) const {}
};

__device__ __forceinline__ unsigned cvt_pk_bf16(float lo, float hi) { unsigned r; asm volatile("v_cvt_pk_bf16_f32 %0, %1, %2" : "=v"(r) : "v"(lo), "v"(hi)); return r; }
typedef float f32x2 __attribute__((ext_vector_type(2)));
__device__ __forceinline__ f32x2 gelu_pk(f32x2 v) {
    const f32x2 av = __builtin_elementwise_abs(v), d = av * 0.2316418882f + 1.0f;
    f32x2 t; t.x = __builtin_amdgcn_rcpf(d.x); t.y = __builtin_amdgcn_rcpf(d.y);
    f32x2 q = t * 0.5307027145f + (-0.7265760135f); q = q * t + 0.7107068705f; q = q * t + (-0.142248368f); q = q * t + 0.127414796f; q = q * t;
    const f32x2 s = (v * v) * (-0.72134752044f);
    f32x2 e; e.x = __builtin_amdgcn_exp2f(s.x); e.y = __builtin_amdgcn_exp2f(s.y);
    const f32x2 m = v * (q * e), r = v - m;
    f32x2 o; o.x = v.x < 0.f ? m.x : r.x; o.y = v.y < 0.f ? m.y : r.y; return o;
}
struct EpiZ {
    static constexpr bool PERM = true, AFTER_DRAIN = false;
    bf16_t* O; int ldc; int gelu_tiles;
    __device__ __forceinline__ void operator()(const f32x4 (&acc)[2][2][4][2], const Unit& u, int wr, int wc, int fr, int fq) const {
        const int row0 = u.pm * BM + wr * 64 + fr, col0 = u.pn * BM + wc * 32 + 8 * fq;
        const bool act = u.pn < gelu_tiles;
#pragma unroll
        for (int ai = 0; ai < 2; ++ai)
#pragma unroll
            for (int m = 0; m < 4; ++m) { bf16_t* rowp = O + (size_t)(row0 + ai * HALF + m * 16) * ldc + col0;
#pragma unroll
                for (int bj = 0; bj < 2; ++bj) { f32x4 v0 = acc[ai][bj][m][0], v1 = acc[ai][bj][m][1];
                    if (act) { f32x2 a = gelu_pk((f32x2){v0[0], v0[1]}), b = gelu_pk((f32x2){v0[2], v0[3]}), c = gelu_pk((f32x2){v1[0], v1[1]}), d = gelu_pk((f32x2){v1[2], v1[3]});
                        v0 = (f32x4){a.x, a.y, b.x, b.y}; v1 = (f32x4){c.x, c.y, d.x, d.y}; }
                    u32x4 w; w.x = cvt_pk_bf16(v0[0], v0[1]); w.y = cvt_pk_bf16(v0[2], v0[3]); w.z = cvt_pk_bf16(v1[0], v1[1]); w.w = cvt_pk_bf16(v1[2], v1[3]);
                    *(u32x4*)(rowp + bj * HALF) = w; } }
    }
};
template <bool RES> struct EpiF32 {
    static constexpr bool PERM = false, AFTER_DRAIN = false;
    const float* base; float* C; int ldc;
    __device__ __forceinline__ void operator()(const f32x4 (&acc)[2][2][4][2], const Unit& u, int wr, int wc, int fr, int fq) const {
        const int row0 = u.pm * BM + wr * 64 + fr, col0 = u.pn * BM + wc * 32 + 4 * fq;
#pragma unroll
        for (int ai = 0; ai < 2; ++ai)
#pragma unroll
            for (int m = 0; m < 4; ++m) { const size_t off = (size_t)(row0 + ai * HALF + m * 16) * ldc + col0;
#pragma unroll
                for (int bj = 0; bj < 2; ++bj)
#pragma unroll
                    for (int n = 0; n < 2; ++n) { const size_t o = off + bj * HALF + n * 16; f32x4 v = acc[ai][bj][m][n];
                        if (RES) v = v + *(const f32x4*)(base + o);
                        *(f32x4*)(C + o) = v; } }
    }
};
struct EpiX1 {
    static constexpr bool PERM = false, AFTER_DRAIN = false;
    const float* base; bf16_t* X1; int ldc;
    __device__ __forceinline__ void init(f32x4 (&acc)[2][2][4][2], const Unit& u, int wr, int wc, int fr, int fq) const {
        const int row0 = u.pm * BM + wr * 64 + fr, col0 = u.pn * BM + wc * 32 + 4 * fq;
#pragma unroll
        for (int ai = 0; ai < 2; ++ai)
#pragma unroll
            for (int m = 0; m < 4; ++m) { const size_t off = (size_t)(row0 + ai * HALF + m * 16) * ldc + col0;
#pragma unroll
                for (int bj = 0; bj < 2; ++bj)
#pragma unroll
                    for (int n = 0; n < 2; ++n) acc[ai][bj][m][n] = *(const f32x4*)(base + off + bj * HALF + n * 16); }
    }
    __device__ __forceinline__ void operator()(const f32x4 (&acc)[2][2][4][2], const Unit& u, int wr, int wc, int fr, int fq) const {
        const int row0 = u.pm * BM + wr * 64 + fr, col0 = u.pn * BM + wc * 32 + 4 * fq;
        typedef __bf16 bf2 __attribute__((ext_vector_type(2)));
        typedef unsigned u2 __attribute__((ext_vector_type(2)));
#pragma unroll
        for (int ai = 0; ai < 2; ++ai)
#pragma unroll
            for (int m = 0; m < 4; ++m) { const size_t off = (size_t)(row0 + ai * HALF + m * 16) * ldc + col0;
#pragma unroll
                for (int bj = 0; bj < 2; ++bj)
#pragma unroll
                    for (int n = 0; n < 2; ++n) { const f32x4 v = acc[ai][bj][m][n]; const f32x2 lo = {v[0], v[1]}, hi = {v[2], v[3]};
                        u2 pk; pk.x = __builtin_bit_cast(unsigned, __builtin_convertvector(lo, bf2)); pk.y = __builtin_bit_cast(unsigned, __builtin_convertvector(hi, bf2));
                        *(u2*)(X1 + off + bj * HALF + n * 16) = pk; } }
    }
};
template <class Epi, class Sched, bool ALIGN_EPI = false, bool SP2 = false, bool PRE = false>
__device__ __forceinline__ void gemm_phase_acc(PG8_LAS unsigned char* lds, const Gemm g, const Sched& S, const Epi& E, f32x4 (&acc)[2][2][4][2]) {
    const int tid = threadIdx.x, wid = __builtin_amdgcn_readfirstlane(tid >> 6), lane = tid & 63, wr = wid >> 2, wc = wid & 3, fr = lane & 15, fq = lane >> 4;
    const int K = g.K, nt = K / BK;
    unsigned voffA[2], voffB[2];
#pragma unroll
    for (int i = 0; i < 2; ++i) { int R, C; stage_rc(tid * 16 + i * 8192, R, C); const int Rb = Epi::PERM ? ((R & ~31) + perm32(R & 31)) : R;
        voffA[i] = (unsigned)(R * K + C) * 2u; voffB[i] = (unsigned)(Rb * K + C) * 2u; }
    const size_t kstep = (size_t)(BK * 2);
    const size_t hstep = (size_t)HALF * K * 2;
    const size_t tstep = 2 * hstep;
    const unsigned ldsw = (unsigned)wid * 1024u;
    const int aoff = lds_byte(wr * 64 + fr, fq * 8), boff = lds_byte(wc * 32 + fr, fq * 8);
#define PG8_SA(b, h) (((b) * 2 + (h)) * HTB)
#define PG8_SB(b, h) ((4 + (b) * 2 + (h)) * HTB)
#define PG8_STAGE(bufoff, gbase, voff) do { _Pragma("unroll") for (int _i = 0; _i < 2; ++_i) \
        __builtin_amdgcn_global_load_lds((const unsigned*)((const char*)(gbase) + (voff)[_i]), (PG8_LAS unsigned*)(lds + (bufoff) + ldsw + _i * 8192), 16, 0, 0); } while (0)
#define PG8_LDA(dst, b, h) do { _Pragma("unroll") for (int m = 0; m < 4; ++m) _Pragma("unroll") for (int k = 0; k < 2; ++k) dst[m][k] = *(const PG8_LAS bf16x8*)(lds + PG8_SA(b, h) + aoff + m * 2048 + k * 1024); } while (0)
#define PG8_LDB(dst, b, h) do { _Pragma("unroll") for (int n = 0; n < 2; ++n) _Pragma("unroll") for (int k = 0; k < 2; ++k) dst[n][k] = *(const PG8_LAS bf16x8*)(lds + PG8_SB(b, h) + boff + n * 2048 + k * 1024); } while (0)
#define PG8_MMA(ai, bj, At, Bt) do { __builtin_amdgcn_s_setprio(1); _Pragma("unroll") for (int m = 0; m < 4; ++m) _Pragma("unroll") for (int n = 0; n < 2; ++n) _Pragma("unroll") for (int k = 0; k < 2; ++k) \
        acc[ai][bj][m][n] = __builtin_amdgcn_mfma_f32_16x16x32_bf16(Bt[n][k], At[m][k], acc[ai][bj][m][n], 0, 0, 0); __builtin_amdgcn_s_setprio(0); } while (0)
#define PG8_WAIT_V(n) asm volatile("s_waitcnt vmcnt(" #n ")" ::: "memory")
#define PG8_WAIT_L(n) asm volatile("s_waitcnt lgkmcnt(" #n ")" ::: "memory")
#define PG8_BAR __builtin_amdgcn_s_barrier()
#define PG8_SCHED __builtin_amdgcn_sched_barrier(0)
    Unit cur, nxt; int ui = 0;
    if (!S.next(0, cur)) return;
    if constexpr (!PRE) {
#pragma unroll
    for (int a = 0; a < 2; ++a)
#pragma unroll
        for (int b = 0; b < 2; ++b)
#pragma unroll
            for (int m = 0; m < 4; ++m)
#pragma unroll
                for (int n = 0; n < 2; ++n) acc[a][b][m][n] = (f32x4){0.f, 0.f, 0.f, 0.f};
    }
    bf16x8 At[4][2], B0[2][2], B1[2][2];
    const char* cA = (const char*)g.A + (size_t)cur.pm * tstep; const char* cB = (const char*)g.Bt + (size_t)cur.pn * tstep;
    S.a_ready(cur);
    if constexpr (SP2) {
        PG8_STAGE(PG8_SB(0, 0), cB, voffB); PG8_STAGE(PG8_SB(0, 1), cB + hstep, voffB); PG8_STAGE(PG8_SA(0, 0), cA, voffA); PG8_STAGE(PG8_SA(0, 1), cA + hstep, voffA);
        if (wr == 1) PG8_BAR;
        PG8_WAIT_V(2); PG8_BAR;
        PG8_STAGE(PG8_SB(1, 0), cB + kstep, voffB); PG8_STAGE(PG8_SA(1, 0), cA + kstep, voffA); PG8_STAGE(PG8_SB(1, 1), cB + hstep + kstep, voffB);
        PG8_WAIT_V(6); PG8_BAR;
    } else {
        PG8_STAGE(PG8_SB(0, 0), cB, voffB); PG8_STAGE(PG8_SA(0, 0), cA, voffA); PG8_STAGE(PG8_SB(0, 1), cB + hstep, voffB); PG8_STAGE(PG8_SA(0, 1), cA + hstep, voffA);
        if (wr == 1) PG8_BAR;
        PG8_WAIT_V(4); PG8_BAR;
        PG8_STAGE(PG8_SB(1, 0), cB + kstep, voffB); PG8_STAGE(PG8_SA(1, 0), cA + kstep, voffA); PG8_STAGE(PG8_SB(1, 1), cB + hstep + kstep, voffB);
        PG8_WAIT_V(6); PG8_BAR;
    }
    for (;;) {
        const bool has_next = S.next(ui + 1, nxt);
        const char* nA = has_next ? (const char*)g.A + (size_t)nxt.pm * tstep : cA; const char* nB = has_next ? (const char*)g.Bt + (size_t)nxt.pn * tstep : cB;
        for (int t = 0; t < nt; t += 2) {
            const bool last = (t == nt - 2);
            const char* a1 = cA + (size_t)(t + 1) * kstep;
            const char* a2 = last ? nA : cA + (size_t)(t + 2) * kstep; const char* b2 = last ? nB : cB + (size_t)(t + 2) * kstep;
            const char* a3 = a2 + kstep; const char* b3 = b2 + kstep;
            if (last && has_next) S.a_ready(nxt);
            if constexpr (SP2) {
            PG8_LDB(B0, 0, 0); PG8_LDB(B1, 0, 1); PG8_SCHED; PG8_LDA(At, 0, 0); PG8_STAGE(PG8_SA(1, 1), a1 + hstep, voffA);
            PG8_WAIT_V(8); PG8_WAIT_L(0); PG8_BAR; PG8_MMA(0, 0, At, B0); PG8_MMA(0, 1, At, B1); PG8_BAR; PG8_SCHED;
            PG8_LDA(At, 0, 1); PG8_STAGE(PG8_SB(0, 0), b2, voffB); PG8_STAGE(PG8_SB(0, 1), b2 + hstep, voffB); PG8_STAGE(PG8_SA(0, 0), a2, voffA);
            PG8_WAIT_V(8); PG8_WAIT_L(0); PG8_BAR; PG8_MMA(1, 0, At, B0); PG8_MMA(1, 1, At, B1); PG8_BAR; PG8_SCHED;
            PG8_LDB(B0, 1, 0); PG8_LDB(B1, 1, 1); PG8_SCHED; PG8_LDA(At, 1, 0); PG8_STAGE(PG8_SA(0, 1), a2 + hstep, voffA);
            PG8_WAIT_V(8); PG8_WAIT_L(0); PG8_BAR; PG8_MMA(0, 0, At, B0); PG8_MMA(0, 1, At, B1); PG8_BAR; PG8_SCHED;
            PG8_LDA(At, 1, 1); PG8_STAGE(PG8_SB(1, 0), b3, voffB); PG8_STAGE(PG8_SB(1, 1), b3 + hstep, voffB); PG8_STAGE(PG8_SA(1, 0), a3, voffA);
            PG8_WAIT_V(8); PG8_WAIT_L(0); PG8_BAR; PG8_MMA(1, 0, At, B0); PG8_MMA(1, 1, At, B1); PG8_BAR; PG8_SCHED;
            } else {
            PG8_LDB(B0, 0, 0); PG8_SCHED; PG8_LDA(At, 0, 0); PG8_STAGE(PG8_SA(1, 1), a1 + hstep, voffA);
            PG8_WAIT_L(8); PG8_BAR; PG8_WAIT_L(0); PG8_MMA(0, 0, At, B0); PG8_BAR; PG8_SCHED;
            PG8_LDB(B1, 0, 1); PG8_STAGE(PG8_SB(0, 0), b2, voffB);
            PG8_BAR; PG8_WAIT_L(0); PG8_MMA(0, 1, At, B1); PG8_BAR;
            PG8_LDA(At, 0, 1); PG8_STAGE(PG8_SA(0, 0), a2, voffA);
            PG8_BAR; PG8_WAIT_L(0); PG8_MMA(1, 0, At, B0); PG8_BAR; PG8_SCHED;
            PG8_STAGE(PG8_SB(0, 1), b2 + hstep, voffB);
            PG8_WAIT_V(6); PG8_BAR; PG8_MMA(1, 1, At, B1); PG8_BAR;
            PG8_LDB(B0, 1, 0); PG8_SCHED; PG8_LDA(At, 1, 0); PG8_STAGE(PG8_SA(0, 1), a2 + hstep, voffA);
            PG8_WAIT_L(8); PG8_BAR; PG8_WAIT_L(0); PG8_MMA(0, 0, At, B0); PG8_BAR; PG8_SCHED;
            PG8_LDB(B1, 1, 1); PG8_STAGE(PG8_SB(1, 0), b3, voffB);
            PG8_BAR; PG8_WAIT_L(0); PG8_MMA(0, 1, At, B1); PG8_BAR;
            PG8_LDA(At, 1, 1); PG8_STAGE(PG8_SA(1, 0), a3, voffA);
            PG8_BAR; PG8_WAIT_L(0); PG8_MMA(1, 0, At, B0); PG8_BAR; PG8_SCHED;
            PG8_STAGE(PG8_SB(1, 1), b3 + hstep, voffB);
            PG8_WAIT_V(6); PG8_BAR; PG8_MMA(1, 1, At, B1); PG8_BAR;
            }
        }
        if constexpr (ALIGN_EPI) { if (wr == 0) PG8_BAR; }
        if constexpr (!Epi::AFTER_DRAIN) { E(acc, cur, wr, wc, fr, fq); S.done(cur); }
        if (!has_next) break;
        if constexpr (PRE) E.init(acc, nxt, wr, wc, fr, fq);
        else {
#pragma unroll
        for (int a = 0; a < 2; ++a)
#pragma unroll
            for (int b = 0; b < 2; ++b)
#pragma unroll
                for (int m = 0; m < 4; ++m)
#pragma unroll
                    for (int n = 0; n < 2; ++n) acc[a][b][m][n] = (f32x4){0.f, 0.f, 0.f, 0.f};
        }
        cur = nxt; cA = nA; cB = nB; ++ui;
        if constexpr (ALIGN_EPI) { if (wr == 1) PG8_BAR; }
    }
    PG8_WAIT_V(0);
    if constexpr (!ALIGN_EPI) { if (wr == 0) PG8_BAR; }
    PG8_BAR;
    if constexpr (Epi::AFTER_DRAIN) { E.fused(acc, cur, wr, wc, fr, fq, lds, wid, lane); S.done(cur); }
#undef PG8_SA
#undef PG8_SB
#undef PG8_STAGE
#undef PG8_LDA
#undef PG8_LDB
#undef PG8_MMA
#undef PG8_WAIT_V
#undef PG8_WAIT_L
#undef PG8_BAR
#undef PG8_SCHED
}
template <class Epi, class Sched, bool ALIGN_EPI = false, bool SP2 = false>
__device__ __forceinline__ void gemm_phase(PG8_LAS unsigned char* lds, const Gemm g, const Sched& S, const Epi& E) { f32x4 acc[2][2][4][2]; gemm_phase_acc<Epi, Sched, ALIGN_EPI, SP2, false>(lds, g, S, E, acc); }
}
#ifndef REP_P5
#define REP_P5 1
#endif
#ifndef REP_P0
#define REP_P0 1
#endif
#ifndef REP_P1
#define REP_P1 1
#endif
#ifndef REP_P4
#define REP_P4 1
#endif
#ifndef REP_P0B
#define REP_P0B 1
#endif
#ifndef REP_P0C
#define REP_P0C 1
#endif
#ifndef REP_P2
#define REP_P2 1
#endif
constexpr int T = 8192, D = 2048, NIN = 3328, SEQ = 2048, NE = 16384;
constexpr float EPS = 1e-6f;
constexpr int NWAVES = 8, NTHR = 512;
constexpr size_t MiB = 1u << 20;
constexpr size_t WS_CTL = 0, CTL_ZERO_BYTES = 1 * MiB;
constexpr size_t WS_WIN = 2 * MiB;
constexpr size_t WS_WOUT = 16 * MiB;
constexpr size_t WS_WEFF = 24 * MiB;
constexpr size_t WS_H = 32 * MiB;
constexpr size_t WS_Z = 64 * MiB;
constexpr size_t WS_MIX = 116 * MiB;
constexpr size_t WS_X1 = 148 * MiB;
constexpr size_t WS_SC = 212 * MiB;
constexpr size_t WS_ED = 284 * MiB;
constexpr size_t WS_EU = 316 * MiB;
constexpr int ROWB = 1536;
constexpr size_t WS_SD = 348 * MiB;
constexpr size_t WS_SU = 348 * MiB + 65536;
constexpr size_t WS_TP = 348 * MiB + 196608;
constexpr size_t WS_END = 349 * MiB;
constexpr int CW_TMO = 0, CW_BAR = 4096;
constexpr int RING_OFF = 0, RING_BYTES = 131072;
constexpr int LDSCTL_OFF = RING_BYTES, MISC_OFF = LDSCTL_OFF + 320;
constexpr int LDS_BYTES = 163840;

#define GAS __attribute__((address_space(1)))
#define LAS __attribute__((address_space(3)))
typedef unsigned short bf16;
typedef unsigned v4u __attribute__((ext_vector_type(4)));
typedef unsigned v2u __attribute__((ext_vector_type(2)));
typedef float f32x4 __attribute__((ext_vector_type(4)));
typedef GAS unsigned gu32;
#define LDS_WAIT() asm volatile("s_waitcnt lgkmcnt(0)" ::: "memory")
#define VM_WAIT() asm volatile("s_waitcnt vmcnt(0)" ::: "memory")
__device__ __forceinline__ unsigned f2bf(float f) { unsigned u = __builtin_bit_cast(unsigned, f); return (u + 0x7fffu + ((u >> 16) & 1u)) >> 16; }
__device__ __forceinline__ unsigned pk2(float lo, float hi) { return f2bf(lo) | (f2bf(hi) << 16); }
__device__ __forceinline__ float bf2f(bf16 h) { return __uint_as_float(((unsigned)h) << 16); }
__device__ __forceinline__ float bflo(unsigned w) { return __uint_as_float(w << 16); }
__device__ __forceinline__ float bfhi(unsigned w) { return __uint_as_float(w & 0xffff0000u); }
__device__ __forceinline__ float gelu_erf(float v) { return 0.5f * v * (1.0f + erff(v * 0.70710678118654752f)); }
__device__ __forceinline__ float wave_sum(float v) {
#pragma unroll
    for (int o = 1; o < 64; o <<= 1) v += __shfl_xor(v, o);
    return v;
}

#define XB_TMO      128
#define XB_XCNT(j)  (256  + 64 * (j))
#define XB_XSUB(j)  (1280 + 64 * (j))
#define XB_XGEN(j)  (2304 + 64 * (j))
#define XB_TOP      3328
#define XB_TOPGEN   3392
#define XCD_BAR_WORDS 3456
#define XB_SPIN_CAP (1u << 18)

__device__ __forceinline__ unsigned xb_ld(unsigned* p)              { return __hip_atomic_load(p, __ATOMIC_RELAXED, __HIP_MEMORY_SCOPE_AGENT); }
__device__ __forceinline__ unsigned xb_add(unsigned* p, unsigned v) { return __hip_atomic_fetch_add(p, v, __ATOMIC_RELAXED, __HIP_MEMORY_SCOPE_AGENT); }
__device__ __forceinline__ unsigned xb_xcc_id() { return (unsigned)__builtin_amdgcn_s_getreg((3 << 11) | 20) & 0xFu; }
#define XB_SPIN(cond, bar) do { unsigned _sp = 0; while (cond) { __builtin_amdgcn_s_sleep(1); \
    if ((++_sp & 255u) == 0u) { if (xb_ld(&(bar)[XB_TMO])) break; if (_sp > XB_SPIN_CAP) { atomicAdd(&(bar)[XB_TMO], 1u); break; } } } } while (0)

struct XcdBarrier {
    unsigned* bar; unsigned x;
    volatile LAS unsigned* st;
};

__device__ __forceinline__ XcdBarrier xcd_barrier_post(unsigned* bar, volatile LAS unsigned* st) {
    XcdBarrier b; b.bar = bar; b.x = xb_xcc_id(); b.st = st;
    if (threadIdx.x == 0) (void)xb_add(&bar[XB_XCNT(b.x)], 1u);
    return b;
}
__device__ __forceinline__ void xcd_barrier_complete(unsigned* bar, unsigned x, unsigned& nloc, unsigned& nx) {
    const unsigned G = gridDim.x * gridDim.y * gridDim.z;
    unsigned sum, cnt, mine, sp = 0u;
    for (;;) {
        sum = 0u; cnt = 0u; mine = 0u;
#pragma unroll
        for (unsigned j = 0; j < 16; ++j) { const unsigned c = xb_ld(&bar[XB_XCNT(j)]); sum += c; cnt += (c > 0u) ? 1u : 0u; mine = (j == x) ? c : mine; }
        if (sum == G) break;
        __builtin_amdgcn_s_sleep(1);
        if ((++sp & 255u) == 0u) { if (xb_ld(&bar[XB_TMO])) break; if (sp > XB_SPIN_CAP) { atomicAdd(&bar[XB_TMO], 1u); break; } }
    }
    nloc = mine > 0u ? mine : 1u; nx = cnt > 0u ? cnt : 1u;
}

__device__ __forceinline__ void xcd_barrier_t0(const XcdBarrier& b) {
    {
        unsigned* bar = b.bar;
        __builtin_amdgcn_s_waitcnt(0);
        unsigned nloc = b.st[0], nx = b.st[1];
        if (nloc == 0u) { xcd_barrier_complete(bar, b.x, nloc, nx); b.st[0] = nloc; b.st[1] = nx; }
        const unsigned old = xb_add(&bar[XB_XSUB(b.x)], 1u);
        const unsigned gen = old / nloc;
        if (old + 1u == (gen + 1u) * nloc) {
            __builtin_amdgcn_fence(__ATOMIC_RELEASE, "agent");
            asm volatile("s_waitcnt vmcnt(0)" ::: "memory");
            const unsigned og = xb_add(&bar[XB_TOP], 1u);
            const unsigned tg = og / nx;
            if (og + 1u == (tg + 1u) * nx) xb_add(&bar[XB_TOPGEN], 1u);
            else XB_SPIN(xb_ld(&bar[XB_TOPGEN]) == tg, bar);
            __builtin_amdgcn_fence(__ATOMIC_ACQUIRE, "agent");
            xb_add(&bar[XB_XGEN(b.x)], 1u);
            asm volatile("s_waitcnt vmcnt(0)" ::: "memory");
        } else {
            XB_SPIN(xb_ld(&bar[XB_XGEN(b.x)]) == gen, bar);
            __builtin_amdgcn_fence(__ATOMIC_ACQUIRE, "agent");
            asm volatile("s_waitcnt vmcnt(0)" ::: "memory");
        }
    }
}
__device__ __forceinline__ void xcd_barrier(const XcdBarrier& b) {
    asm volatile("s_waitcnt vmcnt(0)" ::: "memory");
    __syncthreads();
    if (threadIdx.x == 0) xcd_barrier_t0(b);
    __syncthreads();
}
template <class Pre> __device__ __forceinline__ void xcd_barrier_pre(const XcdBarrier& b, const Pre& pre) {
    asm volatile("s_waitcnt vmcnt(0)" ::: "memory");
    __syncthreads();
    const int w_ = __builtin_amdgcn_readfirstlane((int)threadIdx.x >> 6);
    if (w_ != 0) pre();
    if (threadIdx.x == 0) xcd_barrier_t0(b);
    __syncthreads();
    if (w_ == 0) pre();
}

struct Ctx { LAS unsigned char* lds; int tid, lane, wave, G, bid; };

__device__ __forceinline__ void p0_transpose_item(const float* W, int K, int N, bf16* WT, LAS float* scr, int item, int lane) {
    const int nblk = N / 32, kb = item / nblk, nb = item % nblk, k0 = 64 * kb, n0 = 32 * nb;
    float wv[32];
#pragma unroll
    for (int i = 0; i < 32; ++i) wv[i] = W[(size_t)(k0 + 2 * i + (lane >> 5)) * N + n0 + (lane & 31)];
#pragma unroll
    for (int i = 0; i < 32; ++i) scr[(2 * i + (lane >> 5)) * 33 + (lane & 31)] = wv[i];
    LDS_WAIT(); asm volatile("" ::: "memory");
    const int c = lane & 7;
#pragma unroll
    for (int j = 0; j < 4; ++j) { const int n = (lane >> 3) + 8 * j; const LAS float* s = scr + (8 * c) * 33 + n;
        v4u o; o.x = pk2(s[0 * 33], s[1 * 33]); o.y = pk2(s[2 * 33], s[3 * 33]); o.z = pk2(s[4 * 33], s[5 * 33]); o.w = pk2(s[6 * 33], s[7 * 33]);
        *(v4u*)(WT + (size_t)(n0 + n) * K + k0 + 8 * c) = o; }
    LDS_WAIT(); asm volatile("" ::: "memory");
}
__device__ __forceinline__ void rms_row_to_bf16(const float* xr, const float* g, bf16* orow, int lane) {
    f32x4 v[8]; float s = 0.f;
#pragma unroll
    for (int j = 0; j < 8; ++j) { v[j] = *(const f32x4*)(xr + j * 256 + lane * 4); s += (v[j].x * v[j].x + v[j].y * v[j].y) + (v[j].z * v[j].z + v[j].w * v[j].w); }
    const float r = rsqrtf(wave_sum(s) * (1.f / D) + EPS);
#pragma unroll
    for (int j = 0; j < 8; ++j) { const f32x4 gg = *(const f32x4*)(g + j * 256 + lane * 4);
        v2u o; o.x = pk2(v[j].x * r * gg.x, v[j].y * r * gg.y); o.y = pk2(v[j].z * r * gg.z, v[j].w * r * gg.w);
        *(v2u*)(orow + j * 256 + lane * 4) = o; }
}
typedef float f32x2 __attribute__((ext_vector_type(2)));
typedef __bf16 bf16x2v __attribute__((ext_vector_type(2)));
__device__ __forceinline__ unsigned cvtpk(float lo, float hi) { const f32x2 v = {lo, hi}; return __builtin_bit_cast(unsigned, __builtin_convertvector(v, bf16x2v)); }
typedef short bf16x8 __attribute__((ext_vector_type(8)));
typedef float f32x16 __attribute__((ext_vector_type(16)));
__device__ __forceinline__ bf16x8 pack8(float a0, float a1, float a2, float a3, float a4, float a5, float a6, float a7) {
    v4u w; w.x = cvtpk(a0, a1); w.y = cvtpk(a2, a3); w.z = cvtpk(a4, a5); w.w = cvtpk(a6, a7); return __builtin_bit_cast(bf16x8, w); }
__device__ __forceinline__ void split8(const f32x4 a0, const f32x4 a1, bf16x8& hi, bf16x8& lo) {
    hi = pack8(a0[0], a0[1], a0[2], a0[3], a1[0], a1[1], a1[2], a1[3]);
    const v4u w = __builtin_bit_cast(v4u, hi);
    lo = pack8(a0[0] - bflo(w[0]), a0[1] - bfhi(w[0]), a0[2] - bflo(w[1]), a0[3] - bfhi(w[1]), a1[0] - bflo(w[2]), a1[1] - bfhi(w[2]), a1[2] - bflo(w[3]), a1[3] - bfhi(w[3]));
}
typedef __bf16 bf16x32 __attribute__((ext_vector_type(32)));
typedef unsigned v6u __attribute__((ext_vector_type(6)));
typedef float f32x32 __attribute__((ext_vector_type(32)));
__device__ __forceinline__ void p0_rows_to_fp6(const float* ra, const float* rb, unsigned char* da, unsigned char* db, float* ia, float* ib, int lane) {
    f32x4 va[8], vb[8]; float ma = 0.f, mb = 0.f;
#pragma unroll
    for (int i = 0; i < 8; ++i) { va[i] = __builtin_nontemporal_load((const f32x4*)(ra + i * 256 + lane * 4)); vb[i] = __builtin_nontemporal_load((const f32x4*)(rb + i * 256 + lane * 4)); }
#pragma unroll
    for (int i = 0; i < 8; ++i) { const f32x4 t = va[i], u = vb[i];
        ma = fmaxf(fmaxf(ma, fmaxf(fabsf(t.x), fabsf(t.y))), fmaxf(fabsf(t.z), fabsf(t.w))); mb = fmaxf(fmaxf(mb, fmaxf(fabsf(u.x), fabsf(u.y))), fmaxf(fabsf(u.z), fabsf(u.w))); }
#pragma unroll
    for (int o = 1; o < 64; o <<= 1) { ma = fmaxf(ma, __shfl_xor(ma, o)); mb = fmaxf(mb, __shfl_xor(mb, o)); }
    const float sa = ma > 0.f ? 7.f / ma : 0.f, sb = mb > 0.f ? 7.f / mb : 0.f;
    bf16x32 xa, xb;
#pragma unroll
    for (int k = 0; k < 32; ++k) { xa[k] = (__bf16)(va[k >> 2][k & 3] * sa); xb[k] = (__bf16)(vb[k >> 2][k & 3] * sb); }
    const v6u pa = __builtin_amdgcn_cvt_scalef32_pk32_fp6_bf16(xa, 1.0f), pb = __builtin_amdgcn_cvt_scalef32_pk32_fp6_bf16(xb, 1.0f);
#pragma unroll
    for (int q = 0; q < 3; ++q) { *(v2u*)(da + 24 * lane + 8 * q) = (v2u){pa[2 * q], pa[2 * q + 1]}; *(v2u*)(db + 24 * lane + 8 * q) = (v2u){pb[2 * q], pb[2 * q + 1]}; }
    if (lane == 0) { *ia = ma * (1.f / 7.f); *ib = mb * (1.f / 7.f); }
}
constexpr int CONV_SPLIT = 12800;
__device__ __forceinline__ void convert_rows(const float* e_down, const float* e_up, unsigned char* ED, unsigned char* EU, float* SD, float* SU, int r_lo, int r_hi, int w, int nw, int lane) {
    for (int r = r_lo + 2 * w; r < r_hi; r += 2 * nw) {
        const bool up = r >= NE; const int row = up ? r - NE : r;
        const float* s = (up ? e_up : e_down) + (size_t)row * D; unsigned char* d = (up ? EU : ED) + (size_t)row * ROWB; float* iv = (up ? SU : SD) + row;
        p0_rows_to_fp6(s, s + D, d, d + ROWB, iv, iv + 1, lane);
    }
}
__device__ __forceinline__ void p0_prologue(const Ctx& F, const float* x, const float* g1, const float* w_in, const float* w_out, const float* wq, const float* sk,
                                            const float* e_down, const float* e_up, bf16* WinT, bf16* WoutT, bf16* WeffT, bf16* H, unsigned char* ED, unsigned char* EU, float* SD, float* SU, const float* g2) {
    const int gw = F.bid * NWAVES + F.wave, NGW = F.G * NWAVES;
#if defined(TP_PHASE) && TP_PHASE == 12
    volatile unsigned long long* tsp12 = (volatile unsigned long long*)((unsigned char*)SD + 196608);
    if (F.bid == 0 && F.tid == 0) tsp12[0] = wall_clock64();
#endif
    for (int ph = 0; ph < 2; ++ph) {
    if ((ph == 0) == (((F.bid >> 3) & 1) == 0)) {
    {
        LAS float* scr = (LAS float*)(F.lds + RING_OFF + F.wave * 16384);
        constexpr int I_IN = (D / 64) * (NIN / 32), I_OUT = (D / 64) * (D / 32);
        for (int it = gw; it < I_IN + I_OUT; it += NGW) {
            if (it < I_IN) p0_transpose_item(w_in, D, NIN, WinT, scr, it, F.lane);
            else p0_transpose_item(w_out, D, D, WoutT, scr, it - I_IN, F.lane);
        }
    }
    __syncthreads();
    for (int it = gw; it < 16 * 64 * 2; it += NGW) {
        const int g = it & 15, dtile = (it >> 4) & 63, kh = it >> 10, p = g & 1, c = F.lane & 31, h = F.lane >> 5;
        const float* arow = wq + (size_t)(dtile * 32 + c) * 2048 + g * 128 + 8 * h;
        bf16x8 ah[8], al[8];
#pragma unroll
        for (int ks = 0; ks < 8; ++ks) { const f32x4 a0 = *(const f32x4*)(arow + 16 * ks), a1 = *(const f32x4*)(arow + 16 * ks + 4); split8(a0, a1, ah[ks], al[ks]); }
#pragma unroll 1
        for (int kt = 0; kt < 2; ++kt) {
            const int k0 = (kh * 2 + kt) * 32;
            const float* brow = sk + (size_t)(p * 128 + k0 + c) * 128 + 8 * h;
            f32x16 acc;
#pragma unroll
            for (int i = 0; i < 16; ++i) acc[i] = 0.f;
#pragma unroll
            for (int ks = 0; ks < 8; ++ks) { const f32x4 b0 = *(const f32x4*)(brow + 16 * ks), b1 = *(const f32x4*)(brow + 16 * ks + 4); bf16x8 bh, bl; split8(b0, b1, bh, bl);
                acc = __builtin_amdgcn_mfma_f32_32x32x16_bf16(al[ks], bh, acc, 0, 0, 0); acc = __builtin_amdgcn_mfma_f32_32x32x16_bf16(ah[ks], bl, acc, 0, 0, 0);
                acc = __builtin_amdgcn_mfma_f32_32x32x16_bf16(ah[ks], bh, acc, 0, 0, 0); }
            bf16* orow = WeffT + (size_t)(g * 128 + k0 + c) * 2048 + dtile * 32 + 4 * h;
#pragma unroll
            for (int q = 0; q < 4; ++q) { const f32x4 gq = *(const f32x4*)(g2 + dtile * 32 + 4 * h + 8 * q);
                v2u o; o.x = cvtpk(acc[4 * q] * gq[0], acc[4 * q + 1] * gq[1]); o.y = cvtpk(acc[4 * q + 2] * gq[2], acc[4 * q + 3] * gq[3]); *(v2u*)(orow + 8 * q) = o; }
        }
    }
#if defined(TP_PHASE) && TP_PHASE == 12
    __syncthreads(); if (F.bid == 0 && F.tid == 0) tsp12[1] = wall_clock64() - tsp12[0];
#endif
    } else {
    for (int rep_ = 0; rep_ < REP_P0C; ++rep_) convert_rows(e_down, e_up, ED, EU, SD, SU, 0, CONV_SPLIT, gw, NGW, F.lane);
    for (int m = gw; m < T; m += NGW) rms_row_to_bf16(x + (size_t)m * D, g1, H + (size_t)m * D, F.lane);
    }
    }
}

constexpr int SGU_VS = 136;
__device__ __forceinline__ void p2_sgu(const Ctx& F, const bf16* Z, const float* ln_g, const float* ln_b, const float* w_s, const float* b_s, bf16* MIX) {
    LAS bf16* vnT = (LAS bf16*)(F.lds + RING_OFF);
    LAS float* ps = (LAS float*)(F.lds + RING_OFF + 128 * SGU_VS * 2);
    LAS float* pq = ps + 512;
    const int s = F.tid & 127, dq = F.tid >> 7;
    const int c = F.lane & 31, h = F.lane >> 5, tt = F.wave >> 1;
    for (int unit = F.bid; unit < 512; unit += F.G) {
        const int g = unit & 7, t0 = (unit >> 3) * 128;
        __syncthreads();
        float v[32];
        { const bf16* vr = Z + (size_t)(t0 + s) * NIN + 1024 + g * 128 + dq * 32;
#pragma unroll
          for (int j = 0; j < 4; ++j) { const v4u q = *(const v4u*)(vr + 8 * j);
#pragma unroll
              for (int e = 0; e < 4; ++e) { v[8 * j + 2 * e] = bflo(q[e]); v[8 * j + 2 * e + 1] = bfhi(q[e]); } } }
        float sm = 0.f;
#pragma unroll
        for (int j = 0; j < 32; ++j) sm += v[j];
        ps[dq * 128 + s] = sm;
        __syncthreads();
        const float mean = (ps[s] + ps[128 + s] + ps[256 + s] + ps[384 + s]) * (1.f / 128.f);
        float sq = 0.f;
#pragma unroll
        for (int j = 0; j < 32; ++j) { v[j] -= mean; sq += v[j] * v[j]; }
        pq[dq * 128 + s] = sq;
        __syncthreads();
        const float rstd = rsqrtf((pq[s] + pq[128 + s] + pq[256 + s] + pq[384 + s]) * (1.f / 128.f) + EPS);
#pragma unroll
        for (int j = 0; j < 32; ++j) { const int d = dq * 32 + j; vnT[d * SGU_VS + s] = (bf16)f2bf(v[j] * rstd * ln_g[g * 128 + d] + ln_b[g * 128 + d]); }
        __syncthreads();
        f32x16 acc[2];
#pragma unroll
        for (int a = 0; a < 2; ++a)
#pragma unroll
            for (int i = 0; i < 16; ++i) acc[a][i] = 0.f;
        const int trow = 32 * tt + c;
        const float* wrow = w_s + ((size_t)g * 128 + trow) * 128;
        const int dt0 = 2 * (F.wave & 1);
        for (int ks = 0; ks < 2 * (tt + 1); ++ks) {
            const int s0 = 16 * ks + 8 * h;
            const f32x4 w0 = *(const f32x4*)(wrow + s0), w1 = *(const f32x4*)(wrow + s0 + 4);
            float w[8] = {w0[0], w0[1], w0[2], w0[3], w1[0], w1[1], w1[2], w1[3]};
#pragma unroll
            for (int j = 0; j < 8; ++j) w[j] = (s0 + j <= trow) ? w[j] : 0.f;
            const bf16x8 bf = pack8(w[0], w[1], w[2], w[3], w[4], w[5], w[6], w[7]);
#pragma unroll
            for (int a = 0; a < 2; ++a) { const bf16x8 af = *(const LAS bf16x8*)(vnT + (32 * (dt0 + a) + c) * SGU_VS + s0);
                acc[a] = __builtin_amdgcn_mfma_f32_32x32x16_bf16(af, bf, acc[a], 0, 0, 0); }
        }
        const float bias = b_s[g * 128 + trow];
        const size_t tok = (size_t)(t0 + trow);
#pragma unroll
        for (int a = 0; a < 2; ++a)
#pragma unroll
            for (int q = 0; q < 4; ++q) { const int d0 = 32 * (dt0 + a) + 8 * q + 4 * h;
                const v2u uu = *(const v2u*)(Z + tok * NIN + g * 128 + d0);
                v2u o; o.x = cvtpk(bflo(uu.x) * (acc[a][4 * q] + bias), bfhi(uu.x) * (acc[a][4 * q + 1] + bias));
                o.y = cvtpk(bflo(uu.y) * (acc[a][4 * q + 2] + bias), bfhi(uu.y) * (acc[a][4 * q + 3] + bias));
                *(v2u*)(MIX + tok * D + g * 128 + d0) = o; }
    }
}
constexpr int ATT_KS = 72, ATT_VS = 264;
__device__ __forceinline__ void p2_attn(const Ctx& F, const bf16* Z, const float* sinks, bf16* MIX) {
    LAS bf16* Ks = (LAS bf16*)(F.lds + RING_OFF);
    LAS bf16* Vt = (LAS bf16*)(F.lds + RING_OFF + 256 * ATT_KS * 2);
    const int c = F.lane & 31, h = F.lane >> 5;
    for (int unit = F.bid; unit < 256; unit += F.G) {
        const int hg = unit & 1, hk = (unit >> 1) & 1, n = (unit >> 2) & 15, b = unit >> 6;
        __syncthreads();
        for (int e = F.tid; e < 256 * 8; e += NTHR) {
            const int j = e >> 3, ch = e & 7, pos = (n - 1) * 128 + j;
            v4u kv = (v4u){0u, 0u, 0u, 0u}, vv = (v4u){0u, 0u, 0u, 0u};
            if (pos >= 0) { const bf16* row = Z + ((size_t)b * SEQ + pos) * NIN; kv = *(const v4u*)(row + 3072 + hk * 64 + ch * 8); vv = *(const v4u*)(row + 3200 + hk * 64 + ch * 8); }
            *(LAS v4u*)(Ks + j * ATT_KS + ch * 8) = kv;
#pragma unroll
            for (int jj = 0; jj < 8; ++jj) Vt[(ch * 8 + jj) * ATT_VS + j] = (bf16)((vv[jj >> 1] >> (16 * (jj & 1))) & 0xffffu);
        }
        __syncthreads();
        for (int tk = 0; tk < 2; ++tk) {
            const int hq = hk * 8 + hg * 4 + (F.wave >> 1), i0 = 32 * (2 * (F.wave & 1) + tk);
            const size_t tok = (size_t)b * SEQ + n * 128 + i0 + c;
            const bf16* qrow = Z + tok * NIN + 2048 + hq * 64;
            bf16x8 qf[4];
#pragma unroll
            for (int ks = 0; ks < 4; ++ks) qf[ks] = *(const bf16x8*)(qrow + 16 * ks + 8 * h);
            f32x16 sT[5];
#pragma unroll
            for (int kt = 0; kt < 5; ++kt) {
#pragma unroll
                for (int i = 0; i < 16; ++i) sT[kt][i] = 0.f;
#pragma unroll
                for (int ks = 0; ks < 4; ++ks) { const bf16x8 kf = *(const LAS bf16x8*)(Ks + (i0 + 32 * kt + c) * ATT_KS + 16 * ks + 8 * h);
                    sT[kt] = __builtin_amdgcn_mfma_f32_32x32x16_bf16(kf, qf[ks], sT[kt], 0, 0, 0); }
            }
            const float sink = sinks[hq]; float m = sink;
#pragma unroll
            for (int kt = 0; kt < 5; ++kt) {
                const bool tile_ok = (n > 0) || (i0 + 32 * kt >= 128);
#pragma unroll
                for (int i = 0; i < 16; ++i) { const int jj = (i & 3) + 8 * (i >> 2) + 4 * h;
                    bool ok = tile_ok; if (kt == 0) ok = ok && (jj > c); if (kt == 4) ok = ok && (jj <= c);
                    const float x = ok ? sT[kt][i] * 0.125f : -INFINITY; sT[kt][i] = x; m = fmaxf(m, x); }
            }
            m = fmaxf(m, __shfl_xor(m, 32));
            float l = 0.f;
#pragma unroll
            for (int kt = 0; kt < 5; ++kt)
#pragma unroll
                for (int i = 0; i < 16; ++i) { const float p = __expf(sT[kt][i] - m); sT[kt][i] = p; l += p; }
            l += __shfl_xor(l, 32); l += __expf(sink - m);
            f32x16 o[2];
#pragma unroll
            for (int a = 0; a < 2; ++a)
#pragma unroll
                for (int i = 0; i < 16; ++i) o[a][i] = 0.f;
#pragma unroll
            for (int kt = 0; kt < 5; ++kt)
#pragma unroll
                for (int st = 0; st < 2; ++st) {
                    const bf16x8 pf = pack8(sT[kt][8 * st], sT[kt][8 * st + 1], sT[kt][8 * st + 2], sT[kt][8 * st + 3], sT[kt][8 * st + 4], sT[kt][8 * st + 5], sT[kt][8 * st + 6], sT[kt][8 * st + 7]);
                    const int key0 = i0 + 32 * kt + 16 * st + 4 * h;
#pragma unroll
                    for (int a = 0; a < 2; ++a) { const LAS bf16* vp = Vt + (32 * a + c) * ATT_VS + key0;
                        const v2u lo = *(const LAS v2u*)vp, hi = *(const LAS v2u*)(vp + 8);
                        const v4u vw = (v4u){lo.x, lo.y, hi.x, hi.y};
                        o[a] = __builtin_amdgcn_mfma_f32_32x32x16_bf16(__builtin_bit_cast(bf16x8, vw), pf, o[a], 0, 0, 0); }
                }
            const float inv = 1.f / l;
#pragma unroll
            for (int a = 0; a < 2; ++a)
#pragma unroll
                for (int q = 0; q < 4; ++q) { const int d0 = 32 * a + 8 * q + 4 * h;
                    v2u w; w.x = cvtpk(o[a][4 * q] * inv, o[a][4 * q + 1] * inv); w.y = cvtpk(o[a][4 * q + 2] * inv, o[a][4 * q + 3] * inv);
                    *(v2u*)(MIX + tok * D + 1024 + hq * 64 + d0) = w; }
        }
    }
}

typedef __bf16 bf16x2_t __attribute__((ext_vector_type(2)));
constexpr int P5_TOK = 32;
constexpr int P5_WL = 2048;
__device__ __forceinline__ unsigned fkey(float f) { const unsigned u = __float_as_uint(f); return (u & 0x80000000u) ? ~u : (u | 0x80000000u); }
__device__ __forceinline__ float dot2bf(unsigned a, unsigned b, float c) { return __builtin_amdgcn_fdot2_f32_bf16(__builtin_bit_cast(bf16x2_t, a), __builtin_bit_cast(bf16x2_t, b), c, false); }
template <int CTRL, int RM, bool BC> __device__ __forceinline__ float dpp_f(float v) { return __builtin_bit_cast(float, __builtin_amdgcn_update_dpp(0, __builtin_bit_cast(int, v), CTRL, RM, 0xf, BC)); }
struct WaveLds { LAS int* eid; LAS float* gate; LAS float* sv; LAS float* tv; LAS int* ti; LAS int* ctab; };
template <int CTRL> __device__ __forceinline__ unsigned dppx_u(unsigned v) { return (unsigned)__builtin_amdgcn_update_dpp(0, (int)v, CTRL, 0xf, 0xf, true); }
template <int CTRL> __device__ __forceinline__ float dppx_f(float v) { return __builtin_bit_cast(float, __builtin_amdgcn_update_dpp(0, __builtin_bit_cast(int, v), CTRL, 0xf, 0xf, true)); }
__device__ __forceinline__ unsigned umax(unsigned a, unsigned b) { return a > b ? a : b; }
__device__ __forceinline__ unsigned umin(unsigned a, unsigned b) { return a < b ? a : b; }
__device__ __forceinline__ unsigned row_allmax_u(unsigned m) {
    m = umax(m, dppx_u<0xB1>(m)); m = umax(m, dppx_u<0x4E>(m)); m = umax(m, dppx_u<0x141>(m)); m = umax(m, dppx_u<0x140>(m)); return m; }
__device__ __forceinline__ float row_allmax_f(float m) { m = fmaxf(m, dppx_f<0xB1>(m)); m = fmaxf(m, dppx_f<0x4E>(m)); m = fmaxf(m, dppx_f<0x141>(m)); m = fmaxf(m, dppx_f<0x140>(m)); return m; }
__device__ __forceinline__ float row_allsum_f(float m) { m += dppx_f<0xB1>(m); m += dppx_f<0x4E>(m); m += dppx_f<0x141>(m); m += dppx_f<0x140>(m); return m; }
#define P5_CE(a, b) do { const unsigned _h = umax(a, b), _l = umin(a, b); a = _h; b = _l; } while (0)
__device__ __forceinline__ int cand_pair(int c) {
    return c < 16 ? c : c < 24 ? (1 << 4) | (c - 16) : c < 29 ? (2 << 4) | (c - 24) : c < 33 ? (3 << 4) | (c - 29) : c < 36 ? (4 << 4) | (c - 33) : c < 38 ? (5 << 4) | (c - 36)
         : c < 40 ? (6 << 4) | (c - 38) : c < 42 ? (7 << 4) | (c - 40) : c < 50 ? ((c - 34) << 4) : 0xff;
}
__device__ __forceinline__ void p5_topk_fetch(const WaveLds& W, const float* src, int half, int lane) {
#pragma unroll
    for (int i = 0; i < 4; ++i) __builtin_amdgcn_global_load_lds((const unsigned*)(src + i * 256 + lane * 4), (LAS unsigned*)(W.sv + half * 1024 + i * 256), 16, 0, 0);
}
__device__ __forceinline__ void p5_topk_token(const WaveLds& W, const float* sc  , const float* sc_next, float rs  , int lane) {
    const int r = lane >> 4, l15 = lane & 15;
#pragma unroll 1
    for (int pp = 0; pp < 2; ++pp) {
        unsigned k[2][8]; unsigned top[2] = {0u, 0u};
        asm volatile("s_waitcnt vmcnt(0)" ::: "memory");
        { const float* nsrc = pp == 0 ? sc + 1024 : sc_next; if (nsrc != nullptr) p5_topk_fetch(W, nsrc, 1 - pp, lane); }
#pragma unroll
        for (int u = 0; u < 2; ++u) {
            const int L = 4 * (2 * pp + u) + r;
            const f32x4 v0 = *(const LAS f32x4*)(W.sv + L * 128 + 8 * l15) * rs, v1 = *(const LAS f32x4*)(W.sv + L * 128 + 8 * l15 + 4) * rs;
#pragma unroll
            for (int j = 0; j < 4; ++j) { k[u][j] = (fkey(v0[j]) & ~127u) | (unsigned)(127 - (8 * l15 + j)); k[u][4 + j] = (fkey(v1[j]) & ~127u) | (unsigned)(127 - (8 * l15 + 4 + j)); }
            P5_CE(k[u][0], k[u][1]); P5_CE(k[u][2], k[u][3]); P5_CE(k[u][4], k[u][5]); P5_CE(k[u][6], k[u][7]);
            P5_CE(k[u][0], k[u][2]); P5_CE(k[u][1], k[u][3]); P5_CE(k[u][4], k[u][6]); P5_CE(k[u][5], k[u][7]);
            P5_CE(k[u][1], k[u][2]); P5_CE(k[u][5], k[u][6]);
            P5_CE(k[u][0], k[u][4]); P5_CE(k[u][1], k[u][5]); P5_CE(k[u][2], k[u][6]); P5_CE(k[u][3], k[u][7]);
            P5_CE(k[u][2], k[u][4]); P5_CE(k[u][3], k[u][5]);
            P5_CE(k[u][1], k[u][2]); P5_CE(k[u][3], k[u][4]); P5_CE(k[u][5], k[u][6]);
        }
#pragma unroll 4
        for (int it = 0; it < 16; ++it) {
#pragma unroll
            for (int u = 0; u < 2; ++u) {
                const unsigned m = row_allmax_u(k[u][0]); const bool sel = k[u][0] == m;
                top[u] = (l15 == it) ? m : top[u];
#pragma unroll
                for (int j = 0; j < 7; ++j) k[u][j] = sel ? k[u][j + 1] : k[u][j];
                k[u][7] = sel ? 0u : k[u][7];
            }
        }
        LDS_WAIT(); __builtin_amdgcn_wave_barrier();
#pragma unroll
        for (int u = 0; u < 2; ++u) { const int L = 4 * (2 * pp + u) + r; const int idx = 127 - (int)(top[u] & 127u);
            W.tv[L * 16 + l15] = W.sv[L * 128 + idx] * rs; W.ti[L * 16 + l15] = idx; }
    }
    LDS_WAIT(); __builtin_amdgcn_wave_barrier();
    int cij[4];
#pragma unroll
    for (int j = 0; j < 4; ++j) cij[j] = cand_pair(4 * l15 + j);
    unsigned ck[2][4]; unsigned top2[2] = {0u, 0u};
#pragma unroll
    for (int u = 0; u < 2; ++u) {
        const int hd = 4 * u + r; const LAS float* tv0 = W.tv + (2 * hd) * 16; const LAS float* tv1 = tv0 + 16;
#pragma unroll
        for (int j = 0; j < 4; ++j) { const float cs = tv0[(cij[j] >> 4) & 15] + tv1[cij[j] & 15]; const int s = 4 * l15 + j;
            ck[u][j] = (s < 50) ? ((fkey(cs) & ~63u) | (unsigned)(63 - s)) : 0u; }
        P5_CE(ck[u][0], ck[u][1]); P5_CE(ck[u][2], ck[u][3]); P5_CE(ck[u][0], ck[u][2]); P5_CE(ck[u][1], ck[u][3]); P5_CE(ck[u][1], ck[u][2]);
    }
#pragma unroll 4
    for (int it = 0; it < 16; ++it) {
#pragma unroll
        for (int u = 0; u < 2; ++u) {
            const unsigned m = row_allmax_u(ck[u][0]); const bool sel = ck[u][0] == m;
            top2[u] = (l15 == it) ? m : top2[u];
            ck[u][0] = sel ? ck[u][1] : ck[u][0]; ck[u][1] = sel ? ck[u][2] : ck[u][1]; ck[u][2] = sel ? ck[u][3] : ck[u][2]; ck[u][3] = sel ? 0u : ck[u][3];
        }
    }
#pragma unroll
    for (int u = 0; u < 2; ++u) {
        const int hd = 4 * u + r; const LAS float* tv0 = W.tv + (2 * hd) * 16; const LAS float* tv1 = tv0 + 16; const LAS int* ti0 = W.ti + (2 * hd) * 16; const LAS int* ti1 = ti0 + 16;
        const int ij = W.ctab[63 - (int)(top2[u] & 63u)];
        const int i1 = (ij >> 4) & 15, j1 = ij & 15;
        const float vs = tv0[i1] + tv1[j1]; const int e = ti0[i1] * 128 + ti1[j1];
        const float mx = row_allmax_f(vs), ex = __expf(vs - mx), sm = row_allsum_f(ex);
        W.gate[hd * 16 + l15] = ex / sm; W.eid[hd * 16 + l15] = e;
    }
    LDS_WAIT(); __builtin_amdgcn_wave_barrier();
}
constexpr int P5_R = 9;
constexpr int P5_NSL = 16, P5_SLSH = 10;
#ifndef REP_TOPK
#define REP_TOPK 1
#endif
#ifndef REP_DS
#define REP_DS 1
#endif
constexpr int P5_WL2 = 20480;
struct SweepLds { LAS unsigned char* ring; LAS int* feid; LAS float* fcf; LAS float* raw; };
__device__ __forceinline__ int mbcnt64(unsigned long long m) { return __builtin_amdgcn_mbcnt_hi((unsigned)(m >> 32), __builtin_amdgcn_mbcnt_lo((unsigned)m, 0u)); }
template <int CTRL, int RM, bool BC> __device__ __forceinline__ int dpp_i(int v) { return __builtin_amdgcn_update_dpp(0, v, CTRL, RM, 0xf, BC); }
__device__ __forceinline__ float wave_total63(float v) {
    v += dpp_f<0x111, 0xf, true>(v); v += dpp_f<0x112, 0xf, true>(v); v += dpp_f<0x114, 0xf, true>(v); v += dpp_f<0x118, 0xf, true>(v);
    v += dpp_f<0x142, 0xa, false>(v); v += dpp_f<0x143, 0xc, false>(v); return v; }
__device__ __forceinline__ int wave_incl_scan(int v) {
    v += dpp_i<0x111, 0xf, true>(v); v += dpp_i<0x112, 0xf, true>(v); v += dpp_i<0x114, 0xf, true>(v); v += dpp_i<0x118, 0xf, true>(v);
    v += dpp_i<0x142, 0xa, false>(v); v += dpp_i<0x143, 0xc, false>(v); return v; }
#define P5_WRAP(x) ((x) + 1 == P5_R ? 0 : (x) + 1)
#define P5_ISSUE(tab, id_) do { const unsigned _vo = (unsigned)(id_) * (unsigned)ROWB + (unsigned)lane * 16u;     \
    const unsigned char* _gp = (tab) + _vo; LAS unsigned char* _lp = L.ring + pslot * ROWB; \
    __builtin_amdgcn_global_load_lds((const unsigned*)_gp, (LAS unsigned*)_lp, 16, 0, 0);                         \
    if (lane < 32) __builtin_amdgcn_global_load_lds((const unsigned*)_gp, (LAS unsigned*)_lp, 16, 1024, 0);       \
    pslot = P5_WRAP(pslot); } while (0)
#define P5_ROWREAD(dst_, slot_) do { const LAS unsigned char* _rp = L.ring + (slot_) * ROWB + lane * 24; const v2u _a = *(const LAS v2u*)_rp, _b = *(const LAS v2u*)(_rp + 8), _c = *(const LAS v2u*)(_rp + 16); \
    dst_[0] = (int)_a.x; dst_[1] = (int)_a.y; dst_[2] = (int)_b.x; dst_[3] = (int)_b.y; dst_[4] = (int)_c.x; dst_[5] = (int)_c.y; } while (0)
typedef int v8i __attribute__((ext_vector_type(8)));
#define P5_V6(x_) ((v6u){(unsigned)x_[0], (unsigned)x_[1], (unsigned)x_[2], (unsigned)x_[3], (unsigned)x_[4], (unsigned)x_[5]})
#define P5_FEID(i_) __builtin_amdgcn_readfirstlane(L.feid[(i_) > 511 ? 511 : (i_)])
typedef _Float16 f16x32 __attribute__((ext_vector_type(32)));
typedef _Float16 f16x2v __attribute__((ext_vector_type(2)));
__device__ __forceinline__ void wave_total63x2(float& a, float& b) {
    a += dpp_f<0x111, 0xf, true>(a); b += dpp_f<0x111, 0xf, true>(b); a += dpp_f<0x112, 0xf, true>(a); b += dpp_f<0x112, 0xf, true>(b);
    a += dpp_f<0x114, 0xf, true>(a); b += dpp_f<0x114, 0xf, true>(b); a += dpp_f<0x118, 0xf, true>(a); b += dpp_f<0x118, 0xf, true>(b);
    a += dpp_f<0x142, 0xa, false>(a); b += dpp_f<0x142, 0xa, false>(b); a += dpp_f<0x143, 0xc, false>(a); b += dpp_f<0x143, 0xc, false>(b);
}
template <bool UP> __device__ __forceinline__ void p5_sweep(const SweepLds& L, const unsigned char* tab, unsigned (&hp)[4][16], const v8i (&hq)[4], const float (&hinv)[4], int lenv0, int lenv1, int lane) {
    const LAS int* cbits = (const LAS int*)L.fcf;
    int pslot = 0, cslot = 2, idx = 0;
    for (int i = 0; i < P5_R; ++i) { const int id = P5_FEID(i); P5_ISSUE(tab, id); }
    int nv0 = L.feid[P5_R], nv1 = L.feid[P5_R + 1];
    asm volatile("s_waitcnt vmcnt(14)" ::: "memory");
    v8i ra = {0, 0, 0, 0, 0, 0, 0, 0}, rb = {0, 0, 0, 0, 0, 0, 0, 0}; P5_ROWREAD(ra, 0); P5_ROWREAD(rb, 1);
    const bool dg0 = (lane & 3) == 0, dg1 = (lane & 3) == 1, dg2 = (lane & 3) == 2, dgv = ((lane & 15) >> 2) == (lane >> 4);
    int cav = 0, cbv = 0; if (UP) { cav = cbits[0]; cbv = cbits[1]; }
    for (int s = 0; s < P5_NSL; ++s) {
        const int lenv = s < 16 ? lenv0 : lenv1;
#pragma unroll
        for (int tok = 0; tok < 4; ++tok) {
            const int n = __builtin_amdgcn_readlane(lenv, (s & 15) * 4 + tok);
            int i = 0;
            for (; i + 1 < n; i += 2) {
                f16x32 xa, xb; f32x4 ma, mb;
                if (UP) { xa = __builtin_amdgcn_cvt_scalef32_pk32_f16_fp6(P5_V6(ra), 1.0f); xb = __builtin_amdgcn_cvt_scalef32_pk32_f16_fp6(P5_V6(rb), 1.0f); }
                else { const f32x4 z = {0.f, 0.f, 0.f, 0.f};
                    ma = __builtin_amdgcn_mfma_scale_f32_16x16x128_f8f6f4(ra, hq[tok], z, 2  , 2  , 0, 0, 0, 0);
                    mb = __builtin_amdgcn_mfma_scale_f32_16x16x128_f8f6f4(rb, hq[tok], z, 2, 2, 0, 0, 0, 0); }
                const f16x2v ca = __builtin_bit_cast(f16x2v, __builtin_amdgcn_readfirstlane(cav)), cb = __builtin_bit_cast(f16x2v, __builtin_amdgcn_readfirstlane(cbv));
                { const int id0 = __builtin_amdgcn_readfirstlane(nv0), id1 = __builtin_amdgcn_readfirstlane(nv1); P5_ISSUE(tab, id0); P5_ISSUE(tab, id1); }
                nv0 = L.feid[idx + 2 + P5_R > 511 ? 511 : idx + 2 + P5_R]; nv1 = L.feid[idx + 3 + P5_R > 511 ? 511 : idx + 3 + P5_R];
                if (UP) { cav = cbits[idx + 2 > 511 ? 511 : idx + 2]; cbv = cbits[idx + 3 > 511 ? 511 : idx + 3]; }
                asm volatile("s_waitcnt vmcnt(14)" ::: "memory");
                const int cs1 = P5_WRAP(cslot);
                P5_ROWREAD(ra, cslot); P5_ROWREAD(rb, cs1);
                cslot = P5_WRAP(cs1);
                __builtin_amdgcn_sched_barrier(0);
                if (!UP) {
                    float a0 = ma[0], a1 = ma[1], a2 = ma[2], a3 = ma[3], b0 = mb[0], b1 = mb[1], b2 = mb[2], b3 = mb[3];
                    asm volatile("" : "+v"(a0), "+v"(a1), "+v"(a2), "+v"(a3), "+v"(b0), "+v"(b1), "+v"(b2), "+v"(b3));
                    float ta = dg0 ? a0 : dg1 ? a1 : dg2 ? a2 : a3, tb = dg0 ? b0 : dg1 ? b1 : dg2 ? b2 : b3;
                    ta = dgv ? ta : 0.f; tb = dgv ? tb : 0.f; wave_total63x2(ta, tb);
                    L.raw[idx] = __builtin_bit_cast(float, __builtin_amdgcn_readlane(__builtin_bit_cast(int, ta), 63)) * hinv[tok];
                    L.raw[idx + 1] = __builtin_bit_cast(float, __builtin_amdgcn_readlane(__builtin_bit_cast(int, tb), 63)) * hinv[tok];
                } else {
#pragma unroll
                    for (int k = 0; k < 16; ++k) hp[tok][k] = __builtin_bit_cast(unsigned, __builtin_elementwise_fma((f16x2v){xa[2 * k], xa[2 * k + 1]}, ca, __builtin_bit_cast(f16x2v, hp[tok][k])));
                    __builtin_amdgcn_sched_barrier(0);
#pragma unroll
                    for (int k = 0; k < 16; ++k) hp[tok][k] = __builtin_bit_cast(unsigned, __builtin_elementwise_fma((f16x2v){xb[2 * k], xb[2 * k + 1]}, cb, __builtin_bit_cast(f16x2v, hp[tok][k])));
                }
                idx += 2;
            }
            if (i < n) {
                f16x32 xa; f32x4 ma;
                if (UP) xa = __builtin_amdgcn_cvt_scalef32_pk32_f16_fp6(P5_V6(ra), 1.0f);
                else { const f32x4 z = {0.f, 0.f, 0.f, 0.f}; ma = __builtin_amdgcn_mfma_scale_f32_16x16x128_f8f6f4(ra, hq[tok], z, 2, 2, 0, 0, 0, 0); }
                const f16x2v ca = __builtin_bit_cast(f16x2v, __builtin_amdgcn_readfirstlane(cav));
                ra = rb; cav = cbv;
                { const int id0 = __builtin_amdgcn_readfirstlane(nv0); P5_ISSUE(tab, id0); }
                nv0 = nv1; nv1 = L.feid[idx + 2 + P5_R > 511 ? 511 : idx + 2 + P5_R];
                if (UP) cbv = cbits[idx + 2 > 511 ? 511 : idx + 2];
                asm volatile("s_waitcnt vmcnt(14)" ::: "memory");
                P5_ROWREAD(rb, cslot);
                cslot = P5_WRAP(cslot);
                __builtin_amdgcn_sched_barrier(0);
                if (!UP) {
                    float a0 = ma[0], a1 = ma[1], a2 = ma[2], a3 = ma[3];
                    asm volatile("" : "+v"(a0), "+v"(a1), "+v"(a2), "+v"(a3));
                    float ta = dg0 ? a0 : dg1 ? a1 : dg2 ? a2 : a3; ta = wave_total63(dgv ? ta : 0.f);
                    L.raw[idx] = __builtin_bit_cast(float, __builtin_amdgcn_readlane(__builtin_bit_cast(int, ta), 63)) * hinv[tok];
                } else {
#pragma unroll
                    for (int k = 0; k < 16; ++k) hp[tok][k] = __builtin_bit_cast(unsigned, __builtin_elementwise_fma((f16x2v){xa[2 * k], xa[2 * k + 1]}, ca, __builtin_bit_cast(f16x2v, hp[tok][k])));
                }
                idx += 1;
            }
        }
    }
    asm volatile("s_waitcnt vmcnt(0)" ::: "memory");
}
__device__ __forceinline__ void p5_wave(LAS unsigned char* wl, const float* SC, const bf16* X1, const unsigned char* ED, const unsigned char* EU, const float* SD, const float* SU,
                                        const float* gf, float* out, int t0, int lane, const float* g2) {
    SweepLds L; L.ring = wl; L.feid = (LAS int*)(wl + 14336); L.fcf = (LAS float*)(wl + 14336 + 2048); L.raw = (LAS float*)(wl + 14336 + 4096);
    { LAS int* ctab = (LAS int*)(wl + 14336); ctab[lane] = cand_pair(lane); }
    unsigned hp[4][16]; float rsv[4]; v8i hq[4]; float hinv[4];
    {   f32x4 gl[8];
        int ls = lane; asm volatile("" : "+v"(ls));
#pragma unroll
        for (int i = 0; i < 8; ++i) gl[i] = *(const f32x4*)(g2 + i * 256 + ls * 4);
        v2u xq[4][8];
#pragma unroll
        for (int tk = 0; tk < 4; ++tk)
#pragma unroll
            for (int i = 0; i < 8; ++i) xq[tk][i] = *(const v2u*)(X1 + (size_t)(t0 + 8 * tk) * D + i * 256 + ls * 4);
#pragma unroll
        for (int tk = 0; tk < 4; ++tk) { float ss = 0.f;
#pragma unroll
            for (int i = 0; i < 8; ++i)
#pragma unroll
                for (int e = 0; e < 2; ++e) { const float a = bflo(xq[tk][i][e]), b = bfhi(xq[tk][i][e]); ss += a * a + b * b; }
            const float rs = __builtin_amdgcn_rsqf(wave_sum(ss) * (1.f / D) + EPS); rsv[tk] = rs;
            float hx[32]; float mx = 0.f;
#pragma unroll
            for (int i = 0; i < 8; ++i)
#pragma unroll
                for (int e = 0; e < 2; ++e) {
                    hx[4 * i + 2 * e] = bflo(xq[tk][i][e]) * rs * gl[i][2 * e]; hx[4 * i + 2 * e + 1] = bfhi(xq[tk][i][e]) * rs * gl[i][2 * e + 1];
                    mx = fmaxf(mx, fmaxf(fabsf(hx[4 * i + 2 * e]), fabsf(hx[4 * i + 2 * e + 1]))); }
#pragma unroll
            for (int o = 1; o < 64; o <<= 1) mx = fmaxf(mx, __shfl_xor(mx, o));
            const float hs = mx > 0.f ? 7.f / mx : 0.f; hinv[tk] = mx * (1.f / 7.f);
            bf16x32 hb;
#pragma unroll
            for (int k = 0; k < 32; ++k) hb[k] = (__bf16)(hx[k] * hs);
            const v6u pk = __builtin_amdgcn_cvt_scalef32_pk32_fp6_bf16(hb, 1.0f);
            hq[tk] = (v8i){(int)pk[0], (int)pk[1], (int)pk[2], (int)pk[3], (int)pk[4], (int)pk[5], 0, 0};
        }
    }
    LDS_WAIT(); __builtin_amdgcn_wave_barrier();
    for (int rep_ = 0; rep_ < REP_TOPK; ++rep_)
    for (int tk = 0; tk < 4; ++tk) {
        if (tk == 0) { WaveLds W0; W0.sv = (LAS float*)(wl + 4096); p5_topk_fetch(W0, SC + (size_t)t0 * 2048, 0, lane); }
        WaveLds W; W.eid = (LAS int*)(wl + 1024 * tk); W.gate = (LAS float*)(wl + 1024 * tk + 512);
        W.sv = (LAS float*)(wl + 4096); W.tv = (LAS float*)(wl + 12288); W.ti = (LAS int*)(wl + 13312); W.ctab = (LAS int*)(wl + 14336);
        p5_topk_token(W, SC + (size_t)(t0 + 8 * tk) * 2048, tk < 3 ? SC + (size_t)(t0 + 8 * tk + 8) * 2048 : nullptr, rsv[tk], lane);
    }
    int lenv0 = 0, lenv1 = 0;
#pragma unroll
    for (int tk = 0; tk < 4; ++tk) {
        const LAS int* ue = (const LAS int*)(wl + 1024 * tk); const int sl0 = ue[lane] >> P5_SLSH, sl1 = ue[lane + 64] >> P5_SLSH;
        for (int k = 0; k < P5_NSL; ++k) { const int c = __popcll(__ballot(sl0 == k)) + __popcll(__ballot(sl1 == k));
            if (lane == (k & 15) * 4 + tk) { if (k < 16) lenv0 = c; else lenv1 = c; } }
    }
    const int incl0 = wave_incl_scan(lenv0), tot0 = __builtin_amdgcn_readlane(incl0, 63);
    const int base0 = incl0 - lenv0, base1 = wave_incl_scan(lenv1) - lenv1 + tot0;
#pragma unroll
    for (int tk = 0; tk < 4; ++tk) {
        const LAS int* ue = (const LAS int*)(wl + 1024 * tk); const LAS float* ug = (const LAS float*)(wl + 1024 * tk + 512);
        const int e0 = ue[lane], e1 = ue[lane + 64], sl0 = e0 >> P5_SLSH, sl1 = e1 >> P5_SLSH; const float g0 = ug[lane], g1 = ug[lane + 64];
        int r0 = 0, r1 = 0;
        for (int k = 0; k < P5_NSL; ++k) { const unsigned long long m0 = __ballot(sl0 == k), m1 = __ballot(sl1 == k);
            if (sl0 == k) r0 = mbcnt64(m0);
            if (sl1 == k) r1 = __popcll(m0) + mbcnt64(m1); }
        const int b00 = __shfl(base0, (sl0 & 15) * 4 + tk), b01 = __shfl(base1, (sl0 & 15) * 4 + tk), b10 = __shfl(base0, (sl1 & 15) * 4 + tk), b11 = __shfl(base1, (sl1 & 15) * 4 + tk);
        const int p0 = (sl0 < 16 ? b00 : b01) + r0, p1 = (sl1 < 16 ? b10 : b11) + r1;
        L.feid[p0] = e0; L.fcf[p0] = g0; L.feid[p1] = e1; L.fcf[p1] = g1;
    }
    LDS_WAIT(); __builtin_amdgcn_wave_barrier();
    for (int rep_ = 0; rep_ < REP_DS; ++rep_) p5_sweep<false>(L, ED, hp, hq, hinv, lenv0, lenv1, lane);
    LDS_WAIT(); __builtin_amdgcn_wave_barrier();
    float cmax = 0.f;
    {   float sdv[8], suv[8], cv[8];
#pragma unroll
        for (int k = 0; k < 8; ++k) { const int id = L.feid[lane + 64 * k]; sdv[k] = SD[id]; suv[k] = SU[id]; }
#pragma unroll
        for (int k = 0; k < 8; ++k) { const int i = lane + 64 * k; cv[k] = gelu_erf(L.raw[i] * sdv[k]) * L.fcf[i] * suv[k]; cmax = fmaxf(cmax, fabsf(cv[k])); }
#pragma unroll
        for (int o = 1; o < 64; o <<= 1) cmax = fmaxf(cmax, __shfl_xor(cmax, o));
        const float cinv = cmax > 0.f ? 1.f / cmax : 0.f;
#pragma unroll
        for (int k = 0; k < 8; ++k) { const _Float16 h = (_Float16)(cv[k] * cinv); ((LAS unsigned*)L.fcf)[lane + 64 * k] = __builtin_bit_cast(unsigned, (f16x2v){h, h}); }
    }
    LDS_WAIT(); __builtin_amdgcn_wave_barrier();
    asm volatile("s_waitcnt vmcnt(0)" ::: "memory");
#pragma unroll
    for (int tk = 0; tk < 4; ++tk)
#pragma unroll
        for (int q = 0; q < 16; ++q) hp[tk][q] = 0u;
    p5_sweep<true>(L, EU, hp, hq, hinv, lenv0, lenv1, lane);
    int le = lane; asm volatile("" : "+v"(le));
#pragma unroll
    for (int tk = 0; tk < 4; ++tk) {
        const size_t ro = (size_t)(t0 + 8 * tk) * D; float ss = 0.f; float st[32];
#pragma unroll
        for (int i = 0; i < 8; ++i) { const v2u xa = __builtin_nontemporal_load((const v2u*)(X1 + ro + i * 256 + le * 4));
#pragma unroll
            for (int c = 0; c < 2; ++c) { const int k = 4 * i + 2 * c; const f16x2v a = __builtin_bit_cast(f16x2v, hp[tk][k >> 1]);
                st[k] = (float)a.x * cmax + bflo(xa[c]); st[k + 1] = (float)a.y * cmax + bfhi(xa[c]); ss += st[k] * st[k] + st[k + 1] * st[k + 1]; } }
        const float r = rsqrtf(wave_sum(ss) * (1.f / D) + EPS);
#pragma unroll
        for (int i = 0; i < 8; ++i) { const f32x4 g = *(const f32x4*)(gf + i * 256 + le * 4); f32x4 a;
#pragma unroll
            for (int c = 0; c < 4; ++c) a[c] = st[4 * i + c] * r * g[c];
            __builtin_nontemporal_store(a, (f32x4*)(out + ro + i * 256 + le * 4)); }
    }
}
__device__ __forceinline__ void p5_peer(const Ctx& F, const float* SC, const bf16* X1, const unsigned char* ED, const unsigned char* EU, const float* SD, const float* SU, const float* gf, float* out, const float* g2) {
    for (int tile = F.bid; tile < T / P5_TOK; tile += F.G)
        p5_wave(F.lds + F.wave * P5_WL2, SC, X1, ED, EU, SD, SU, gf, out, tile * P5_TOK + F.wave, F.lane, g2);
}

struct Args { const float* in[15]; float* out; unsigned char* ws; };
__global__ void __launch_bounds__(NTHR, 2) mega_fwd(Args args) {
    extern __shared__ __attribute__((aligned(16))) unsigned char lds_raw[];
    Ctx F; F.lds = (LAS unsigned char*)lds_raw; F.tid = threadIdx.x; F.lane = F.tid & 63; F.wave = __builtin_amdgcn_readfirstlane(F.tid >> 6); F.G = gridDim.x; F.bid = blockIdx.x;
    volatile LAS unsigned* MISC = (volatile LAS unsigned*)(F.lds + MISC_OFF);
    unsigned char* ws = args.ws; unsigned* ctl = (unsigned*)(ws + WS_CTL);
    const float* x = args.in[0]; const float* norm1_g = args.in[1]; const float* w_in = args.in[2]; const float* sgu_ln_g = args.in[3]; const float* sgu_ln_b = args.in[4];
    const float* w_spatial = args.in[5]; const float* b_spatial = args.in[6]; const float* attn_sinks = args.in[7]; const float* w_out = args.in[8]; const float* norm2_g = args.in[9];
    const float* w_query = args.in[10]; const float* sub_keys = args.in[11]; const float* expert_down = args.in[12]; const float* expert_up = args.in[13]; const float* norm_f_g = args.in[14];
    bf16* WinT = (bf16*)(ws + WS_WIN); bf16* WoutT = (bf16*)(ws + WS_WOUT); bf16* WeffT = (bf16*)(ws + WS_WEFF); bf16* H = (bf16*)(ws + WS_H);
    bf16* Z = (bf16*)(ws + WS_Z); bf16* MIX = (bf16*)(ws + WS_MIX); bf16* X1 = (bf16*)(ws + WS_X1); float* SC = (float*)(ws + WS_SC);
    unsigned char* ED = ws + WS_ED; unsigned char* EU = ws + WS_EU; float* SD = (float*)(ws + WS_SD); float* SU = (float*)(ws + WS_SU);
    for (int u = F.tid; u < (LDS_BYTES - LDSCTL_OFF) / 4; u += NTHR) ((LAS unsigned*)(F.lds + LDSCTL_OFF))[u] = 0u;
    __syncthreads();
    XcdBarrier bar = xcd_barrier_post(ctl + CW_BAR, MISC + 8);
#ifdef TP_PHASE
    volatile unsigned long long* tsp = (volatile unsigned long long*)(ws + WS_TP);
#define TP_BEGIN(k) do { if ((k) == TP_PHASE && F.bid == 0 && F.tid == 0) tsp[0] = wall_clock64(); } while (0)
#define TP_END(k) do { if ((k) == TP_PHASE && F.bid == 0 && F.tid == 0) tsp[1] = wall_clock64() - tsp[0]; } while (0)
#else
#define TP_BEGIN(k) do { } while (0)
#define TP_END(k) do { } while (0)
#endif
    TP_BEGIN(0);

    for (int rep = 0; rep < REP_P0; ++rep) p0_prologue(F, x, norm1_g, w_in, w_out, w_query, sub_keys, expert_down, expert_up, WinT, WoutT, WeffT, H, ED, EU, SD, SU, norm2_g);
    xcd_barrier(bar); TP_END(0); TP_BEGIN(1);
#if defined(TP_PHASE) && TP_PHASE == 11
    if (F.bid == F.G - 1 && F.tid == 0) tsp[0] = wall_clock64();
#endif
    for (int rep_ = 0; rep_ < REP_P1; ++rep_)
    {   pg8::Gemm g{H, WinT, T, NIN, D}; pg8::StaticOrder S; S.init(T, NIN, F.G, F.bid);
        pg8::EpiZ E{Z, NIN, 8};
        pg8::gemm_phase<pg8::EpiZ, pg8::StaticOrder, true, true>(F.lds + RING_OFF, g, S, E); }
    {
        const int nU = (T / 256) * (NIN / 256), maxu = (nU + F.G - 1) / F.G, nfull = nU - (maxu - 1) * F.G;
        const bool all = nfull == F.G; const int nidle = all ? F.G : F.G - nfull, q = all ? F.bid : F.bid - nfull;
        if (q >= 0) convert_rows(expert_down, expert_up, ED, EU, SD, SU, CONV_SPLIT, 2 * NE, q * NWAVES + F.wave, nidle * NWAVES, F.lane);
#if defined(TP_PHASE) && TP_PHASE == 11
        __syncthreads(); if (F.bid == F.G - 1 && F.tid == 0) tsp[1] = wall_clock64() - tsp[0];
#endif
    }
    xcd_barrier(bar); TP_END(1); TP_BEGIN(2);
    for (int rep = 0; rep < REP_P2; ++rep) { p2_sgu(F, Z, sgu_ln_g, sgu_ln_b, w_spatial, b_spatial, MIX); p2_attn(F, Z, attn_sinks, MIX); }
    {   pg8::Gemm g{MIX, WoutT, T, D, D}; pg8::StaticOrder S; S.init(T, D, F.G, F.bid);
        pg8::EpiX1 E{x, X1, D};
        pg8::f32x4 acc[2][2][4][2]; pg8::Unit u0; const bool has0 = S.next(0, u0);
        const int wr_ = F.wave >> 2, wc_ = F.wave & 3, fr_ = F.lane & 15, fq_ = F.lane >> 4;
        xcd_barrier_pre(bar, [&]() { if (has0) E.init(acc, u0, wr_, wc_, fr_, fq_); }); TP_END(2); TP_BEGIN(3);
        pg8::gemm_phase_acc<pg8::EpiX1, pg8::StaticOrder, true, true, true>(F.lds + RING_OFF, g, S, E, acc); }
    xcd_barrier(bar); TP_END(3); TP_BEGIN(4);
    {   pg8::Gemm g{X1, WeffT, T, D, D}; pg8::StaticOrder S; S.init(T, D, F.G, F.bid);
        pg8::EpiF32<false> E{nullptr, SC, D};
        pg8::gemm_phase<pg8::EpiF32<false>, pg8::StaticOrder, true, true>(F.lds + RING_OFF, g, S, E); }
    xcd_barrier(bar); TP_END(4); TP_BEGIN(5);
    for (int rep = 0; rep < REP_P5; ++rep) p5_peer(F, SC, X1, ED, EU, SD, SU, norm_f_g, args.out, norm2_g);
#ifdef TP_PHASE
    xcd_barrier(bar); TP_END(5);
    if (F.bid == 0 && F.tid == 0) { const unsigned long long t0 = wall_clock64(), w = (unsigned long long)TP_W * tsp[1]; while (wall_clock64() - t0 < w) __builtin_amdgcn_s_sleep(16); }
#endif
}

extern "C" void kernel_launch(void* const* d_in, const int* in_sizes, int n_in, void* d_out, int out_size, void* d_ws, size_t ws_size, hipStream_t stream) {
    static int grid = 0;
    if (grid == 0) {
        if (n_in != 15 || ws_size < WS_END) { fprintf(stderr, "kernel_launch: unexpected inputs / workspace\n"); grid = -1; return; }
        int dev = 0, cus = 0, per_cu = 0;
        if (hipGetDevice(&dev) != hipSuccess || hipDeviceGetAttribute(&cus, hipDeviceAttributeMultiprocessorCount, dev) != hipSuccess) { grid = -1; return; }
        if (hipFuncSetAttribute((const void*)mega_fwd, hipFuncAttributeMaxDynamicSharedMemorySize, LDS_BYTES) != hipSuccess) { fprintf(stderr, "kernel_launch: hipFuncSetAttribute failed\n"); grid = -1; return; }
        if (hipOccupancyMaxActiveBlocksPerMultiprocessor(&per_cu, (const void*)mega_fwd, NTHR, LDS_BYTES) != hipSuccess || per_cu < 1)
            fprintf(stderr, "kernel_launch: note: occupancy query reports %d workgroups per CU\n", per_cu);
        (void)hipGetLastError();
        grid = cus;
    }
    if (grid < 0) return;
    if (hipMemsetAsync((char*)d_ws + WS_CTL, 0, CTL_ZERO_BYTES, stream) != hipSuccess) return;
    Args a{};
    for (int i = 0; i < 15; ++i) a.in[i] = (const float*)d_in[i];
    a.out = (float*)d_out; a.ws = (unsigned char*)d_ws;
    hipLaunchKernelGGL(mega_fwd, dim3(grid), dim3(NTHR), LDS_BYTES, stream, a);
}
```

```cpp
#include <hip/hip_runtime.h>
#include <cstdio>
#include <cstdint>
#include <math.h>
namespace pg8 {
#define PG8_LAS __attribute__((address_space(3)))
typedef unsigned short bf16_t;
typedef short bf16x8 __attribute__((ext_vector_type(8)));
typedef float f32x4 __attribute__((ext_vector_type(4)));
typedef unsigned u32x4 __attribute__((ext_vector_type(4)));
constexpr int BM = 256, BK = 64, HALF = 128, HTB = HALF * BK * 2  , STAGE_BYTES = 8 * HTB, NXCD = 8, WGM = 8;

__host__ __device__ __forceinline__ int lds_byte(int r, int c) { const int st = (r >> 4) * 2 + (c >> 5), rr = r & 15, cc = c & 31, ob = rr * 64 + cc * 2; return st * 1024 + (ob ^ (((ob >> 9) & 1) << 5)); }
__host__ __device__ __forceinline__ void stage_rc(int b, int& R, int& C) { const int st = b / 1024, sb = b % 1024, swz = sb ^ (((sb >> 9) & 1) << 5); R = (st >> 1) * 16 + swz / 64; C = (st & 1) * 32 + (swz % 64) / 2; }
__host__ __device__ __forceinline__ int perm32(int rho) { const int n = rho >> 4, i = rho & 15; return 8 * (i >> 2) + 4 * n + (i & 3); }

struct Unit { int pm, pn; };
struct Gemm { const bf16_t* A; const bf16_t* Bt; int M, N, K; };

struct StaticOrder {
    int nM, nN, nwg, G, c;
    __host__ __device__ void init(int M, int N, int G_, int c_) { nM = M / BM; nN = N / BM; nwg = nM * nN; G = G_; c = c_; }
    __host__ __device__ bool next(int i, Unit& u) const {
        const long L = (long)i * G + c; if (L >= nwg) return false;
        int wgid = (int)L; { const int q = nwg / NXCD, r = nwg % NXCD, xcd = wgid % NXCD, off = wgid / NXCD; wgid = (xcd < r ? xcd * (q + 1) : r * (q + 1) + (xcd - r) * q) + off; }
        const int nig = WGM * nN, gid = wgid / nig, fm = gid * WGM, gsz = (nM - fm) < WGM ? (nM - fm) : WGM;
        u.pm = fm + ((wgid % nig) % gsz); u.pn = (wgid % nig) / gsz; return true;
    }
    __device__ __forceinline__ void a_ready(const Unit&) const {}
    __device__ __forceinline__ void done(const Unit&) const {}
};

__device__ __forceinline__ unsigned cvt_pk_bf16(float lo, float hi) { unsigned r; asm volatile("v_cvt_pk_bf16_f32 %0, %1, %2" : "=v"(r) : "v"(lo), "v"(hi)); return r; }
typedef float f32x2 __attribute__((ext_vector_type(2)));
__device__ __forceinline__ f32x2 gelu_pk(f32x2 v) {
    const f32x2 av = __builtin_elementwise_abs(v), d = av * 0.2316418882f + 1.0f;
    f32x2 t; t.x = __builtin_amdgcn_rcpf(d.x); t.y = __builtin_amdgcn_rcpf(d.y);
    f32x2 q = t * 0.5307027145f + (-0.7265760135f); q = q * t + 0.7107068705f; q = q * t + (-0.142248368f); q = q * t + 0.127414796f; q = q * t;
    const f32x2 s = (v * v) * (-0.72134752044f);
    f32x2 e; e.x = __builtin_amdgcn_exp2f(s.x); e.y = __builtin_amdgcn_exp2f(s.y);
    const f32x2 m = v * (q * e), r = v - m;
    f32x2 o; o.x = v.x < 0.f ? m.x : r.x; o.y = v.y < 0.f ? m.y : r.y; return o;
}
struct EpiZ {
    static constexpr bool PERM = true, AFTER_DRAIN = false;
    bf16_t* O; int ldc; int gelu_tiles;
    __device__ __forceinline__ void operator()(const f32x4 (&acc)[2][2][4][2], const Unit& u, int wr, int wc, int fr, int fq) const {
        const int row0 = u.pm * BM + wr * 64 + fr, col0 = u.pn * BM + wc * 32 + 8 * fq;
        const bool act = u.pn < gelu_tiles;
#pragma unroll
        for (int ai = 0; ai < 2; ++ai)
#pragma unroll
            for (int m = 0; m < 4; ++m) { bf16_t* rowp = O + (size_t)(row0 + ai * HALF + m * 16) * ldc + col0;
#pragma unroll
                for (int bj = 0; bj < 2; ++bj) { f32x4 v0 = acc[ai][bj][m][0], v1 = acc[ai][bj][m][1];
                    if (act) { f32x2 a = gelu_pk((f32x2){v0[0], v0[1]}), b = gelu_pk((f32x2){v0[2], v0[3]}), c = gelu_pk((f32x2){v1[0], v1[1]}), d = gelu_pk((f32x2){v1[2], v1[3]});
                        v0 = (f32x4){a.x, a.y, b.x, b.y}; v1 = (f32x4){c.x, c.y, d.x, d.y}; }
                    u32x4 w; w.x = cvt_pk_bf16(v0[0], v0[1]); w.y = cvt_pk_bf16(v0[2], v0[3]); w.z = cvt_pk_bf16(v1[0], v1[1]); w.w = cvt_pk_bf16(v1[2], v1[3]);
                    *(u32x4*)(rowp + bj * HALF) = w; } }
    }
};
template <bool RES> struct EpiF32 {
    static constexpr bool PERM = false, AFTER_DRAIN = false;
    const float* base; float* C; int ldc;
    __device__ __forceinline__ void operator()(const f32x4 (&acc)[2][2][4][2], const Unit& u, int wr, int wc, int fr, int fq) const {
        const int row0 = u.pm * BM + wr * 64 + fr, col0 = u.pn * BM + wc * 32 + 4 * fq;
#pragma unroll
        for (int ai = 0; ai < 2; ++ai)
#pragma unroll
            for (int m = 0; m < 4; ++m) { const size_t off = (size_t)(row0 + ai * HALF + m * 16) * ldc + col0;
#pragma unroll
                for (int bj = 0; bj < 2; ++bj)
#pragma unroll
                    for (int n = 0; n < 2; ++n) { const size_t o = off + bj * HALF + n * 16; f32x4 v = acc[ai][bj][m][n];
                        if (RES) v = v + *(const f32x4*)(base + o);
                        *(f32x4*)(C + o) = v; } }
    }
};
struct EpiX1 {
    static constexpr bool PERM = false, AFTER_DRAIN = false;
    const float* base; bf16_t* X1; int ldc;
    __device__ __forceinline__ void init(f32x4 (&acc)[2][2][4][2], const Unit& u, int wr, int wc, int fr, int fq) const {
        const int row0 = u.pm * BM + wr * 64 + fr, col0 = u.pn * BM + wc * 32 + 4 * fq;
#pragma unroll
        for (int ai = 0; ai < 2; ++ai)
#pragma unroll
            for (int m = 0; m < 4; ++m) { const size_t off = (size_t)(row0 + ai * HALF + m * 16) * ldc + col0;
#pragma unroll
                for (int bj = 0; bj < 2; ++bj)
#pragma unroll
                    for (int n = 0; n < 2; ++n) acc[ai][bj][m][n] = *(const f32x4*)(base + off + bj * HALF + n * 16); }
    }
    __device__ __forceinline__ void operator()(const f32x4 (&acc)[2][2][4][2], const Unit& u, int wr, int wc, int fr, int fq) const {
        const int row0 = u.pm * BM + wr * 64 + fr, col0 = u.pn * BM + wc * 32 + 4 * fq;
        typedef __bf16 bf2 __attribute__((ext_vector_type(2)));
        typedef unsigned u2 __attribute__((ext_vector_type(2)));
#pragma unroll
        for (int ai = 0; ai < 2; ++ai)
#pragma unroll
            for (int m = 0; m < 4; ++m) { const size_t off = (size_t)(row0 + ai * HALF + m * 16) * ldc + col0;
#pragma unroll
                for (int bj = 0; bj < 2; ++bj)
#pragma unroll
                    for (int n = 0; n < 2; ++n) { const f32x4 v = acc[ai][bj][m][n]; const f32x2 lo = {v[0], v[1]}, hi = {v[2], v[3]};
                        u2 pk; pk.x = __builtin_bit_cast(unsigned, __builtin_convertvector(lo, bf2)); pk.y = __builtin_bit_cast(unsigned, __builtin_convertvector(hi, bf2));
                        *(u2*)(X1 + off + bj * HALF + n * 16) = pk; } }
    }
};
template <class Epi, class Sched, bool ALIGN_EPI = false, bool SP2 = false, bool PRE = false>
__device__ __forceinline__ void gemm_phase_acc(PG8_LAS unsigned char* lds, const Gemm g, const Sched& S, const Epi& E, f32x4 (&acc)[2][2][4][2]) {
    const int tid = threadIdx.x, wid = __builtin_amdgcn_readfirstlane(tid >> 6), lane = tid & 63, wr = wid >> 2, wc = wid & 3, fr = lane & 15, fq = lane >> 4;
    const int K = g.K, nt = K / BK;
    unsigned voffA[2], voffB[2];
#pragma unroll
    for (int i = 0; i < 2; ++i) { int R, C; stage_rc(tid * 16 + i * 8192, R, C); const int Rb = Epi::PERM ? ((R & ~31) + perm32(R & 31)) : R;
        voffA[i] = (unsigned)(R * K + C) * 2u; voffB[i] = (unsigned)(Rb * K + C) * 2u; }
    const size_t kstep = (size_t)(BK * 2);
    const size_t hstep = (size_t)HALF * K * 2;
    const size_t tstep = 2 * hstep;
    const unsigned ldsw = (unsigned)wid * 1024u;
    const int aoff = lds_byte(wr * 64 + fr, fq * 8), boff = lds_byte(wc * 32 + fr, fq * 8);
#define PG8_SA(b, h) (((b) * 2 + (h)) * HTB)
#define PG8_SB(b, h) ((4 + (b) * 2 + (h)) * HTB)
#define PG8_STAGE(bufoff, gbase, voff) do { _Pragma("unroll") for (int _i = 0; _i < 2; ++_i) \
        __builtin_amdgcn_global_load_lds((const unsigned*)((const char*)(gbase) + (voff)[_i]), (PG8_LAS unsigned*)(lds + (bufoff) + ldsw + _i * 8192), 16, 0, 0); } while (0)
#define PG8_LDA(dst, b, h) do { _Pragma("unroll") for (int m = 0; m < 4; ++m) _Pragma("unroll") for (int k = 0; k < 2; ++k) dst[m][k] = *(const PG8_LAS bf16x8*)(lds + PG8_SA(b, h) + aoff + m * 2048 + k * 1024); } while (0)
#define PG8_LDB(dst, b, h) do { _Pragma("unroll") for (int n = 0; n < 2; ++n) _Pragma("unroll") for (int k = 0; k < 2; ++k) dst[n][k] = *(const PG8_LAS bf16x8*)(lds + PG8_SB(b, h) + boff + n * 2048 + k * 1024); } while (0)
#define PG8_MMA(ai, bj, At, Bt) do { __builtin_amdgcn_s_setprio(1); _Pragma("unroll") for (int m = 0; m < 4; ++m) _Pragma("unroll") for (int n = 0; n < 2; ++n) _Pragma("unroll") for (int k = 0; k < 2; ++k) \
        acc[ai][bj][m][n] = __builtin_amdgcn_mfma_f32_16x16x32_bf16(Bt[n][k], At[m][k], acc[ai][bj][m][n], 0, 0, 0); __builtin_amdgcn_s_setprio(0); } while (0)
#define PG8_WAIT_V(n) asm volatile("s_waitcnt vmcnt(" #n ")" ::: "memory")
#define PG8_WAIT_L(n) asm volatile("s_waitcnt lgkmcnt(" #n ")" ::: "memory")
#define PG8_BAR __builtin_amdgcn_s_barrier()
#define PG8_SCHED __builtin_amdgcn_sched_barrier(0)
    Unit cur, nxt; int ui = 0;
    if (!S.next(0, cur)) return;
    if constexpr (!PRE) {
#pragma unroll
    for (int a = 0; a < 2; ++a)
#pragma unroll
        for (int b = 0; b < 2; ++b)
#pragma unroll
            for (int m = 0; m < 4; ++m)
#pragma unroll
                for (int n = 0; n < 2; ++n) acc[a][b][m][n] = (f32x4){0.f, 0.f, 0.f, 0.f};
    }
    bf16x8 At[4][2], B0[2][2], B1[2][2];
    const char* cA = (const char*)g.A + (size_t)cur.pm * tstep; const char* cB = (const char*)g.Bt + (size_t)cur.pn * tstep;
    S.a_ready(cur);
    if constexpr (SP2) {
        PG8_STAGE(PG8_SB(0, 0), cB, voffB); PG8_STAGE(PG8_SB(0, 1), cB + hstep, voffB); PG8_STAGE(PG8_SA(0, 0), cA, voffA); PG8_STAGE(PG8_SA(0, 1), cA + hstep, voffA);
        if (wr == 1) PG8_BAR;
        PG8_WAIT_V(2); PG8_BAR;
        PG8_STAGE(PG8_SB(1, 0), cB + kstep, voffB); PG8_STAGE(PG8_SA(1, 0), cA + kstep, voffA); PG8_STAGE(PG8_SB(1, 1), cB + hstep + kstep, voffB);
        PG8_WAIT_V(6); PG8_BAR;
    } else {
        PG8_STAGE(PG8_SB(0, 0), cB, voffB); PG8_STAGE(PG8_SA(0, 0), cA, voffA); PG8_STAGE(PG8_SB(0, 1), cB + hstep, voffB); PG8_STAGE(PG8_SA(0, 1), cA + hstep, voffA);
        if (wr == 1) PG8_BAR;
        PG8_WAIT_V(4); PG8_BAR;
        PG8_STAGE(PG8_SB(1, 0), cB + kstep, voffB); PG8_STAGE(PG8_SA(1, 0), cA + kstep, voffA); PG8_STAGE(PG8_SB(1, 1), cB + hstep + kstep, voffB);
        PG8_WAIT_V(6); PG8_BAR;
    }
    for (;;) {
        const bool has_next = S.next(ui + 1, nxt);
        const char* nA = has_next ? (const char*)g.A + (size_t)nxt.pm * tstep : cA; const char* nB = has_next ? (const char*)g.Bt + (size_t)nxt.pn * tstep : cB;
        for (int t = 0; t < nt; t += 2) {
            const bool last = (t == nt - 2);
            const char* a1 = cA + (size_t)(t + 1) * kstep;
            const char* a2 = last ? nA : cA + (size_t)(t + 2) * kstep; const char* b2 = last ? nB : cB + (size_t)(t + 2) * kstep;
            const char* a3 = a2 + kstep; const char* b3 = b2 + kstep;
            if (last && has_next) S.a_ready(nxt);
            if constexpr (SP2) {
            PG8_LDB(B0, 0, 0); PG8_LDB(B1, 0, 1); PG8_SCHED; PG8_LDA(At, 0, 0); PG8_STAGE(PG8_SA(1, 1), a1 + hstep, voffA);
            PG8_WAIT_V(8); PG8_WAIT_L(0); PG8_BAR; PG8_MMA(0, 0, At, B0); PG8_MMA(0, 1, At, B1); PG8_BAR; PG8_SCHED;
            PG8_LDA(At, 0, 1); PG8_STAGE(PG8_SB(0, 0), b2, voffB); PG8_STAGE(PG8_SB(0, 1), b2 + hstep, voffB); PG8_STAGE(PG8_SA(0, 0), a2, voffA);
            PG8_WAIT_V(8); PG8_WAIT_L(0); PG8_BAR; PG8_MMA(1, 0, At, B0); PG8_MMA(1, 1, At, B1); PG8_BAR; PG8_SCHED;
            PG8_LDB(B0, 1, 0); PG8_LDB(B1, 1, 1); PG8_SCHED; PG8_LDA(At, 1, 0); PG8_STAGE(PG8_SA(0, 1), a2 + hstep, voffA);
            PG8_WAIT_V(8); PG8_WAIT_L(0); PG8_BAR; PG8_MMA(0, 0, At, B0); PG8_MMA(0, 1, At, B1); PG8_BAR; PG8_SCHED;
            PG8_LDA(At, 1, 1); PG8_STAGE(PG8_SB(1, 0), b3, voffB); PG8_STAGE(PG8_SB(1, 1), b3 + hstep, voffB); PG8_STAGE(PG8_SA(1, 0), a3, voffA);
            PG8_WAIT_V(8); PG8_WAIT_L(0); PG8_BAR; PG8_MMA(1, 0, At, B0); PG8_MMA(1, 1, At, B1); PG8_BAR; PG8_SCHED;
            } else {
            PG8_LDB(B0, 0, 0); PG8_SCHED; PG8_LDA(At, 0, 0); PG8_STAGE(PG8_SA(1, 1), a1 + hstep, voffA);
            PG8_WAIT_L(8); PG8_BAR; PG8_WAIT_L(0); PG8_MMA(0, 0, At, B0); PG8_BAR; PG8_SCHED;
            PG8_LDB(B1, 0, 1); PG8_STAGE(PG8_SB(0, 0), b2, voffB);
            PG8_BAR; PG8_WAIT_L(0); PG8_MMA(0, 1, At, B1); PG8_BAR;
            PG8_LDA(At, 0, 1); PG8_STAGE(PG8_SA(0, 0), a2, voffA);
            PG8_BAR; PG8_WAIT_L(0); PG8_MMA(1, 0, At, B0); PG8_BAR; PG8_SCHED;
            PG8_STAGE(PG8_SB(0, 1), b2 + hstep, voffB);
            PG8_WAIT_V(6); PG8_BAR; PG8_MMA(1, 1, At, B1); PG8_BAR;
            PG8_LDB(B0, 1, 0); PG8_SCHED; PG8_LDA(At, 1, 0); PG8_STAGE(PG8_SA(0, 1), a2 + hstep, voffA);
            PG8_WAIT_L(8); PG8_BAR; PG8_WAIT_L(0); PG8_MMA(0, 0, At, B0); PG8_BAR; PG8_SCHED;
            PG8_LDB(B1, 1, 1); PG8_STAGE(PG8_SB(1, 0), b3, voffB);
            PG8_BAR; PG8_WAIT_L(0); PG8_MMA(0, 1, At, B1); PG8_BAR;
            PG8_LDA(At, 1, 1); PG8_STAGE(PG8_SA(1, 0), a3, voffA);
            PG8_BAR; PG8_WAIT_L(0); PG8_MMA(1, 0, At, B0); PG8_BAR; PG8_SCHED;
            PG8_STAGE(PG8_SB(1, 1), b3 + hstep, voffB);
            PG8_WAIT_V(6); PG8_BAR; PG8_MMA(1, 1, At, B1); PG8_BAR;
            }
        }
        if constexpr (ALIGN_EPI) { if (wr == 0) PG8_BAR; }
        if constexpr (!Epi::AFTER_DRAIN) { E(acc, cur, wr, wc, fr, fq); S.done(cur); }
        if (!has_next) break;
        if constexpr (PRE) E.init(acc, nxt, wr, wc, fr, fq);
        else {
#pragma unroll
        for (int a = 0; a < 2; ++a)
#pragma unroll
            for (int b = 0; b < 2; ++b)
#pragma unroll
                for (int m = 0; m < 4; ++m)
#pragma unroll
                    for (int n = 0; n < 2; ++n) acc[a][b][m][n] = (f32x4){0.f, 0.f, 0.f, 0.f};
        }
        cur = nxt; cA = nA; cB = nB; ++ui;
        if constexpr (ALIGN_EPI) { if (wr == 1) PG8_BAR; }
    }
    PG8_WAIT_V(0);
    if constexpr (!ALIGN_EPI) { if (wr == 0) PG8_BAR; }
    PG8_BAR;
    if constexpr (Epi::AFTER_DRAIN) { E.fused(acc, cur, wr, wc, fr, fq, lds, wid, lane); S.done(cur); }
#undef PG8_SA
#undef PG8_SB
#undef PG8_STAGE
#undef PG8_LDA
#undef PG8_LDB
#undef PG8_MMA
#undef PG8_WAIT_V
#undef PG8_WAIT_L
#undef PG8_BAR
#undef PG8_SCHED
}
template <class Epi, class Sched, bool ALIGN_EPI = false, bool SP2 = false>
__device__ __forceinline__ void gemm_phase(PG8_LAS unsigned char* lds, const Gemm g, const Sched& S, const Epi& E) { f32x4 acc[2][2][4][2]; gemm_phase_acc<Epi, Sched, ALIGN_EPI, SP2, false>(lds, g, S, E, acc); }
}
#ifndef REP_P5
#define REP_P5 1
#endif
#ifndef REP_P0
#define REP_P0 1
#endif
#ifndef REP_P1
#define REP_P1 1
#endif
#ifndef REP_P4
#define REP_P4 1
#endif
#ifndef REP_P0B
#define REP_P0B 1
#endif
#ifndef REP_P0C
#define REP_P0C 1
#endif
#ifndef REP_P2
#define REP_P2 1
#endif
constexpr int T = 8192, D = 2048, NIN = 3328, SEQ = 2048, NE = 16384;
constexpr float EPS = 1e-6f;
constexpr int NWAVES = 8, NTHR = 512;
constexpr size_t MiB = 1u << 20;
constexpr size_t WS_CTL = 0, CTL_ZERO_BYTES = 1 * MiB;
constexpr size_t WS_WIN = 2 * MiB;
constexpr size_t WS_WOUT = 16 * MiB;
constexpr size_t WS_WEFF = 24 * MiB;
constexpr size_t WS_H = 32 * MiB;
constexpr size_t WS_Z = 64 * MiB;
constexpr size_t WS_MIX = 116 * MiB;
constexpr size_t WS_X1 = 148 * MiB;
constexpr size_t WS_SC = 212 * MiB;
constexpr size_t WS_ED = 284 * MiB;
constexpr size_t WS_EU = 316 * MiB;
constexpr int ROWB = 1536;
constexpr size_t WS_SD = 348 * MiB;
constexpr size_t WS_SU = 348 * MiB + 65536;
constexpr size_t WS_TP = 348 * MiB + 196608;
constexpr size_t WS_END = 349 * MiB;
constexpr int CW_TMO = 0, CW_BAR = 4096;
constexpr int RING_OFF = 0, RING_BYTES = 131072;
constexpr int LDSCTL_OFF = RING_BYTES, MISC_OFF = LDSCTL_OFF + 320;
constexpr int LDS_BYTES = 163840;

#define GAS __attribute__((address_space(1)))
#define LAS __attribute__((address_space(3)))
typedef unsigned short bf16;
typedef unsigned v4u __attribute__((ext_vector_type(4)));
typedef unsigned v2u __attribute__((ext_vector_type(2)));
typedef float f32x4 __attribute__((ext_vector_type(4)));
typedef GAS unsigned gu32;
#define LDS_WAIT() asm volatile("s_waitcnt lgkmcnt(0)" ::: "memory")
#define VM_WAIT() asm volatile("s_waitcnt vmcnt(0)" ::: "memory")
__device__ __forceinline__ unsigned f2bf(float f) { unsigned u = __builtin_bit_cast(unsigned, f); return (u + 0x7fffu + ((u >> 16) & 1u)) >> 16; }
__device__ __forceinline__ unsigned pk2(float lo, float hi) { return f2bf(lo) | (f2bf(hi) << 16); }
__device__ __forceinline__ float bf2f(bf16 h) { return __uint_as_float(((unsigned)h) << 16); }
__device__ __forceinline__ float bflo(unsigned w) { return __uint_as_float(w << 16); }
__device__ __forceinline__ float bfhi(unsigned w) { return __uint_as_float(w & 0xffff0000u); }
__device__ __forceinline__ float gelu_erf(float v) { return 0.5f * v * (1.0f + erff(v * 0.70710678118654752f)); }
__device__ __forceinline__ float wave_sum(float v) {
#pragma unroll
    for (int o = 1; o < 64; o <<= 1) v += __shfl_xor(v, o);
    return v;
}

#define XB_TMO      128
#define XB_XCNT(j)  (256  + 64 * (j))
#define XB_XSUB(j)  (1280 + 64 * (j))
#define XB_XGEN(j)  (2304 + 64 * (j))
#define XB_TOP      3328
#define XB_TOPGEN   3392
#define XCD_BAR_WORDS 3456
#define XB_SPIN_CAP (1u << 18)

__device__ __forceinline__ unsigned xb_ld(unsigned* p)              { return __hip_atomic_load(p, __ATOMIC_RELAXED, __HIP_MEMORY_SCOPE_AGENT); }
__device__ __forceinline__ unsigned xb_add(unsigned* p, unsigned v) { return __hip_atomic_fetch_add(p, v, __ATOMIC_RELAXED, __HIP_MEMORY_SCOPE_AGENT); }
__device__ __forceinline__ unsigned xb_xcc_id() { return (unsigned)__builtin_amdgcn_s_getreg((3 << 11) | 20) & 0xFu; }
#define XB_SPIN(cond, bar) do { unsigned _sp = 0; while (cond) { __builtin_amdgcn_s_sleep(1); \
    if ((++_sp & 255u) == 0u) { if (xb_ld(&(bar)[XB_TMO])) break; if (_sp > XB_SPIN_CAP) { atomicAdd(&(bar)[XB_TMO], 1u); break; } } } } while (0)

struct XcdBarrier {
    unsigned* bar; unsigned x;
    volatile LAS unsigned* st;
};

__device__ __forceinline__ XcdBarrier xcd_barrier_post(unsigned* bar, volatile LAS unsigned* st) {
    XcdBarrier b; b.bar = bar; b.x = xb_xcc_id(); b.st = st;
    if (threadIdx.x == 0) (void)xb_add(&bar[XB_XCNT(b.x)], 1u);
    return b;
}
__device__ __forceinline__ void xcd_barrier_complete(unsigned* bar, unsigned x, unsigned& nloc, unsigned& nx) {
    const unsigned G = gridDim.x * gridDim.y * gridDim.z;
    unsigned sum, cnt, mine, sp = 0u;
    for (;;) {
        sum = 0u; cnt = 0u; mine = 0u;
#pragma unroll
        for (unsigned j = 0; j < 16; ++j) { const unsigned c = xb_ld(&bar[XB_XCNT(j)]); sum += c; cnt += (c > 0u) ? 1u : 0u; mine = (j == x) ? c : mine; }
        if (sum == G) break;
        __builtin_amdgcn_s_sleep(1);
        if ((++sp & 255u) == 0u) { if (xb_ld(&bar[XB_TMO])) break; if (sp > XB_SPIN_CAP) { atomicAdd(&bar[XB_TMO], 1u); break; } }
    }
    nloc = mine > 0u ? mine : 1u; nx = cnt > 0u ? cnt : 1u;
}

__device__ __forceinline__ void xcd_barrier_t0(const XcdBarrier& b) {
    {
        unsigned* bar = b.bar;
        __builtin_amdgcn_s_waitcnt(0);
        unsigned nloc = b.st[0], nx = b.st[1];
        if (nloc == 0u) { xcd_barrier_complete(bar, b.x, nloc, nx); b.st[0] = nloc; b.st[1] = nx; }
        const unsigned old = xb_add(&bar[XB_XSUB(b.x)], 1u);
        const unsigned gen = old / nloc;
        if (old + 1u == (gen + 1u) * nloc) {
            __builtin_amdgcn_fence(__ATOMIC_RELEASE, "agent");
            asm volatile("s_waitcnt vmcnt(0)" ::: "memory");
            const unsigned og = xb_add(&bar[XB_TOP], 1u);
            const unsigned tg = og / nx;
            if (og + 1u == (tg + 1u) * nx) xb_add(&bar[XB_TOPGEN], 1u);
            else XB_SPIN(xb_ld(&bar[XB_TOPGEN]) == tg, bar);
            __builtin_amdgcn_fence(__ATOMIC_ACQUIRE, "agent");
            xb_add(&bar[XB_XGEN(b.x)], 1u);
            asm volatile("s_waitcnt vmcnt(0)" ::: "memory");
        } else {
            XB_SPIN(xb_ld(&bar[XB_XGEN(b.x)]) == gen, bar);
            __builtin_amdgcn_fence(__ATOMIC_ACQUIRE, "agent");
            asm volatile("s_waitcnt vmcnt(0)" ::: "memory");
        }
    }
}
__device__ __forceinline__ void xcd_barrier(const XcdBarrier& b) {
    asm volatile("s_waitcnt vmcnt(0)" ::: "memory");
    __syncthreads();
    if (threadIdx.x == 0) xcd_barrier_t0(b);
    __syncthreads();
}
template <class Pre> __device__ __forceinline__ void xcd_barrier_pre(const XcdBarrier& b, const Pre& pre) {
    asm volatile("s_waitcnt vmcnt(0)" ::: "memory");
    __syncthreads();
    const int w_ = __builtin_amdgcn_readfirstlane((int)threadIdx.x >> 6);
    if (w_ != 0) pre();
    if (threadIdx.x == 0) xcd_barrier_t0(b);
    __syncthreads();
    if (w_ == 0) pre();
}

struct Ctx { LAS unsigned char* lds; int tid, lane, wave, G, bid; };

__device__ __forceinline__ void p0_transpose_item(const float* W, int K, int N, bf16* WT, LAS float* scr, int item, int lane) {
    const int nblk = N / 32, kb = item / nblk, nb = item % nblk, k0 = 64 * kb, n0 = 32 * nb;
    float wv[32];
#pragma unroll
    for (int i = 0; i < 32; ++i) wv[i] = W[(size_t)(k0 + 2 * i + (lane >> 5)) * N + n0 + (lane & 31)];
#pragma unroll
    for (int i = 0; i < 32; ++i) scr[(2 * i + (lane >> 5)) * 33 + (lane & 31)] = wv[i];
    LDS_WAIT(); asm volatile("" ::: "memory");
    const int c = lane & 7;
#pragma unroll
    for (int j = 0; j < 4; ++j) { const int n = (lane >> 3) + 8 * j; const LAS float* s = scr + (8 * c) * 33 + n;
        v4u o; o.x = pk2(s[0 * 33], s[1 * 33]); o.y = pk2(s[2 * 33], s[3 * 33]); o.z = pk2(s[4 * 33], s[5 * 33]); o.w = pk2(s[6 * 33], s[7 * 33]);
        *(v4u*)(WT + (size_t)(n0 + n) * K + k0 + 8 * c) = o; }
    LDS_WAIT(); asm volatile("" ::: "memory");
}
__device__ __forceinline__ void rms_row_to_bf16(const float* xr, const float* g, bf16* orow, int lane) {
    f32x4 v[8]; float s = 0.f;
#pragma unroll
    for (int j = 0; j < 8; ++j) { v[j] = *(const f32x4*)(xr + j * 256 + lane * 4); s += (v[j].x * v[j].x + v[j].y * v[j].y) + (v[j].z * v[j].z + v[j].w * v[j].w); }
    const float r = rsqrtf(wave_sum(s) * (1.f / D) + EPS);
#pragma unroll
    for (int j = 0; j < 8; ++j) { const f32x4 gg = *(const f32x4*)(g + j * 256 + lane * 4);
        v2u o; o.x = pk2(v[j].x * r * gg.x, v[j].y * r * gg.y); o.y = pk2(v[j].z * r * gg.z, v[j].w * r * gg.w);
        *(v2u*)(orow + j * 256 + lane * 4) = o; }
}
typedef float f32x2 __attribute__((ext_vector_type(2)));
typedef __bf16 bf16x2v __attribute__((ext_vector_type(2)));
__device__ __forceinline__ unsigned cvtpk(float lo, float hi) { const f32x2 v = {lo, hi}; return __builtin_bit_cast(unsigned, __builtin_convertvector(v, bf16x2v)); }
typedef short bf16x8 __attribute__((ext_vector_type(8)));
typedef float f32x16 __attribute__((ext_vector_type(16)));
__device__ __forceinline__ bf16x8 pack8(float a0, float a1, float a2, float a3, float a4, float a5, float a6, float a7) {
    v4u w; w.x = cvtpk(a0, a1); w.y = cvtpk(a2, a3); w.z = cvtpk(a4, a5); w.w = cvtpk(a6, a7); return __builtin_bit_cast(bf16x8, w); }
__device__ __forceinline__ void split8(const f32x4 a0, const f32x4 a1, bf16x8& hi, bf16x8& lo) {
    hi = pack8(a0[0], a0[1], a0[2], a0[3], a1[0], a1[1], a1[2], a1[3]);
    const v4u w = __builtin_bit_cast(v4u, hi);
    lo = pack8(a0[0] - bflo(w[0]), a0[1] - bfhi(w[0]), a0[2] - bflo(w[1]), a0[3] - bfhi(w[1]), a1[0] - bflo(w[2]), a1[1] - bfhi(w[2]), a1[2] - bflo(w[3]), a1[3] - bfhi(w[3]));
}
typedef __bf16 bf16x32 __attribute__((ext_vector_type(32)));
typedef unsigned v6u __attribute__((ext_vector_type(6)));
typedef float f32x32 __attribute__((ext_vector_type(32)));
__device__ __forceinline__ void p0_rows_to_fp6(const float* ra, const float* rb, unsigned char* da, unsigned char* db, float* ia, float* ib, int lane) {
    f32x4 va[8], vb[8]; float ma = 0.f, mb = 0.f;
#pragma unroll
    for (int i = 0; i < 8; ++i) { va[i] = __builtin_nontemporal_load((const f32x4*)(ra + i * 256 + lane * 4)); vb[i] = __builtin_nontemporal_load((const f32x4*)(rb + i * 256 + lane * 4)); }
#pragma unroll
    for (int i = 0; i < 8; ++i) { const f32x4 t = va[i], u = vb[i];
        ma = fmaxf(fmaxf(ma, fmaxf(fabsf(t.x), fabsf(t.y))), fmaxf(fabsf(t.z), fabsf(t.w))); mb = fmaxf(fmaxf(mb, fmaxf(fabsf(u.x), fabsf(u.y))), fmaxf(fabsf(u.z), fabsf(u.w))); }
#pragma unroll
    for (int o = 1; o < 64; o <<= 1) { ma = fmaxf(ma, __shfl_xor(ma, o)); mb = fmaxf(mb, __shfl_xor(mb, o)); }
    const float sa = ma > 0.f ? 7.f / ma : 0.f, sb = mb > 0.f ? 7.f / mb : 0.f;
    bf16x32 xa, xb;
#pragma unroll
    for (int k = 0; k < 32; ++k) { xa[k] = (__bf16)(va[k >> 2][k & 3] * sa); xb[k] = (__bf16)(vb[k >> 2][k & 3] * sb); }
    const v6u pa = __builtin_amdgcn_cvt_scalef32_pk32_fp6_bf16(xa, 1.0f), pb = __builtin_amdgcn_cvt_scalef32_pk32_fp6_bf16(xb, 1.0f);
#pragma unroll
    for (int q = 0; q < 3; ++q) { *(v2u*)(da + 24 * lane + 8 * q) = (v2u){pa[2 * q], pa[2 * q + 1]}; *(v2u*)(db + 24 * lane + 8 * q) = (v2u){pb[2 * q], pb[2 * q + 1]}; }
    if (lane == 0) { *ia = ma * (1.f / 7.f); *ib = mb * (1.f / 7.f); }
}
constexpr int CONV_SPLIT = 12800;
__device__ __forceinline__ void convert_rows(const float* e_down, const float* e_up, unsigned char* ED, unsigned char* EU, float* SD, float* SU, int r_lo, int r_hi, int w, int nw, int lane) {
    for (int r = r_lo + 2 * w; r < r_hi; r += 2 * nw) {
        const bool up = r >= NE; const int row = up ? r - NE : r;
        const float* s = (up ? e_up : e_down) + (size_t)row * D; unsigned char* d = (up ? EU : ED) + (size_t)row * ROWB; float* iv = (up ? SU : SD) + row;
        p0_rows_to_fp6(s, s + D, d, d + ROWB, iv, iv + 1, lane);
    }
}
__device__ __forceinline__ void p0_prologue(const Ctx& F, const float* x, const float* g1, const float* w_in, const float* w_out, const float* wq, const float* sk,
                                            const float* e_down, const float* e_up, bf16* WinT, bf16* WoutT, bf16* WeffT, bf16* H, unsigned char* ED, unsigned char* EU, float* SD, float* SU, const float* g2) {
    const int gw = F.bid * NWAVES + F.wave, NGW = F.G * NWAVES;
#if defined(TP_PHASE) && TP_PHASE == 12
    volatile unsigned long long* tsp12 = (volatile unsigned long long*)((unsigned char*)SD + 196608);
    if (F.bid == 0 && F.tid == 0) tsp12[0] = wall_clock64();
#endif
    for (int ph = 0; ph < 2; ++ph) {
    if ((ph == 0) == (((F.bid >> 3) & 1) == 0)) {
    {
        LAS float* scr = (LAS float*)(F.lds + RING_OFF + F.wave * 16384);
        constexpr int I_IN = (D / 64) * (NIN / 32), I_OUT = (D / 64) * (D / 32);
        for (int it = gw; it < I_IN + I_OUT; it += NGW) {
            if (it < I_IN) p0_transpose_item(w_in, D, NIN, WinT, scr, it, F.lane);
            else p0_transpose_item(w_out, D, D, WoutT, scr, it - I_IN, F.lane);
        }
    }
    __syncthreads();
    for (int it = gw; it < 16 * 64 * 2; it += NGW) {
        const int g = it & 15, dtile = (it >> 4) & 63, kh = it >> 10, p = g & 1, c = F.lane & 31, h = F.lane >> 5;
        const float* arow = wq + (size_t)(dtile * 32 + c) * 2048 + g * 128 + 8 * h;
        bf16x8 ah[8], al[8];
#pragma unroll
        for (int ks = 0; ks < 8; ++ks) { const f32x4 a0 = *(const f32x4*)(arow + 16 * ks), a1 = *(const f32x4*)(arow + 16 * ks + 4); split8(a0, a1, ah[ks], al[ks]); }
#pragma unroll 1
        for (int kt = 0; kt < 2; ++kt) {
            const int k0 = (kh * 2 + kt) * 32;
            const float* brow = sk + (size_t)(p * 128 + k0 + c) * 128 + 8 * h;
            f32x16 acc;
#pragma unroll
            for (int i = 0; i < 16; ++i) acc[i] = 0.f;
#pragma unroll
            for (int ks = 0; ks < 8; ++ks) { const f32x4 b0 = *(const f32x4*)(brow + 16 * ks), b1 = *(const f32x4*)(brow + 16 * ks + 4); bf16x8 bh, bl; split8(b0, b1, bh, bl);
                acc = __builtin_amdgcn_mfma_f32_32x32x16_bf16(al[ks], bh, acc, 0, 0, 0); acc = __builtin_amdgcn_mfma_f32_32x32x16_bf16(ah[ks], bl, acc, 0, 0, 0);
                acc = __builtin_amdgcn_mfma_f32_32x32x16_bf16(ah[ks], bh, acc, 0, 0, 0); }
            bf16* orow = WeffT + (size_t)(g * 128 + k0 + c) * 2048 + dtile * 32 + 4 * h;
#pragma unroll
            for (int q = 0; q < 4; ++q) { const f32x4 gq = *(const f32x4*)(g2 + dtile * 32 + 4 * h + 8 * q);
                v2u o; o.x = cvtpk(acc[4 * q] * gq[0], acc[4 * q + 1] * gq[1]); o.y = cvtpk(acc[4 * q + 2] * gq[2], acc[4 * q + 3] * gq[3]); *(v2u*)(orow + 8 * q) = o; }
        }
    }
#if defined(TP_PHASE) && TP_PHASE == 12
    __syncthreads(); if (F.bid == 0 && F.tid == 0) tsp12[1] = wall_clock64() - tsp12[0];
#endif
    } else {
    for (int rep_ = 0; rep_ < REP_P0C; ++rep_) convert_rows(e_down, e_up, ED, EU, SD, SU, 0, CONV_SPLIT, gw, NGW, F.lane);
    for (int m = gw; m < T; m += NGW) rms_row_to_bf16(x + (size_t)m * D, g1, H + (size_t)m * D, F.lane);
    }
    }
}

constexpr int SGU_VS = 136;
__device__ __forceinline__ void p2_sgu(const Ctx& F, const bf16* Z, const float* ln_g, const float* ln_b, const float* w_s, const float* b_s, bf16* MIX) {
    LAS bf16* vnT = (LAS bf16*)(F.lds + RING_OFF);
    LAS float* ps = (LAS float*)(F.lds + RING_OFF + 128 * SGU_VS * 2);
    LAS float* pq = ps + 512;
    const int s = F.tid & 127, dq = F.tid >> 7;
    const int c = F.lane & 31, h = F.lane >> 5, tt = F.wave >> 1;
    for (int unit = F.bid; unit < 512; unit += F.G) {
        const int g = unit & 7, t0 = (unit >> 3) * 128;
        __syncthreads();
        float v[32];
        { const bf16* vr = Z + (size_t)(t0 + s) * NIN + 1024 + g * 128 + dq * 32;
#pragma unroll
          for (int j = 0; j < 4; ++j) { const v4u q = *(const v4u*)(vr + 8 * j);
#pragma unroll
              for (int e = 0; e < 4; ++e) { v[8 * j + 2 * e] = bflo(q[e]); v[8 * j + 2 * e + 1] = bfhi(q[e]); } } }
        float sm = 0.f;
#pragma unroll
        for (int j = 0; j < 32; ++j) sm += v[j];
        ps[dq * 128 + s] = sm;
        __syncthreads();
        const float mean = (ps[s] + ps[128 + s] + ps[256 + s] + ps[384 + s]) * (1.f / 128.f);
        float sq = 0.f;
#pragma unroll
        for (int j = 0; j < 32; ++j) { v[j] -= mean; sq += v[j] * v[j]; }
        pq[dq * 128 + s] = sq;
        __syncthreads();
        const float rstd = rsqrtf((pq[s] + pq[128 + s] + pq[256 + s] + pq[384 + s]) * (1.f / 128.f) + EPS);
#pragma unroll
        for (int j = 0; j < 32; ++j) { const int d = dq * 32 + j; vnT[d * SGU_VS + s] = (bf16)f2bf(v[j] * rstd * ln_g[g * 128 + d] + ln_b[g * 128 + d]); }
        __syncthreads();
        f32x16 acc[2];
#pragma unroll
        for (int a = 0; a < 2; ++a)
#pragma unroll
            for (int i = 0; i < 16; ++i) acc[a][i] = 0.f;
        const int trow = 32 * tt + c;
        const float* wrow = w_s + ((size_t)g * 128 + trow) * 128;
        const int dt0 = 2 * (F.wave & 1);
        for (int ks = 0; ks < 2 * (tt + 1); ++ks) {
            const int s0 = 16 * ks + 8 * h;
            const f32x4 w0 = *(const f32x4*)(wrow + s0), w1 = *(const f32x4*)(wrow + s0 + 4);
            float w[8] = {w0[0], w0[1], w0[2], w0[3], w1[0], w1[1], w1[2], w1[3]};
#pragma unroll
            for (int j = 0; j < 8; ++j) w[j] = (s0 + j <= trow) ? w[j] : 0.f;
            const bf16x8 bf = pack8(w[0], w[1], w[2], w[3], w[4], w[5], w[6], w[7]);
#pragma unroll
            for (int a = 0; a < 2; ++a) { const bf16x8 af = *(const LAS bf16x8*)(vnT + (32 * (dt0 + a) + c) * SGU_VS + s0);
                acc[a] = __builtin_amdgcn_mfma_f32_32x32x16_bf16(af, bf, acc[a], 0, 0, 0); }
        }
        const float bias = b_s[g * 128 + trow];
        const size_t tok = (size_t)(t0 + trow);
#pragma unroll
        for (int a = 0; a < 2; ++a)
#pragma unroll
            for (int q = 0; q < 4; ++q) { const int d0 = 32 * (dt0 + a) + 8 * q + 4 * h;
                const v2u uu = *(const v2u*)(Z + tok * NIN + g * 128 + d0);
                v2u o; o.x = cvtpk(bflo(uu.x) * (acc[a][4 * q] + bias), bfhi(uu.x) * (acc[a][4 * q + 1] + bias));
                o.y = cvtpk(bflo(uu.y) * (acc[a][4 * q + 2] + bias), bfhi(uu.y) * (acc[a][4 * q + 3] + bias));
                *(v2u*)(MIX + tok * D + g * 128 + d0) = o; }
    }
}
constexpr int ATT_KS = 72, ATT_VS = 264;
__device__ __forceinline__ void p2_attn(const Ctx& F, const bf16* Z, const float* sinks, bf16* MIX) {
    LAS bf16* Ks = (LAS bf16*)(F.lds + RING_OFF);
    LAS bf16* Vt = (LAS bf16*)(F.lds + RING_OFF + 256 * ATT_KS * 2);
    const int c = F.lane & 31, h = F.lane >> 5;
    for (int unit = F.bid; unit < 256; unit += F.G) {
        const int hg = unit & 1, hk = (unit >> 1) & 1, n = (unit >> 2) & 15, b = unit >> 6;
        __syncthreads();
        for (int e = F.tid; e < 256 * 8; e += NTHR) {
            const int j = e >> 3, ch = e & 7, pos = (n - 1) * 128 + j;
            v4u kv = (v4u){0u, 0u, 0u, 0u}, vv = (v4u){0u, 0u, 0u, 0u};
            if (pos >= 0) { const bf16* row = Z + ((size_t)b * SEQ + pos) * NIN; kv = *(const v4u*)(row + 3072 + hk * 64 + ch * 8); vv = *(const v4u*)(row + 3200 + hk * 64 + ch * 8); }
            *(LAS v4u*)(Ks + j * ATT_KS + ch * 8) = kv;
#pragma unroll
            for (int jj = 0; jj < 8; ++jj) Vt[(ch * 8 + jj) * ATT_VS + j] = (bf16)((vv[jj >> 1] >> (16 * (jj & 1))) & 0xffffu);
        }
        __syncthreads();
        for (int tk = 0; tk < 2; ++tk) {
            const int hq = hk * 8 + hg * 4 + (F.wave >> 1), i0 = 32 * (2 * (F.wave & 1) + tk);
            const size_t tok = (size_t)b * SEQ + n * 128 + i0 + c;
            const bf16* qrow = Z + tok * NIN + 2048 + hq * 64;
            bf16x8 qf[4];
#pragma unroll
            for (int ks = 0; ks < 4; ++ks) qf[ks] = *(const bf16x8*)(qrow + 16 * ks + 8 * h);
            f32x16 sT[5];
#pragma unroll
            for (int kt = 0; kt < 5; ++kt) {
#pragma unroll
                for (int i = 0; i < 16; ++i) sT[kt][i] = 0.f;
#pragma unroll
                for (int ks = 0; ks < 4; ++ks) { const bf16x8 kf = *(const LAS bf16x8*)(Ks + (i0 + 32 * kt + c) * ATT_KS + 16 * ks + 8 * h);
                    sT[kt] = __builtin_amdgcn_mfma_f32_32x32x16_bf16(kf, qf[ks], sT[kt], 0, 0, 0); }
            }
            const float sink = sinks[hq]; float m = sink;
#pragma unroll
            for (int kt = 0; kt < 5; ++kt) {
                const bool tile_ok = (n > 0) || (i0 + 32 * kt >= 128);
#pragma unroll
                for (int i = 0; i < 16; ++i) { const int jj = (i & 3) + 8 * (i >> 2) + 4 * h;
                    bool ok = tile_ok; if (kt == 0) ok = ok && (jj > c); if (kt == 4) ok = ok && (jj <= c);
                    const float x = ok ? sT[kt][i] * 0.125f : -INFINITY; sT[kt][i] = x; m = fmaxf(m, x); }
            }
            m = fmaxf(m, __shfl_xor(m, 32));
            float l = 0.f;
#pragma unroll
            for (int kt = 0; kt < 5; ++kt)
#pragma unroll
                for (int i = 0; i < 16; ++i) { const float p = __expf(sT[kt][i] - m); sT[kt][i] = p; l += p; }
            l += __shfl_xor(l, 32); l += __expf(sink - m);
            f32x16 o[2];
#pragma unroll
            for (int a = 0; a < 2; ++a)
#pragma unroll
                for (int i = 0; i < 16; ++i) o[a][i] = 0.f;
#pragma unroll
            for (int kt = 0; kt < 5; ++kt)
#pragma unroll
                for (int st = 0; st < 2; ++st) {
                    const bf16x8 pf = pack8(sT[kt][8 * st], sT[kt][8 * st + 1], sT[kt][8 * st + 2], sT[kt][8 * st + 3], sT[kt][8 * st + 4], sT[kt][8 * st + 5], sT[kt][8 * st + 6], sT[kt][8 * st + 7]);
                    const int key0 = i0 + 32 * kt + 16 * st + 4 * h;
#pragma unroll
                    for (int a = 0; a < 2; ++a) { const LAS bf16* vp = Vt + (32 * a + c) * ATT_VS + key0;
                        const v2u lo = *(const LAS v2u*)vp, hi = *(const LAS v2u*)(vp + 8);
                        const v4u vw = (v4u){lo.x, lo.y, hi.x, hi.y};
                        o[a] = __builtin_amdgcn_mfma_f32_32x32x16_bf16(__builtin_bit_cast(bf16x8, vw), pf, o[a], 0, 0, 0); }
                }
            const float inv = 1.f / l;
#pragma unroll
            for (int a = 0; a < 2; ++a)
#pragma unroll
                for (int q = 0; q < 4; ++q) { const int d0 = 32 * a + 8 * q + 4 * h;
                    v2u w; w.x = cvtpk(o[a][4 * q] * inv, o[a][4 * q + 1] * inv); w.y = cvtpk(o[a][4 * q + 2] * inv, o[a][4 * q + 3] * inv);
                    *(v2u*)(MIX + tok * D + 1024 + hq * 64 + d0) = w; }
        }
    }
}

typedef __bf16 bf16x2_t __attribute__((ext_vector_type(2)));
constexpr int P5_TOK = 32;
constexpr int P5_WL = 2048;
__device__ __forceinline__ unsigned fkey(float f) { const unsigned u = __float_as_uint(f); return (u & 0x80000000u) ? ~u : (u | 0x80000000u); }
__device__ __forceinline__ float dot2bf(unsigned a, unsigned b, float c) { return __builtin_amdgcn_fdot2_f32_bf16(__builtin_bit_cast(bf16x2_t, a), __builtin_bit_cast(bf16x2_t, b), c, false); }
template <int CTRL, int RM, bool BC> __device__ __forceinline__ float dpp_f(float v) { return __builtin_bit_cast(float, __builtin_amdgcn_update_dpp(0, __builtin_bit_cast(int, v), CTRL, RM, 0xf, BC)); }
struct WaveLds { LAS int* eid; LAS float* gate; LAS float* sv; LAS float* tv; LAS int* ti; LAS int* ctab; };
template <int CTRL> __device__ __forceinline__ unsigned dppx_u(unsigned v) { return (unsigned)__builtin_amdgcn_update_dpp(0, (int)v, CTRL, 0xf, 0xf, true); }
template <int CTRL> __device__ __forceinline__ float dppx_f(float v) { return __builtin_bit_cast(float, __builtin_amdgcn_update_dpp(0, __builtin_bit_cast(int, v), CTRL, 0xf, 0xf, true)); }
__device__ __forceinline__ unsigned umax(unsigned a, unsigned b) { return a > b ? a : b; }
__device__ __forceinline__ unsigned umin(unsigned a, unsigned b) { return a < b ? a : b; }
__device__ __forceinline__ unsigned row_allmax_u(unsigned m) {
    m = umax(m, dppx_u<0xB1>(m)); m = umax(m, dppx_u<0x4E>(m)); m = umax(m, dppx_u<0x141>(m)); m = umax(m, dppx_u<0x140>(m)); return m; }
__device__ __forceinline__ float row_allmax_f(float m) { m = fmaxf(m, dppx_f<0xB1>(m)); m = fmaxf(m, dppx_f<0x4E>(m)); m = fmaxf(m, dppx_f<0x141>(m)); m = fmaxf(m, dppx_f<0x140>(m)); return m; }
__device__ __forceinline__ float row_allsum_f(float m) { m += dppx_f<0xB1>(m); m += dppx_f<0x4E>(m); m += dppx_f<0x141>(m); m += dppx_f<0x140>(m); return m; }
#define P5_CE(a, b) do { const unsigned _h = umax(a, b), _l = umin(a, b); a = _h; b = _l; } while (0)
__device__ __forceinline__ int cand_pair(int c) {
    return c < 16 ? c : c < 24 ? (1 << 4) | (c - 16) : c < 29 ? (2 << 4) | (c - 24) : c < 33 ? (3 << 4) | (c - 29) : c < 36 ? (4 << 4) | (c - 33) : c < 38 ? (5 << 4) | (c - 36)
         : c < 40 ? (6 << 4) | (c - 38) : c < 42 ? (7 << 4) | (c - 40) : c < 50 ? ((c - 34) << 4) : 0xff;
}
__device__ __forceinline__ void p5_topk_fetch(const WaveLds& W, const float* src, int half, int lane) {
#pragma unroll
    for (int i = 0; i < 4; ++i) __builtin_amdgcn_global_load_lds((const unsigned*)(src + i * 256 + lane * 4), (LAS unsigned*)(W.sv + half * 1024 + i * 256), 16, 0, 0);
}
__device__ __forceinline__ void p5_topk_token(const WaveLds& W, const float* sc  , const float* sc_next, float rs  , int lane) {
    const int r = lane >> 4, l15 = lane & 15;
#pragma unroll 1
    for (int pp = 0; pp < 2; ++pp) {
        unsigned k[2][8]; unsigned top[2] = {0u, 0u};
        asm volatile("s_waitcnt vmcnt(0)" ::: "memory");
        { const float* nsrc = pp == 0 ? sc + 1024 : sc_next; if (nsrc != nullptr) p5_topk_fetch(W, nsrc, 1 - pp, lane); }
#pragma unroll
        for (int u = 0; u < 2; ++u) {
            const int L = 4 * (2 * pp + u) + r;
            const f32x4 v0 = *(const LAS f32x4*)(W.sv + L * 128 + 8 * l15) * rs, v1 = *(const LAS f32x4*)(W.sv + L * 128 + 8 * l15 + 4) * rs;
#pragma unroll
            for (int j = 0; j < 4; ++j) { k[u][j] = (fkey(v0[j]) & ~127u) | (unsigned)(127 - (8 * l15 + j)); k[u][4 + j] = (fkey(v1[j]) & ~127u) | (unsigned)(127 - (8 * l15 + 4 + j)); }
            P5_CE(k[u][0], k[u][1]); P5_CE(k[u][2], k[u][3]); P5_CE(k[u][4], k[u][5]); P5_CE(k[u][6], k[u][7]);
            P5_CE(k[u][0], k[u][2]); P5_CE(k[u][1], k[u][3]); P5_CE(k[u][4], k[u][6]); P5_CE(k[u][5], k[u][7]);
            P5_CE(k[u][1], k[u][2]); P5_CE(k[u][5], k[u][6]);
            P5_CE(k[u][0], k[u][4]); P5_CE(k[u][1], k[u][5]); P5_CE(k[u][2], k[u][6]); P5_CE(k[u][3], k[u][7]);
            P5_CE(k[u][2], k[u][4]); P5_CE(k[u][3], k[u][5]);
            P5_CE(k[u][1], k[u][2]); P5_CE(k[u][3], k[u][4]); P5_CE(k[u][5], k[u][6]);
        }
#pragma unroll 4
        for (int it = 0; it < 16; ++it) {
#pragma unroll
            for (int u = 0; u < 2; ++u) {
                const unsigned m = row_allmax_u(k[u][0]); const bool sel = k[u][0] == m;
                top[u] = (l15 == it) ? m : top[u];
#pragma unroll
                for (int j = 0; j < 7; ++j) k[u][j] = sel ? k[u][j + 1] : k[u][j];
                k[u][7] = sel ? 0u : k[u][7];
            }
        }
        LDS_WAIT(); __builtin_amdgcn_wave_barrier();
#pragma unroll
        for (int u = 0; u < 2; ++u) { const int L = 4 * (2 * pp + u) + r; const int idx = 127 - (int)(top[u] & 127u);
            W.tv[L * 16 + l15] = W.sv[L * 128 + idx] * rs; W.ti[L * 16 + l15] = idx; }
    }
    LDS_WAIT(); __builtin_amdgcn_wave_barrier();
    int cij[4];
#pragma unroll
    for (int j = 0; j < 4; ++j) cij[j] = cand_pair(4 * l15 + j);
    unsigned ck[2][4]; unsigned top2[2] = {0u, 0u};
#pragma unroll
    for (int u = 0; u < 2; ++u) {
        const int hd = 4 * u + r; const LAS float* tv0 = W.tv + (2 * hd) * 16; const LAS float* tv1 = tv0 + 16;
#pragma unroll
        for (int j = 0; j < 4; ++j) { const float cs = tv0[(cij[j] >> 4) & 15] + tv1[cij[j] & 15]; const int s = 4 * l15 + j;
            ck[u][j] = (s < 50) ? ((fkey(cs) & ~63u) | (unsigned)(63 - s)) : 0u; }
        P5_CE(ck[u][0], ck[u][1]); P5_CE(ck[u][2], ck[u][3]); P5_CE(ck[u][0], ck[u][2]); P5_CE(ck[u][1], ck[u][3]); P5_CE(ck[u][1], ck[u][2]);
    }
#pragma unroll 4
    for (int it = 0; it < 16; ++it) {
#pragma unroll
        for (int u = 0; u < 2; ++u) {
            const unsigned m = row_allmax_u(ck[u][0]); const bool sel = ck[u][0] == m;
            top2[u] = (l15 == it) ? m : top2[u];
            ck[u][0] = sel ? ck[u][1] : ck[u][0]; ck[u][1] = sel ? ck[u][2] : ck[u][1]; ck[u][2] = sel ? ck[u][3] : ck[u][2]; ck[u][3] = sel ? 0u : ck[u][3];
        }
    }
#pragma unroll
    for (int u = 0; u < 2; ++u) {
        const int hd = 4 * u + r; const LAS float* tv0 = W.tv + (2 * hd) * 16; const LAS float* tv1 = tv0 + 16; const LAS int* ti0 = W.ti + (2 * hd) * 16; const LAS int* ti1 = ti0 + 16;
        const int ij = W.ctab[63 - (int)(top2[u] & 63u)];
        const int i1 = (ij >> 4) & 15, j1 = ij & 15;
        const float vs = tv0[i1] + tv1[j1]; const int e = ti0[i1] * 128 + ti1[j1];
        const float mx = row_allmax_f(vs), ex = __expf(vs - mx), sm = row_allsum_f(ex);
        W.gate[hd * 16 + l15] = ex / sm; W.eid[hd * 16 + l15] = e;
    }
    LDS_WAIT(); __builtin_amdgcn_wave_barrier();
}
constexpr int P5_R = 9;
constexpr int P5_NSL = 16, P5_SLSH = 10;
#ifndef REP_TOPK
#define REP_TOPK 1
#endif
#ifndef REP_DS
#define REP_DS 1
#endif
constexpr int P5_WL2 = 20480;
struct SweepLds { LAS unsigned char* ring; LAS int* feid; LAS float* fcf; LAS float* raw; };
__device__ __forceinline__ int mbcnt64(unsigned long long m) { return __builtin_amdgcn_mbcnt_hi((unsigned)(m >> 32), __builtin_amdgcn_mbcnt_lo((unsigned)m, 0u)); }
template <int CTRL, int RM, bool BC> __device__ __forceinline__ int dpp_i(int v) { return __builtin_amdgcn_update_dpp(0, v, CTRL, RM, 0xf, BC); }
__device__ __forceinline__ float wave_total63(float v) {
    v += dpp_f<0x111, 0xf, true>(v); v += dpp_f<0x112, 0xf, true>(v); v += dpp_f<0x114, 0xf, true>(v); v += dpp_f<0x118, 0xf, true>(v);
    v += dpp_f<0x142, 0xa, false>(v); v += dpp_f<0x143, 0xc, false>(v); return v; }
__device__ __forceinline__ int wave_incl_scan(int v) {
    v += dpp_i<0x111, 0xf, true>(v); v += dpp_i<0x112, 0xf, true>(v); v += dpp_i<0x114, 0xf, true>(v); v += dpp_i<0x118, 0xf, true>(v);
    v += dpp_i<0x142, 0xa, false>(v); v += dpp_i<0x143, 0xc, false>(v); return v; }
#define P5_WRAP(x) ((x) + 1 == P5_R ? 0 : (x) + 1)
#define P5_ISSUE(tab, id_) do { const unsigned char* _gp = (tab) + (size_t)(id_) * ROWB + lane * 16; LAS unsigned char* _lp = L.ring + pslot * ROWB; \
    __builtin_amdgcn_global_load_lds((const unsigned*)_gp, (LAS unsigned*)_lp, 16, 0, 0);                         \
    if (lane < 32) __builtin_amdgcn_global_load_lds((const unsigned*)(_gp + 1024), (LAS unsigned*)(_lp + 1024), 16, 0, 0);     \
    pslot = P5_WRAP(pslot); } while (0)
#define P5_ROWREAD(dst_, slot_) do { const LAS unsigned char* _rp = L.ring + (slot_) * ROWB + lane * 24; const v2u _a = *(const LAS v2u*)_rp, _b = *(const LAS v2u*)(_rp + 8), _c = *(const LAS v2u*)(_rp + 16); \
    dst_[0] = (int)_a.x; dst_[1] = (int)_a.y; dst_[2] = (int)_b.x; dst_[3] = (int)_b.y; dst_[4] = (int)_c.x; dst_[5] = (int)_c.y; } while (0)
typedef int v8i __attribute__((ext_vector_type(8)));
#define P5_V6(x_) ((v6u){(unsigned)x_[0], (unsigned)x_[1], (unsigned)x_[2], (unsigned)x_[3], (unsigned)x_[4], (unsigned)x_[5]})
#define P5_FEID(i_) __builtin_amdgcn_readfirstlane(L.feid[(i_) > 511 ? 511 : (i_)])
typedef _Float16 f16x32 __attribute__((ext_vector_type(32)));
typedef _Float16 f16x2v __attribute__((ext_vector_type(2)));
__device__ __forceinline__ void wave_total63x2(float& a, float& b) {
    a += dpp_f<0x111, 0xf, true>(a); b += dpp_f<0x111, 0xf, true>(b); a += dpp_f<0x112, 0xf, true>(a); b += dpp_f<0x112, 0xf, true>(b);
    a += dpp_f<0x114, 0xf, true>(a); b += dpp_f<0x114, 0xf, true>(b); a += dpp_f<0x118, 0xf, true>(a); b += dpp_f<0x118, 0xf, true>(b);
    a += dpp_f<0x142, 0xa, false>(a); b += dpp_f<0x142, 0xa, false>(b); a += dpp_f<0x143, 0xc, false>(a); b += dpp_f<0x143, 0xc, false>(b);
}
template <bool UP> __device__ __forceinline__ void p5_sweep(const SweepLds& L, const unsigned char* tab, unsigned (&hp)[4][16], const v8i (&hq)[4], const float (&hinv)[4], int lenv0, int lenv1, int lane) {
    const LAS int* cbits = (const LAS int*)L.fcf;
    int pslot = 0, cslot = 2, idx = 0;
    for (int i = 0; i < P5_R; ++i) { const int id = P5_FEID(i); P5_ISSUE(tab, id); }
    int nv0 = L.feid[P5_R], nv1 = L.feid[P5_R + 1];
    asm volatile("s_waitcnt vmcnt(14)" ::: "memory");
    v8i ra = {0, 0, 0, 0, 0, 0, 0, 0}, rb = {0, 0, 0, 0, 0, 0, 0, 0}; P5_ROWREAD(ra, 0); P5_ROWREAD(rb, 1);
    const bool dg0 = (lane & 3) == 0, dg1 = (lane & 3) == 1, dg2 = (lane & 3) == 2, dgv = ((lane & 15) >> 2) == (lane >> 4);
    int cav = 0, cbv = 0; if (UP) { cav = cbits[0]; cbv = cbits[1]; }
    for (int s = 0; s < P5_NSL; ++s) {
        const int lenv = s < 16 ? lenv0 : lenv1;
#pragma unroll
        for (int tok = 0; tok < 4; ++tok) {
            const int n = __builtin_amdgcn_readlane(lenv, (s & 15) * 4 + tok);
            int i = 0;
            for (; i + 1 < n; i += 2) {
                f16x32 xa, xb; f32x4 ma, mb;
                if (UP) { xa = __builtin_amdgcn_cvt_scalef32_pk32_f16_fp6(P5_V6(ra), 1.0f); xb = __builtin_amdgcn_cvt_scalef32_pk32_f16_fp6(P5_V6(rb), 1.0f); }
                else { const f32x4 z = {0.f, 0.f, 0.f, 0.f};
                    ma = __builtin_amdgcn_mfma_scale_f32_16x16x128_f8f6f4(ra, hq[tok], z, 2  , 2  , 0, 0, 0, 0);
                    mb = __builtin_amdgcn_mfma_scale_f32_16x16x128_f8f6f4(rb, hq[tok], z, 2, 2, 0, 0, 0, 0); }
                const f16x2v ca = __builtin_bit_cast(f16x2v, __builtin_amdgcn_readfirstlane(cav)), cb = __builtin_bit_cast(f16x2v, __builtin_amdgcn_readfirstlane(cbv));
                { const int id0 = __builtin_amdgcn_readfirstlane(nv0), id1 = __builtin_amdgcn_readfirstlane(nv1); P5_ISSUE(tab, id0); P5_ISSUE(tab, id1); }
                nv0 = L.feid[idx + 2 + P5_R > 511 ? 511 : idx + 2 + P5_R]; nv1 = L.feid[idx + 3 + P5_R > 511 ? 511 : idx + 3 + P5_R];
                if (UP) { cav = cbits[idx + 2 > 511 ? 511 : idx + 2]; cbv = cbits[idx + 3 > 511 ? 511 : idx + 3]; }
                asm volatile("s_waitcnt vmcnt(14)" ::: "memory");
                const int cs1 = P5_WRAP(cslot);
                P5_ROWREAD(ra, cslot); P5_ROWREAD(rb, cs1);
                cslot = P5_WRAP(cs1);
                __builtin_amdgcn_sched_barrier(0);
                if (!UP) {
                    float a0 = ma[0], a1 = ma[1], a2 = ma[2], a3 = ma[3], b0 = mb[0], b1 = mb[1], b2 = mb[2], b3 = mb[3];
                    asm volatile("" : "+v"(a0), "+v"(a1), "+v"(a2), "+v"(a3), "+v"(b0), "+v"(b1), "+v"(b2), "+v"(b3));
                    float ta = dg0 ? a0 : dg1 ? a1 : dg2 ? a2 : a3, tb = dg0 ? b0 : dg1 ? b1 : dg2 ? b2 : b3;
                    ta = dgv ? ta : 0.f; tb = dgv ? tb : 0.f; wave_total63x2(ta, tb);
                    L.raw[idx] = __builtin_bit_cast(float, __builtin_amdgcn_readlane(__builtin_bit_cast(int, ta), 63)) * hinv[tok];
                    L.raw[idx + 1] = __builtin_bit_cast(float, __builtin_amdgcn_readlane(__builtin_bit_cast(int, tb), 63)) * hinv[tok];
                } else {
#pragma unroll
                    for (int k = 0; k < 16; ++k) hp[tok][k] = __builtin_bit_cast(unsigned, __builtin_elementwise_fma((f16x2v){xa[2 * k], xa[2 * k + 1]}, ca, __builtin_bit_cast(f16x2v, hp[tok][k])));
                    __builtin_amdgcn_sched_barrier(0);
#pragma unroll
                    for (int k = 0; k < 16; ++k) hp[tok][k] = __builtin_bit_cast(unsigned, __builtin_elementwise_fma((f16x2v){xb[2 * k], xb[2 * k + 1]}, cb, __builtin_bit_cast(f16x2v, hp[tok][k])));
                }
                idx += 2;
            }
            if (i < n) {
                f16x32 xa; f32x4 ma;
                if (UP) xa = __builtin_amdgcn_cvt_scalef32_pk32_f16_fp6(P5_V6(ra), 1.0f);
                else { const f32x4 z = {0.f, 0.f, 0.f, 0.f}; ma = __builtin_amdgcn_mfma_scale_f32_16x16x128_f8f6f4(ra, hq[tok], z, 2, 2, 0, 0, 0, 0); }
                const f16x2v ca = __builtin_bit_cast(f16x2v, __builtin_amdgcn_readfirstlane(cav));
                ra = rb; cav = cbv;
                { const int id0 = __builtin_amdgcn_readfirstlane(nv0); P5_ISSUE(tab, id0); }
                nv0 = nv1; nv1 = L.feid[idx + 2 + P5_R > 511 ? 511 : idx + 2 + P5_R];
                if (UP) cbv = cbits[idx + 2 > 511 ? 511 : idx + 2];
                asm volatile("s_waitcnt vmcnt(14)" ::: "memory");
                P5_ROWREAD(rb, cslot);
                cslot = P5_WRAP(cslot);
                __builtin_amdgcn_sched_barrier(0);
                if (!UP) {
                    float a0 = ma[0], a1 = ma[1], a2 = ma[2], a3 = ma[3];
                    asm volatile("" : "+v"(a0), "+v"(a1), "+v"(a2), "+v"(a3));
                    float ta = dg0 ? a0 : dg1 ? a1 : dg2 ? a2 : a3; ta = wave_total63(dgv ? ta : 0.f);
                    L.raw[idx] = __builtin_bit_cast(float, __builtin_amdgcn_readlane(__builtin_bit_cast(int, ta), 63)) * hinv[tok];
                } else {
#pragma unroll
                    for (int k = 0; k < 16; ++k) hp[tok][k] = __builtin_bit_cast(unsigned, __builtin_elementwise_fma((f16x2v){xa[2 * k], xa[2 * k + 1]}, ca, __builtin_bit_cast(f16x2v, hp[tok][k])));
                }
                idx += 1;
            }
        }
    }
    asm volatile("s_waitcnt vmcnt(0)" ::: "memory");
}
__device__ __forceinline__ void p5_wave(LAS unsigned char* wl, const float* SC, const bf16* X1, const unsigned char* ED, const unsigned char* EU, const float* SD, const float* SU,
                                        const float* gf, float* out, int t0, int lane, const float* g2) {
    SweepLds L; L.ring = wl; L.feid = (LAS int*)(wl + 14336); L.fcf = (LAS float*)(wl + 14336 + 2048); L.raw = (LAS float*)(wl + 14336 + 4096);
    { LAS int* ctab = (LAS int*)(wl + 14336); ctab[lane] = cand_pair(lane); }
    unsigned hp[4][16]; float rsv[4]; v8i hq[4]; float hinv[4];
    {   f32x4 gl[8];
        int ls = lane; asm volatile("" : "+v"(ls));
#pragma unroll
        for (int i = 0; i < 8; ++i) gl[i] = *(const f32x4*)(g2 + i * 256 + ls * 4);
        v2u xq[4][8];
#pragma unroll
        for (int tk = 0; tk < 4; ++tk)
#pragma unroll
            for (int i = 0; i < 8; ++i) xq[tk][i] = *(const v2u*)(X1 + (size_t)(t0 + 8 * tk) * D + i * 256 + ls * 4);
#pragma unroll
        for (int tk = 0; tk < 4; ++tk) { float ss = 0.f;
#pragma unroll
            for (int i = 0; i < 8; ++i)
#pragma unroll
                for (int e = 0; e < 2; ++e) { const float a = bflo(xq[tk][i][e]), b = bfhi(xq[tk][i][e]); ss += a * a + b * b; }
            const float rs = __builtin_amdgcn_rsqf(wave_sum(ss) * (1.f / D) + EPS); rsv[tk] = rs;
            float hx[32]; float mx = 0.f;
#pragma unroll
            for (int i = 0; i < 8; ++i)
#pragma unroll
                for (int e = 0; e < 2; ++e) {
                    hx[4 * i + 2 * e] = bflo(xq[tk][i][e]) * rs * gl[i][2 * e]; hx[4 * i + 2 * e + 1] = bfhi(xq[tk][i][e]) * rs * gl[i][2 * e + 1];
                    mx = fmaxf(mx, fmaxf(fabsf(hx[4 * i + 2 * e]), fabsf(hx[4 * i + 2 * e + 1]))); }
#pragma unroll
            for (int o = 1; o < 64; o <<= 1) mx = fmaxf(mx, __shfl_xor(mx, o));
            const float hs = mx > 0.f ? 7.f / mx : 0.f; hinv[tk] = mx * (1.f / 7.f);
            bf16x32 hb;
#pragma unroll
            for (int k = 0; k < 32; ++k) hb[k] = (__bf16)(hx[k] * hs);
            const v6u pk = __builtin_amdgcn_cvt_scalef32_pk32_fp6_bf16(hb, 1.0f);
            hq[tk] = (v8i){(int)pk[0], (int)pk[1], (int)pk[2], (int)pk[3], (int)pk[4], (int)pk[5], 0, 0};
        }
    }
    LDS_WAIT(); __builtin_amdgcn_wave_barrier();
    for (int rep_ = 0; rep_ < REP_TOPK; ++rep_)
    for (int tk = 0; tk < 4; ++tk) {
        if (tk == 0) { WaveLds W0; W0.sv = (LAS float*)(wl + 4096); p5_topk_fetch(W0, SC + (size_t)t0 * 2048, 0, lane); }
        WaveLds W; W.eid = (LAS int*)(wl + 1024 * tk); W.gate = (LAS float*)(wl + 1024 * tk + 512);
        W.sv = (LAS float*)(wl + 4096); W.tv = (LAS float*)(wl + 12288); W.ti = (LAS int*)(wl + 13312); W.ctab = (LAS int*)(wl + 14336);
        p5_topk_token(W, SC + (size_t)(t0 + 8 * tk) * 2048, tk < 3 ? SC + (size_t)(t0 + 8 * tk + 8) * 2048 : nullptr, rsv[tk], lane);
    }
    int lenv0 = 0, lenv1 = 0;
#pragma unroll
    for (int tk = 0; tk < 4; ++tk) {
        const LAS int* ue = (const LAS int*)(wl + 1024 * tk); const int sl0 = ue[lane] >> P5_SLSH, sl1 = ue[lane + 64] >> P5_SLSH;
        for (int k = 0; k < P5_NSL; ++k) { const int c = __popcll(__ballot(sl0 == k)) + __popcll(__ballot(sl1 == k));
            if (lane == (k & 15) * 4 + tk) { if (k < 16) lenv0 = c; else lenv1 = c; } }
    }
    const int incl0 = wave_incl_scan(lenv0), tot0 = __builtin_amdgcn_readlane(incl0, 63);
    const int base0 = incl0 - lenv0, base1 = wave_incl_scan(lenv1) - lenv1 + tot0;
#pragma unroll
    for (int tk = 0; tk < 4; ++tk) {
        const LAS int* ue = (const LAS int*)(wl + 1024 * tk); const LAS float* ug = (const LAS float*)(wl + 1024 * tk + 512);
        const int e0 = ue[lane], e1 = ue[lane + 64], sl0 = e0 >> P5_SLSH, sl1 = e1 >> P5_SLSH; const float g0 = ug[lane], g1 = ug[lane + 64];
        int r0 = 0, r1 = 0;
        for (int k = 0; k < P5_NSL; ++k) { const unsigned long long m0 = __ballot(sl0 == k), m1 = __ballot(sl1 == k);
            if (sl0 == k) r0 = mbcnt64(m0);
            if (sl1 == k) r1 = __popcll(m0) + mbcnt64(m1); }
        const int b00 = __shfl(base0, (sl0 & 15) * 4 + tk), b01 = __shfl(base1, (sl0 & 15) * 4 + tk), b10 = __shfl(base0, (sl1 & 15) * 4 + tk), b11 = __shfl(base1, (sl1 & 15) * 4 + tk);
        const int p0 = (sl0 < 16 ? b00 : b01) + r0, p1 = (sl1 < 16 ? b10 : b11) + r1;
        L.feid[p0] = e0; L.fcf[p0] = g0; L.feid[p1] = e1; L.fcf[p1] = g1;
    }
    LDS_WAIT(); __builtin_amdgcn_wave_barrier();
    for (int rep_ = 0; rep_ < REP_DS; ++rep_) p5_sweep<false>(L, ED, hp, hq, hinv, lenv0, lenv1, lane);
    LDS_WAIT(); __builtin_amdgcn_wave_barrier();
    float cmax = 0.f;
    {   float sdv[8], suv[8], cv[8];
#pragma unroll
        for (int k = 0; k < 8; ++k) { const int id = L.feid[lane + 64 * k]; sdv[k] = SD[id]; suv[k] = SU[id]; }
#pragma unroll
        for (int k = 0; k < 8; ++k) { const int i = lane + 64 * k; cv[k] = gelu_erf(L.raw[i] * sdv[k]) * L.fcf[i] * suv[k]; cmax = fmaxf(cmax, fabsf(cv[k])); }
#pragma unroll
        for (int o = 1; o < 64; o <<= 1) cmax = fmaxf(cmax, __shfl_xor(cmax, o));
        const float cinv = cmax > 0.f ? 1.f / cmax : 0.f;
#pragma unroll
        for (int k = 0; k < 8; ++k) { const _Float16 h = (_Float16)(cv[k] * cinv); ((LAS unsigned*)L.fcf)[lane + 64 * k] = __builtin_bit_cast(unsigned, (f16x2v){h, h}); }
    }
    LDS_WAIT(); __builtin_amdgcn_wave_barrier();
    asm volatile("s_waitcnt vmcnt(0)" ::: "memory");
#pragma unroll
    for (int tk = 0; tk < 4; ++tk)
#pragma unroll
        for (int q = 0; q < 16; ++q) hp[tk][q] = 0u;
    v2u xr[4][8];
    {   int lx = lane; asm volatile("" : "+v"(lx));
#pragma unroll
        for (int tk = 0; tk < 4; ++tk)
#pragma unroll
            for (int i = 0; i < 8; ++i) xr[tk][i] = __builtin_nontemporal_load((const v2u*)(X1 + (size_t)(t0 + 8 * tk) * D + i * 256 + lx * 4)); }
    p5_sweep<true>(L, EU, hp, hq, hinv, lenv0, lenv1, lane);
    int le = lane; asm volatile("" : "+v"(le));
#pragma unroll
    for (int tk = 0; tk < 4; ++tk) {
        const size_t ro = (size_t)(t0 + 8 * tk) * D; float ss = 0.f; float st[32];
#pragma unroll
        for (int i = 0; i < 8; ++i) { const v2u xa = xr[tk][i];
#pragma unroll
            for (int c = 0; c < 2; ++c) { const int k = 4 * i + 2 * c; const f16x2v a = __builtin_bit_cast(f16x2v, hp[tk][k >> 1]);
                st[k] = (float)a.x * cmax + bflo(xa[c]); st[k + 1] = (float)a.y * cmax + bfhi(xa[c]); ss += st[k] * st[k] + st[k + 1] * st[k + 1]; } }
        const float r = rsqrtf(wave_sum(ss) * (1.f / D) + EPS);
#pragma unroll
        for (int i = 0; i < 8; ++i) { const f32x4 g = *(const f32x4*)(gf + i * 256 + le * 4); f32x4 a;
#pragma unroll
            for (int c = 0; c < 4; ++c) a[c] = st[4 * i + c] * r * g[c];
            __builtin_nontemporal_store(a, (f32x4*)(out + ro + i * 256 + le * 4)); }
    }
}
__device__ __forceinline__ void p5_peer(const Ctx& F, const float* SC, const bf16* X1, const unsigned char* ED, const unsigned char* EU, const float* SD, const float* SU, const float* gf, float* out, const float* g2) {
    for (int tile = F.bid; tile < T / P5_TOK; tile += F.G)
        p5_wave(F.lds + F.wave * P5_WL2, SC, X1, ED, EU, SD, SU, gf, out, tile * P5_TOK + F.wave, F.lane, g2);
}

struct Args { const float* in[15]; float* out; unsigned char* ws; };
__global__ void __launch_bounds__(NTHR, 2) mega_fwd(Args args) {
    extern __shared__ __attribute__((aligned(16))) unsigned char lds_raw[];
    Ctx F; F.lds = (LAS unsigned char*)lds_raw; F.tid = threadIdx.x; F.lane = F.tid & 63; F.wave = __builtin_amdgcn_readfirstlane(F.tid >> 6); F.G = gridDim.x; F.bid = blockIdx.x;
    volatile LAS unsigned* MISC = (volatile LAS unsigned*)(F.lds + MISC_OFF);
    unsigned char* ws = args.ws; unsigned* ctl = (unsigned*)(ws + WS_CTL);
    const float* x = args.in[0]; const float* norm1_g = args.in[1]; const float* w_in = args.in[2]; const float* sgu_ln_g = args.in[3]; const float* sgu_ln_b = args.in[4];
    const float* w_spatial = args.in[5]; const float* b_spatial = args.in[6]; const float* attn_sinks = args.in[7]; const float* w_out = args.in[8]; const float* norm2_g = args.in[9];
    const float* w_query = args.in[10]; const float* sub_keys = args.in[11]; const float* expert_down = args.in[12]; const float* expert_up = args.in[13]; const float* norm_f_g = args.in[14];
    bf16* WinT = (bf16*)(ws + WS_WIN); bf16* WoutT = (bf16*)(ws + WS_WOUT); bf16* WeffT = (bf16*)(ws + WS_WEFF); bf16* H = (bf16*)(ws + WS_H);
    bf16* Z = (bf16*)(ws + WS_Z); bf16* MIX = (bf16*)(ws + WS_MIX); bf16* X1 = (bf16*)(ws + WS_X1); float* SC = (float*)(ws + WS_SC);
    unsigned char* ED = ws + WS_ED; unsigned char* EU = ws + WS_EU; float* SD = (float*)(ws + WS_SD); float* SU = (float*)(ws + WS_SU);
    for (int u = F.tid; u < (LDS_BYTES - LDSCTL_OFF) / 4; u += NTHR) ((LAS unsigned*)(F.lds + LDSCTL_OFF))[u] = 0u;
    __syncthreads();
    XcdBarrier bar = xcd_barrier_post(ctl + CW_BAR, MISC + 8);
#ifdef TP_PHASE
    volatile unsigned long long* tsp = (volatile unsigned long long*)(ws + WS_TP);
#define TP_BEGIN(k) do { if ((k) == TP_PHASE && F.bid == 0 && F.tid == 0) tsp[0] = wall_clock64(); } while (0)
#define TP_END(k) do { if ((k) == TP_PHASE && F.bid == 0 && F.tid == 0) tsp[1] = wall_clock64() - tsp[0]; } while (0)
#else
#define TP_BEGIN(k) do { } while (0)
#define TP_END(k) do { } while (0)
#endif
    TP_BEGIN(0);

    for (int rep = 0; rep < REP_P0; ++rep) p0_prologue(F, x, norm1_g, w_in, w_out, w_query, sub_keys, expert_down, expert_up, WinT, WoutT, WeffT, H, ED, EU, SD, SU, norm2_g);
    xcd_barrier(bar); TP_END(0); TP_BEGIN(1);
#if defined(TP_PHASE) && TP_PHASE == 11
    if (F.bid == F.G - 1 && F.tid == 0) tsp[0] = wall_clock64();
#endif
    for (int rep_ = 0; rep_ < REP_P1; ++rep_)
    {   pg8::Gemm g{H, WinT, T, NIN, D}; pg8::StaticOrder S; S.init(T, NIN, F.G, F.bid);
        pg8::EpiZ E{Z, NIN, 8};
        pg8::gemm_phase<pg8::EpiZ, pg8::StaticOrder, true, true>(F.lds + RING_OFF, g, S, E); }
    {
        const int nU = (T / 256) * (NIN / 256), maxu = (nU + F.G - 1) / F.G, nfull = nU - (maxu - 1) * F.G;
        const bool all = nfull == F.G; const int nidle = all ? F.G : F.G - nfull, q = all ? F.bid : F.bid - nfull;
        if (q >= 0) convert_rows(expert_down, expert_up, ED, EU, SD, SU, CONV_SPLIT, 2 * NE, q * NWAVES + F.wave, nidle * NWAVES, F.lane);
#if defined(TP_PHASE) && TP_PHASE == 11
        __syncthreads(); if (F.bid == F.G - 1 && F.tid == 0) tsp[1] = wall_clock64() - tsp[0];
#endif
    }
    xcd_barrier(bar); TP_END(1); TP_BEGIN(2);
    for (int rep = 0; rep < REP_P2; ++rep) { p2_sgu(F, Z, sgu_ln_g, sgu_ln_b, w_spatial, b_spatial, MIX); p2_attn(F, Z, attn_sinks, MIX); }
    {   pg8::Gemm g{MIX, WoutT, T, D, D}; pg8::StaticOrder S; S.init(T, D, F.G, F.bid);
        pg8::EpiX1 E{x, X1, D};
        pg8::f32x4 acc[2][2][4][2]; pg8::Unit u0; const bool has0 = S.next(0, u0);
        const int wr_ = F.wave >> 2, wc_ = F.wave & 3, fr_ = F.lane & 15, fq_ = F.lane >> 4;
        xcd_barrier_pre(bar, [&]() { if (has0) E.init(acc, u0, wr_, wc_, fr_, fq_); }); TP_END(2); TP_BEGIN(3);
        pg8::gemm_phase_acc<pg8::EpiX1, pg8::StaticOrder, true, true, true>(F.lds + RING_OFF, g, S, E, acc); }
    xcd_barrier(bar); TP_END(3); TP_BEGIN(4);
    {   pg8::Gemm g{X1, WeffT, T, D, D}; pg8::StaticOrder S; S.init(T, D, F.G, F.bid);
        pg8::EpiF32<false> E{nullptr, SC, D};
        pg8::gemm_phase<pg8::EpiF32<false>, pg8::StaticOrder, true, true>(F.lds + RING_OFF, g, S, E); }
    xcd_barrier(bar); TP_END(4); TP_BEGIN(5);
    for (int rep = 0; rep < REP_P5; ++rep) p5_peer(F, SC, X1, ED, EU, SD, SU, norm_f_g, args.out, norm2_g);
#ifdef TP_PHASE
    xcd_barrier(bar); TP_END(5);
    if (F.bid == 0 && F.tid == 0) { const unsigned long long t0 = wall_clock64(), w = (unsigned long long)TP_W * tsp[1]; while (wall_clock64() - t0 < w) __builtin_amdgcn_s_sleep(16); }
#endif
}

extern "C" void kernel_launch(void* const* d_in, const int* in_sizes, int n_in, void* d_out, int out_size, void* d_ws, size_t ws_size, hipStream_t stream) {
    static int grid = 0;
    if (grid == 0) {
        if (n_in != 15 || ws_size < WS_END) { fprintf(stderr, "kernel_launch: unexpected inputs / workspace\n"); grid = -1; return; }
        int dev = 0, cus = 0, per_cu = 0;
        if (hipGetDevice(&dev) != hipSuccess || hipDeviceGetAttribute(&cus, hipDeviceAttributeMultiprocessorCount, dev) != hipSuccess) { grid = -1; return; }
        if (hipFuncSetAttribute((const void*)mega_fwd, hipFuncAttributeMaxDynamicSharedMemorySize, LDS_BYTES) != hipSuccess) { fprintf(stderr, "kernel_launch: hipFuncSetAttribute failed\n"); grid = -1; return; }
        if (hipOccupancyMaxActiveBlocksPerMultiprocessor(&per_cu, (const void*)mega_fwd, NTHR, LDS_BYTES) != hipSuccess || per_cu < 1)
            fprintf(stderr, "kernel_launch: note: occupancy query reports %d workgroups per CU\n", per_cu);
        (void)hipGetLastError();
        grid = cus;
    }
    if (grid < 0) return;
    if (hipMemsetAsync((char*)d_ws + WS_CTL, 0, CTL_ZERO_BYTES, stream) != hipSuccess) return;
    Args a{};
    for (int i = 0; i < 15; ++i) a.in[i] = (const float*)d_in[i];
    a.out = (float*)d_out; a.ws = (unsigned char*)d_ws;
    hipLaunchKernelGGL(mega_fwd, dim3(grid), dim3(NTHR), LDS_BYTES, stream, a);
}
```

```cpp
#include <hip/hip_runtime.h>
#include <cstdio>
#include <cstdint>
#include <math.h>
namespace pg8 {
#define PG8_LAS __attribute__((address_space(3)))
typedef unsigned short bf16_t;
typedef short bf16x8 __attribute__((ext_vector_type(8)));
typedef float f32x4 __attribute__((ext_vector_type(4)));
typedef unsigned u32x4 __attribute__((ext_vector_type(4)));
constexpr int BM = 256, BK = 64, HALF = 128, HTB = HALF * BK * 2  , STAGE_BYTES = 8 * HTB, NXCD = 8, WGM = 8;

__host__ __device__ __forceinline__ int lds_byte(int r, int c) { const int st = (r >> 4) * 2 + (c >> 5), rr = r & 15, cc = c & 31, ob = rr * 64 + cc * 2; return st * 1024 + (ob ^ (((ob >> 9) & 1) << 5)); }
__host__ __device__ __forceinline__ void stage_rc(int b, int& R, int& C) { const int st = b / 1024, sb = b % 1024, swz = sb ^ (((sb >> 9) & 1) << 5); R = (st >> 1) * 16 + swz / 64; C = (st & 1) * 32 + (swz % 64) / 2; }
__host__ __device__ __forceinline__ int perm32(int rho) { const int n = rho >> 4, i = rho & 15; return 8 * (i >> 2) + 4 * n + (i & 3); }

struct Unit { int pm, pn; };
struct Gemm { const bf16_t* A; const bf16_t* Bt; int M, N, K; };

struct StaticOrder {
    int nM, nN, nwg, G, c;
    __host__ __device__ void init(int M, int N, int G_, int c_) { nM = M / BM; nN = N / BM; nwg = nM * nN; G = G_; c = c_; }
    __host__ __device__ bool next(int i, Unit& u) const {
        const long L = (long)i * G + c; if (L >= nwg) return false;
        int wgid = (int)L; { const int q = nwg / NXCD, r = nwg % NXCD, xcd = wgid % NXCD, off = wgid / NXCD; wgid = (xcd < r ? xcd * (q + 1) : r * (q + 1) + (xcd - r) * q) + off; }
        const int nig = WGM * nN, gid = wgid / nig, fm = gid * WGM, gsz = (nM - fm) < WGM ? (nM - fm) : WGM;
        u.pm = fm + ((wgid % nig) % gsz); u.pn = (wgid % nig) / gsz; return true;
    }
    __device__ __forceinline__ void a_ready(const Unit&) const {}
    __device__ __forceinline__ void done(const Unit&) const {}
};

__device__ __forceinline__ unsigned cvt_pk_bf16(float lo, float hi) { unsigned r; asm volatile("v_cvt_pk_bf16_f32 %0, %1, %2" : "=v"(r) : "v"(lo), "v"(hi)); return r; }
typedef float f32x2 __attribute__((ext_vector_type(2)));
__device__ __forceinline__ f32x2 gelu_pk(f32x2 v) {
    const f32x2 av = __builtin_elementwise_abs(v), d = av * 0.2316418882f + 1.0f;
    f32x2 t; t.x = __builtin_amdgcn_rcpf(d.x); t.y = __builtin_amdgcn_rcpf(d.y);
    f32x2 q = t * 0.5307027145f + (-0.7265760135f); q = q * t + 0.7107068705f; q = q * t + (-0.142248368f); q = q * t + 0.127414796f; q = q * t;
    const f32x2 s = (v * v) * (-0.72134752044f);
    f32x2 e; e.x = __builtin_amdgcn_exp2f(s.x); e.y = __builtin_amdgcn_exp2f(s.y);
    const f32x2 m = v * (q * e), r = v - m;
    f32x2 o; o.x = v.x < 0.f ? m.x : r.x; o.y = v.y < 0.f ? m.y : r.y; return o;
}
struct EpiZ {
    static constexpr bool PERM = true, AFTER_DRAIN = false;
    bf16_t* O; int ldc; int gelu_tiles;
    __device__ __forceinline__ void operator()(const f32x4 (&acc)[2][2][4][2], const Unit& u, int wr, int wc, int fr, int fq) const {
        const int row0 = u.pm * BM + wr * 64 + fr, col0 = u.pn * BM + wc * 32 + 8 * fq;
        const bool act = u.pn < gelu_tiles;
#pragma unroll
        for (int ai = 0; ai < 2; ++ai)
#pragma unroll
            for (int m = 0; m < 4; ++m) { bf16_t* rowp = O + (size_t)(row0 + ai * HALF + m * 16) * ldc + col0;
#pragma unroll
                for (int bj = 0; bj < 2; ++bj) { f32x4 v0 = acc[ai][bj][m][0], v1 = acc[ai][bj][m][1];
                    if (act) { f32x2 a = gelu_pk((f32x2){v0[0], v0[1]}), b = gelu_pk((f32x2){v0[2], v0[3]}), c = gelu_pk((f32x2){v1[0], v1[1]}), d = gelu_pk((f32x2){v1[2], v1[3]});
                        v0 = (f32x4){a.x, a.y, b.x, b.y}; v1 = (f32x4){c.x, c.y, d.x, d.y}; }
                    u32x4 w; w.x = cvt_pk_bf16(v0[0], v0[1]); w.y = cvt_pk_bf16(v0[2], v0[3]); w.z = cvt_pk_bf16(v1[0], v1[1]); w.w = cvt_pk_bf16(v1[2], v1[3]);
                    *(u32x4*)(rowp + bj * HALF) = w; } }
    }
};
template <bool RES> struct EpiF32 {
    static constexpr bool PERM = false, AFTER_DRAIN = false;
    const float* base; float* C; int ldc;
    __device__ __forceinline__ void operator()(const f32x4 (&acc)[2][2][4][2], const Unit& u, int wr, int wc, int fr, int fq) const {
        const int row0 = u.pm * BM + wr * 64 + fr, col0 = u.pn * BM + wc * 32 + 4 * fq;
#pragma unroll
        for (int ai = 0; ai < 2; ++ai)
#pragma unroll
            for (int m = 0; m < 4; ++m) { const size_t off = (size_t)(row0 + ai * HALF + m * 16) * ldc + col0;
#pragma unroll
                for (int bj = 0; bj < 2; ++bj)
#pragma unroll
                    for (int n = 0; n < 2; ++n) { const size_t o = off + bj * HALF + n * 16; f32x4 v = acc[ai][bj][m][n];
                        if (RES) v = v + *(const f32x4*)(base + o);
                        *(f32x4*)(C + o) = v; } }
    }
};
struct EpiX1 {
    static constexpr bool PERM = false, AFTER_DRAIN = false;
    const float* base; bf16_t* X1; int ldc;
    __device__ __forceinline__ void init(f32x4 (&acc)[2][2][4][2], const Unit& u, int wr, int wc, int fr, int fq) const {
        const int row0 = u.pm * BM + wr * 64 + fr, col0 = u.pn * BM + wc * 32 + 4 * fq;
#pragma unroll
        for (int ai = 0; ai < 2; ++ai)
#pragma unroll
            for (int m = 0; m < 4; ++m) { const size_t off = (size_t)(row0 + ai * HALF + m * 16) * ldc + col0;
#pragma unroll
                for (int bj = 0; bj < 2; ++bj)
#pragma unroll
                    for (int n = 0; n < 2; ++n) acc[ai][bj][m][n] = *(const f32x4*)(base + off + bj * HALF + n * 16); }
    }
    __device__ __forceinline__ void operator()(const f32x4 (&acc)[2][2][4][2], const Unit& u, int wr, int wc, int fr, int fq) const {
        const int row0 = u.pm * BM + wr * 64 + fr, col0 = u.pn * BM + wc * 32 + 4 * fq;
        typedef __bf16 bf2 __attribute__((ext_vector_type(2)));
        typedef unsigned u2 __attribute__((ext_vector_type(2)));
#pragma unroll
        for (int ai = 0; ai < 2; ++ai)
#pragma unroll
            for (int m = 0; m < 4; ++m) { const size_t off = (size_t)(row0 + ai * HALF + m * 16) * ldc + col0;
#pragma unroll
                for (int bj = 0; bj < 2; ++bj)
#pragma unroll
                    for (int n = 0; n < 2; ++n) { const f32x4 v = acc[ai][bj][m][n]; const f32x2 lo = {v[0], v[1]}, hi = {v[2], v[3]};
                        u2 pk; pk.x = __builtin_bit_cast(unsigned, __builtin_convertvector(lo, bf2)); pk.y = __builtin_bit_cast(unsigned, __builtin_convertvector(hi, bf2));
                        *(u2*)(X1 + off + bj * HALF + n * 16) = pk; } }
    }
};
template <class Epi, class Sched, bool ALIGN_EPI = false, bool SP2 = false, bool PRE = false>
__device__ __forceinline__ void gemm_phase_acc(PG8_LAS unsigned char* lds, const Gemm g, const Sched& S, const Epi& E, f32x4 (&acc)[2][2][4][2]) {
    const int tid = threadIdx.x, wid = __builtin_amdgcn_readfirstlane(tid >> 6), lane = tid & 63, wr = wid >> 2, wc = wid & 3, fr = lane & 15, fq = lane >> 4;
    const int K = g.K, nt = K / BK;
    unsigned voffA[2], voffB[2];
#pragma unroll
    for (int i = 0; i < 2; ++i) { int R, C; stage_rc(tid * 16 + i * 8192, R, C); const int Rb = Epi::PERM ? ((R & ~31) + perm32(R & 31)) : R;
        voffA[i] = (unsigned)(R * K + C) * 2u; voffB[i] = (unsigned)(Rb * K + C) * 2u; }
    const size_t kstep = (size_t)(BK * 2);
    const size_t hstep = (size_t)HALF * K * 2;
    const size_t tstep = 2 * hstep;
    const unsigned ldsw = (unsigned)wid * 1024u;
    const int aoff = lds_byte(wr * 64 + fr, fq * 8), boff = lds_byte(wc * 32 + fr, fq * 8);
#define PG8_SA(b, h) (((b) * 2 + (h)) * HTB)
#define PG8_SB(b, h) ((4 + (b) * 2 + (h)) * HTB)
#define PG8_STAGE(bufoff, gbase, voff) do { _Pragma("unroll") for (int _i = 0; _i < 2; ++_i) \
        __builtin_amdgcn_global_load_lds((const unsigned*)((const char*)(gbase) + (voff)[_i]), (PG8_LAS unsigned*)(lds + (bufoff) + ldsw + _i * 8192), 16, 0, 0); } while (0)
#define PG8_LDA(dst, b, h) do { _Pragma("unroll") for (int m = 0; m < 4; ++m) _Pragma("unroll") for (int k = 0; k < 2; ++k) dst[m][k] = *(const PG8_LAS bf16x8*)(lds + PG8_SA(b, h) + aoff + m * 2048 + k * 1024); } while (0)
#define PG8_LDB(dst, b, h) do { _Pragma("unroll") for (int n = 0; n < 2; ++n) _Pragma("unroll") for (int k = 0; k < 2; ++k) dst[n][k] = *(const PG8_LAS bf16x8*)(lds + PG8_SB(b, h) + boff + n * 2048 + k * 1024); } while (0)
#define PG8_MMA(ai, bj, At, Bt) do { __builtin_amdgcn_s_setprio(1); _Pragma("unroll") for (int m = 0; m < 4; ++m) _Pragma("unroll") for (int n = 0; n < 2; ++n) _Pragma("unroll") for (int k = 0; k < 2; ++k) \
        acc[ai][bj][m][n] = __builtin_amdgcn_mfma_f32_16x16x32_bf16(Bt[n][k], At[m][k], acc[ai][bj][m][n], 0, 0, 0); __builtin_amdgcn_s_setprio(0); } while (0)
#define PG8_WAIT_V(n) asm volatile("s_waitcnt vmcnt(" #n ")" ::: "memory")
#define PG8_WAIT_L(n) asm volatile("s_waitcnt lgkmcnt(" #n ")" ::: "memory")
#define PG8_BAR __builtin_amdgcn_s_barrier()
#define PG8_SCHED __builtin_amdgcn_sched_barrier(0)
    Unit cur, nxt; int ui = 0;
    if (!S.next(0, cur)) return;
    if constexpr (!PRE) {
#pragma unroll
    for (int a = 0; a < 2; ++a)
#pragma unroll
        for (int b = 0; b < 2; ++b)
#pragma unroll
            for (int m = 0; m < 4; ++m)
#pragma unroll
                for (int n = 0; n < 2; ++n) acc[a][b][m][n] = (f32x4){0.f, 0.f, 0.f, 0.f};
    }
    bf16x8 At[4][2], B0[2][2], B1[2][2];
    const char* cA = (const char*)g.A + (size_t)cur.pm * tstep; const char* cB = (const char*)g.Bt + (size_t)cur.pn * tstep;
    S.a_ready(cur);
    if constexpr (SP2) {
        PG8_STAGE(PG8_SB(0, 0), cB, voffB); PG8_STAGE(PG8_SB(0, 1), cB + hstep, voffB); PG8_STAGE(PG8_SA(0, 0), cA, voffA); PG8_STAGE(PG8_SA(0, 1), cA + hstep, voffA);
        if (wr == 1) PG8_BAR;
        PG8_WAIT_V(2); PG8_BAR;
        PG8_STAGE(PG8_SB(1, 0), cB + kstep, voffB); PG8_STAGE(PG8_SA(1, 0), cA + kstep, voffA); PG8_STAGE(PG8_SB(1, 1), cB + hstep + kstep, voffB);
        PG8_WAIT_V(6); PG8_BAR;
    } else {
        PG8_STAGE(PG8_SB(0, 0), cB, voffB); PG8_STAGE(PG8_SA(0, 0), cA, voffA); PG8_STAGE(PG8_SB(0, 1), cB + hstep, voffB); PG8_STAGE(PG8_SA(0, 1), cA + hstep, voffA);
        if (wr == 1) PG8_BAR;
        PG8_WAIT_V(4); PG8_BAR;
        PG8_STAGE(PG8_SB(1, 0), cB + kstep, voffB); PG8_STAGE(PG8_SA(1, 0), cA + kstep, voffA); PG8_STAGE(PG8_SB(1, 1), cB + hstep + kstep, voffB);
        PG8_WAIT_V(6); PG8_BAR;
    }
    for (;;) {
        const bool has_next = S.next(ui + 1, nxt);
        const char* nA = has_next ? (const char*)g.A + (size_t)nxt.pm * tstep : cA; const char* nB = has_next ? (const char*)g.Bt + (size_t)nxt.pn * tstep : cB;
        for (int t = 0; t < nt; t += 2) {
            const bool last = (t == nt - 2);
            const char* a1 = cA + (size_t)(t + 1) * kstep;
            const char* a2 = last ? nA : cA + (size_t)(t + 2) * kstep; const char* b2 = last ? nB : cB + (size_t)(t + 2) * kstep;
            const char* a3 = a2 + kstep; const char* b3 = b2 + kstep;
            if (last && has_next) S.a_ready(nxt);
            if constexpr (SP2) {
            PG8_LDB(B0, 0, 0); PG8_LDB(B1, 0, 1); PG8_SCHED; PG8_LDA(At, 0, 0); PG8_STAGE(PG8_SA(1, 1), a1 + hstep, voffA);
            PG8_WAIT_V(8); PG8_WAIT_L(0); PG8_BAR; PG8_MMA(0, 0, At, B0); PG8_MMA(0, 1, At, B1); PG8_BAR; PG8_SCHED;
            PG8_LDA(At, 0, 1); PG8_STAGE(PG8_SB(0, 0), b2, voffB); PG8_STAGE(PG8_SB(0, 1), b2 + hstep, voffB); PG8_STAGE(PG8_SA(0, 0), a2, voffA);
            PG8_WAIT_V(8); PG8_WAIT_L(0); PG8_BAR; PG8_MMA(1, 0, At, B0); PG8_MMA(1, 1, At, B1); PG8_BAR; PG8_SCHED;
            PG8_LDB(B0, 1, 0); PG8_LDB(B1, 1, 1); PG8_SCHED; PG8_LDA(At, 1, 0); PG8_STAGE(PG8_SA(0, 1), a2 + hstep, voffA);
            PG8_WAIT_V(8); PG8_WAIT_L(0); PG8_BAR; PG8_MMA(0, 0, At, B0); PG8_MMA(0, 1, At, B1); PG8_BAR; PG8_SCHED;
            PG8_LDA(At, 1, 1); PG8_STAGE(PG8_SB(1, 0), b3, voffB); PG8_STAGE(PG8_SB(1, 1), b3 + hstep, voffB); PG8_STAGE(PG8_SA(1, 0), a3, voffA);
            PG8_WAIT_V(8); PG8_WAIT_L(0); PG8_BAR; PG8_MMA(1, 0, At, B0); PG8_MMA(1, 1, At, B1); PG8_BAR; PG8_SCHED;
            } else {
            PG8_LDB(B0, 0, 0); PG8_SCHED; PG8_LDA(At, 0, 0); PG8_STAGE(PG8_SA(1, 1), a1 + hstep, voffA);
            PG8_WAIT_L(8); PG8_BAR; PG8_WAIT_L(0); PG8_MMA(0, 0, At, B0); PG8_BAR; PG8_SCHED;
            PG8_LDB(B1, 0, 1); PG8_STAGE(PG8_SB(0, 0), b2, voffB);
            PG8_BAR; PG8_WAIT_L(0); PG8_MMA(0, 1, At, B1); PG8_BAR;
            PG8_LDA(At, 0, 1); PG8_STAGE(PG8_SA(0, 0), a2, voffA);
            PG8_BAR; PG8_WAIT_L(0); PG8_MMA(1, 0, At, B0); PG8_BAR; PG8_SCHED;
            PG8_STAGE(PG8_SB(0, 1), b2 + hstep, voffB);
            PG8_WAIT_V(6); PG8_BAR; PG8_MMA(1, 1, At, B1); PG8_BAR;
            PG8_LDB(B0, 1, 0); PG8_SCHED; PG8_LDA(At, 1, 0); PG8_STAGE(PG8_SA(0, 1), a2 + hstep, voffA);
            PG8_WAIT_L(8); PG8_BAR; PG8_WAIT_L(0); PG8_MMA(0, 0, At, B0); PG8_BAR; PG8_SCHED;
            PG8_LDB(B1, 1, 1); PG8_STAGE(PG8_SB(1, 0), b3, voffB);
            PG8_BAR; PG8_WAIT_L(0); PG8_MMA(0, 1, At, B1); PG8_BAR;
            PG8_LDA(At, 1, 1); PG8_STAGE(PG8_SA(1, 0), a3, voffA);
            PG8_BAR; PG8_WAIT_L(0); PG8_MMA(1, 0, At, B0); PG8_BAR; PG8_SCHED;
            PG8_STAGE(PG8_SB(1, 1), b3 + hstep, voffB);
            PG8_WAIT_V(6); PG8_BAR; PG8_MMA(1, 1, At, B1); PG8_BAR;
            }
        }
        if constexpr (ALIGN_EPI) { if (wr == 0) PG8_BAR; }
        if constexpr (!Epi::AFTER_DRAIN) { E(acc, cur, wr, wc, fr, fq); S.done(cur); }
        if (!has_next) break;
        if constexpr (PRE) E.init(acc, nxt, wr, wc, fr, fq);
        else {
#pragma unroll
        for (int a = 0; a < 2; ++a)
#pragma unroll
            for (int b = 0; b < 2; ++b)
#pragma unroll
                for (int m = 0; m < 4; ++m)
#pragma unroll
                    for (int n = 0; n < 2; ++n) acc[a][b][m][n] = (f32x4){0.f, 0.f, 0.f, 0.f};
        }
        cur = nxt; cA = nA; cB = nB; ++ui;
        if constexpr (ALIGN_EPI) { if (wr == 1) PG8_BAR; }
    }
    PG8_WAIT_V(0);
    if constexpr (!ALIGN_EPI) { if (wr == 0) PG8_BAR; }
    PG8_BAR;
    if constexpr (Epi::AFTER_DRAIN) { E.fused(acc, cur, wr, wc, fr, fq, lds, wid, lane); S.done(cur); }
#undef PG8_SA
#undef PG8_SB
#undef PG8_STAGE
#undef PG8_LDA
#undef PG8_LDB
#undef PG8_MMA
#undef PG8_WAIT_V
#undef PG8_WAIT_L
#undef PG8_BAR
#undef PG8_SCHED
}
template <class Epi, class Sched, bool ALIGN_EPI = false, bool SP2 = false>
__device__ __forceinline__ void gemm_phase(PG8_LAS unsigned char* lds, const Gemm g, const Sched& S, const Epi& E) { f32x4 acc[2][2][4][2]; gemm_phase_acc<Epi, Sched, ALIGN_EPI, SP2, false>(lds, g, S, E, acc); }
}
#ifndef REP_P5
#define REP_P5 1
#endif
#ifndef REP_P0
#define REP_P0 1
#endif
#ifndef REP_P1
#define REP_P1 1
#endif
#ifndef REP_P4
#define REP_P4 1
#endif
#ifndef REP_P0B
#define REP_P0B 1
#endif
#ifndef REP_P0C
#define REP_P0C 1
#endif
#ifndef REP_P2
#define REP_P2 1
#endif
constexpr int T = 8192, D = 2048, NIN = 3328, SEQ = 2048, NE = 16384;
constexpr float EPS = 1e-6f;
constexpr int NWAVES = 8, NTHR = 512;
constexpr size_t MiB = 1u << 20;
constexpr size_t WS_CTL = 0, CTL_ZERO_BYTES = 1 * MiB;
constexpr size_t WS_WIN = 2 * MiB;
constexpr size_t WS_WOUT = 16 * MiB;
constexpr size_t WS_WEFF = 24 * MiB;
constexpr size_t WS_H = 32 * MiB;
constexpr size_t WS_Z = 64 * MiB;
constexpr size_t WS_MIX = 116 * MiB;
constexpr size_t WS_X1 = 148 * MiB;
constexpr size_t WS_SC = 212 * MiB;
constexpr size_t WS_ED = 284 * MiB;
constexpr size_t WS_EU = 316 * MiB;
constexpr int ROWB = 1536;
constexpr size_t WS_SD = 348 * MiB;
constexpr size_t WS_SU = 348 * MiB + 65536;
constexpr size_t WS_TP = 348 * MiB + 196608;
constexpr size_t WS_END = 349 * MiB;
constexpr int CW_TMO = 0, CW_BAR = 4096;
constexpr int RING_OFF = 0, RING_BYTES = 131072;
constexpr int LDSCTL_OFF = RING_BYTES, MISC_OFF = LDSCTL_OFF + 320;
constexpr int LDS_BYTES = 163840;

#define GAS __attribute__((address_space(1)))
#define LAS __attribute__((address_space(3)))
typedef unsigned short bf16;
typedef unsigned v4u __attribute__((ext_vector_type(4)));
typedef unsigned v2u __attribute__((ext_vector_type(2)));
typedef float f32x4 __attribute__((ext_vector_type(4)));
typedef GAS unsigned gu32;
#define LDS_WAIT() asm volatile("s_waitcnt lgkmcnt(0)" ::: "memory")
#define VM_WAIT() asm volatile("s_waitcnt vmcnt(0)" ::: "memory")
__device__ __forceinline__ unsigned f2bf(float f) { unsigned u = __builtin_bit_cast(unsigned, f); return (u + 0x7fffu + ((u >> 16) & 1u)) >> 16; }
__device__ __forceinline__ unsigned pk2(float lo, float hi) { return f2bf(lo) | (f2bf(hi) << 16); }
__device__ __forceinline__ float bf2f(bf16 h) { return __uint_as_float(((unsigned)h) << 16); }
__device__ __forceinline__ float bflo(unsigned w) { return __uint_as_float(w << 16); }
__device__ __forceinline__ float bfhi(unsigned w) { return __uint_as_float(w & 0xffff0000u); }
__device__ __forceinline__ float gelu_erf(float v) { return 0.5f * v * (1.0f + erff(v * 0.70710678118654752f)); }
__device__ __forceinline__ float wave_sum(float v) {
#pragma unroll
    for (int o = 1; o < 64; o <<= 1) v += __shfl_xor(v, o);
    return v;
}

#define XB_TMO      128
#define XB_XCNT(j)  (256  + 64 * (j))
#define XB_XSUB(j)  (1280 + 64 * (j))
#define XB_XGEN(j)  (2304 + 64 * (j))
#define XB_TOP      3328
#define XB_TOPGEN   3392
#define XCD_BAR_WORDS 3456
#define XB_SPIN_CAP (1u << 18)

__device__ __forceinline__ unsigned xb_ld(unsigned* p)              { return __hip_atomic_load(p, __ATOMIC_RELAXED, __HIP_MEMORY_SCOPE_AGENT); }
__device__ __forceinline__ unsigned xb_add(unsigned* p, unsigned v) { return __hip_atomic_fetch_add(p, v, __ATOMIC_RELAXED, __HIP_MEMORY_SCOPE_AGENT); }
__device__ __forceinline__ unsigned xb_xcc_id() { return (unsigned)__builtin_amdgcn_s_getreg((3 << 11) | 20) & 0xFu; }
#define XB_SPIN(cond, bar) do { unsigned _sp = 0; while (cond) { __builtin_amdgcn_s_sleep(1); \
    if ((++_sp & 255u) == 0u) { if (xb_ld(&(bar)[XB_TMO])) break; if (_sp > XB_SPIN_CAP) { atomicAdd(&(bar)[XB_TMO], 1u); break; } } } } while (0)

struct XcdBarrier {
    unsigned* bar; unsigned x;
    volatile LAS unsigned* st;
};

__device__ __forceinline__ XcdBarrier xcd_barrier_post(unsigned* bar, volatile LAS unsigned* st) {
    XcdBarrier b; b.bar = bar; b.x = xb_xcc_id(); b.st = st;
    if (threadIdx.x == 0) (void)xb_add(&bar[XB_XCNT(b.x)], 1u);
    return b;
}
__device__ __forceinline__ void xcd_barrier_complete(unsigned* bar, unsigned x, unsigned& nloc, unsigned& nx) {
    const unsigned G = gridDim.x * gridDim.y * gridDim.z;
    unsigned sum, cnt, mine, sp = 0u;
    for (;;) {
        sum = 0u; cnt = 0u; mine = 0u;
#pragma unroll
        for (unsigned j = 0; j < 16; ++j) { const unsigned c = xb_ld(&bar[XB_XCNT(j)]); sum += c; cnt += (c > 0u) ? 1u : 0u; mine = (j == x) ? c : mine; }
        if (sum == G) break;
        __builtin_amdgcn_s_sleep(1);
        if ((++sp & 255u) == 0u) { if (xb_ld(&bar[XB_TMO])) break; if (sp > XB_SPIN_CAP) { atomicAdd(&bar[XB_TMO], 1u); break; } }
    }
    nloc = mine > 0u ? mine : 1u; nx = cnt > 0u ? cnt : 1u;
}

__device__ __forceinline__ void xcd_barrier_t0(const XcdBarrier& b) {
    {
        unsigned* bar = b.bar;
        __builtin_amdgcn_s_waitcnt(0);
        unsigned nloc = b.st[0], nx = b.st[1];
        if (nloc == 0u) { xcd_barrier_complete(bar, b.x, nloc, nx); b.st[0] = nloc; b.st[1] = nx; }
        const unsigned old = xb_add(&bar[XB_XSUB(b.x)], 1u);
        const unsigned gen = old / nloc;
        if (old + 1u == (gen + 1u) * nloc) {
            __builtin_amdgcn_fence(__ATOMIC_RELEASE, "agent");
            asm volatile("s_waitcnt vmcnt(0)" ::: "memory");
            const unsigned og = xb_add(&bar[XB_TOP], 1u);
            const unsigned tg = og / nx;
            if (og + 1u == (tg + 1u) * nx) xb_add(&bar[XB_TOPGEN], 1u);
            else XB_SPIN(xb_ld(&bar[XB_TOPGEN]) == tg, bar);
            __builtin_amdgcn_fence(__ATOMIC_ACQUIRE, "agent");
            xb_add(&bar[XB_XGEN(b.x)], 1u);
            asm volatile("s_waitcnt vmcnt(0)" ::: "memory");
        } else {
            XB_SPIN(xb_ld(&bar[XB_XGEN(b.x)]) == gen, bar);
            __builtin_amdgcn_fence(__ATOMIC_ACQUIRE, "agent");
            asm volatile("s_waitcnt vmcnt(0)" ::: "memory");
        }
    }
}
__device__ __forceinline__ void xcd_barrier(const XcdBarrier& b) {
    asm volatile("s_waitcnt vmcnt(0)" ::: "memory");
    __syncthreads();
    if (threadIdx.x == 0) xcd_barrier_t0(b);
    __syncthreads();
}
template <class Pre> __device__ __forceinline__ void xcd_barrier_pre(const XcdBarrier& b, const Pre& pre) {
    asm volatile("s_waitcnt vmcnt(0)" ::: "memory");
    __syncthreads();
    const int w_ = __builtin_amdgcn_readfirstlane((int)threadIdx.x >> 6);
    if (w_ != 0) pre();
    if (threadIdx.x == 0) xcd_barrier_t0(b);
    __syncthreads();
    if (w_ == 0) pre();
}

struct Ctx { LAS unsigned char* lds; int tid, lane, wave, G, bid; };

__device__ __forceinline__ void p0_transpose_item(const float* W, int K, int N, bf16* WT, LAS float* scr, int item, int lane) {
    const int nblk = N / 32, kb = item / nblk, nb = item % nblk, k0 = 64 * kb, n0 = 32 * nb;
    float wv[32];
#pragma unroll
    for (int i = 0; i < 32; ++i) wv[i] = W[(size_t)(k0 + 2 * i + (lane >> 5)) * N + n0 + (lane & 31)];
#pragma unroll
    for (int i = 0; i < 32; ++i) scr[(2 * i + (lane >> 5)) * 33 + (lane & 31)] = wv[i];
    LDS_WAIT(); asm volatile("" ::: "memory");
    const int c = lane & 7;
#pragma unroll
    for (int j = 0; j < 4; ++j) { const int n = (lane >> 3) + 8 * j; const LAS float* s = scr + (8 * c) * 33 + n;
        v4u o; o.x = pk2(s[0 * 33], s[1 * 33]); o.y = pk2(s[2 * 33], s[3 * 33]); o.z = pk2(s[4 * 33], s[5 * 33]); o.w = pk2(s[6 * 33], s[7 * 33]);
        *(v4u*)(WT + (size_t)(n0 + n) * K + k0 + 8 * c) = o; }
    LDS_WAIT(); asm volatile("" ::: "memory");
}
__device__ __forceinline__ void rms_row_to_bf16(const float* xr, const float* g, bf16* orow, int lane) {
    f32x4 v[8]; float s = 0.f;
#pragma unroll
    for (int j = 0; j < 8; ++j) { v[j] = *(const f32x4*)(xr + j * 256 + lane * 4); s += (v[j].x * v[j].x + v[j].y * v[j].y) + (v[j].z * v[j].z + v[j].w * v[j].w); }
    const float r = rsqrtf(wave_sum(s) * (1.f / D) + EPS);
#pragma unroll
    for (int j = 0; j < 8; ++j) { const f32x4 gg = *(const f32x4*)(g + j * 256 + lane * 4);
        v2u o; o.x = pk2(v[j].x * r * gg.x, v[j].y * r * gg.y); o.y = pk2(v[j].z * r * gg.z, v[j].w * r * gg.w);
        *(v2u*)(orow + j * 256 + lane * 4) = o; }
}
typedef float f32x2 __attribute__((ext_vector_type(2)));
typedef __bf16 bf16x2v __attribute__((ext_vector_type(2)));
__device__ __forceinline__ unsigned cvtpk(float lo, float hi) { const f32x2 v = {lo, hi}; return __builtin_bit_cast(unsigned, __builtin_convertvector(v, bf16x2v)); }
typedef short bf16x8 __attribute__((ext_vector_type(8)));
typedef float f32x16 __attribute__((ext_vector_type(16)));
__device__ __forceinline__ bf16x8 pack8(float a0, float a1, float a2, float a3, float a4, float a5, float a6, float a7) {
    v4u w; w.x = cvtpk(a0, a1); w.y = cvtpk(a2, a3); w.z = cvtpk(a4, a5); w.w = cvtpk(a6, a7); return __builtin_bit_cast(bf16x8, w); }
__device__ __forceinline__ void split8(const f32x4 a0, const f32x4 a1, bf16x8& hi, bf16x8& lo) {
    hi = pack8(a0[0], a0[1], a0[2], a0[3], a1[0], a1[1], a1[2], a1[3]);
    const v4u w = __builtin_bit_cast(v4u, hi);
    lo = pack8(a0[0] - bflo(w[0]), a0[1] - bfhi(w[0]), a0[2] - bflo(w[1]), a0[3] - bfhi(w[1]), a1[0] - bflo(w[2]), a1[1] - bfhi(w[2]), a1[2] - bflo(w[3]), a1[3] - bfhi(w[3]));
}
typedef __bf16 bf16x32 __attribute__((ext_vector_type(32)));
typedef unsigned v6u __attribute__((ext_vector_type(6)));
typedef float f32x32 __attribute__((ext_vector_type(32)));
__device__ __forceinline__ void p0_rows_to_fp6(const float* ra, const float* rb, unsigned char* da, unsigned char* db, float* ia, float* ib, int lane) {
    f32x4 va[8], vb[8]; float ma = 0.f, mb = 0.f;
#pragma unroll
    for (int i = 0; i < 8; ++i) { va[i] = __builtin_nontemporal_load((const f32x4*)(ra + i * 256 + lane * 4)); vb[i] = __builtin_nontemporal_load((const f32x4*)(rb + i * 256 + lane * 4)); }
#pragma unroll
    for (int i = 0; i < 8; ++i) { const f32x4 t = va[i], u = vb[i];
        ma = fmaxf(fmaxf(ma, fmaxf(fabsf(t.x), fabsf(t.y))), fmaxf(fabsf(t.z), fabsf(t.w))); mb = fmaxf(fmaxf(mb, fmaxf(fabsf(u.x), fabsf(u.y))), fmaxf(fabsf(u.z), fabsf(u.w))); }
#pragma unroll
    for (int o = 1; o < 64; o <<= 1) { ma = fmaxf(ma, __shfl_xor(ma, o)); mb = fmaxf(mb, __shfl_xor(mb, o)); }
    const float sa = ma > 0.f ? 7.f / ma : 0.f, sb = mb > 0.f ? 7.f / mb : 0.f;
    bf16x32 xa, xb;
#pragma unroll
    for (int k = 0; k < 32; ++k) { xa[k] = (__bf16)(va[k >> 2][k & 3] * sa); xb[k] = (__bf16)(vb[k >> 2][k & 3] * sb); }
    const v6u pa = __builtin_amdgcn_cvt_scalef32_pk32_fp6_bf16(xa, 1.0f), pb = __builtin_amdgcn_cvt_scalef32_pk32_fp6_bf16(xb, 1.0f);
#pragma unroll
    for (int q = 0; q < 3; ++q) { *(v2u*)(da + 24 * lane + 8 * q) = (v2u){pa[2 * q], pa[2 * q + 1]}; *(v2u*)(db + 24 * lane + 8 * q) = (v2u){pb[2 * q], pb[2 * q + 1]}; }
    if (lane == 0) { *ia = ma * (1.f / 7.f); *ib = mb * (1.f / 7.f); }
}
constexpr int CONV_SPLIT = 12800;
__device__ __forceinline__ void convert_rows(const float* e_down, const float* e_up, unsigned char* ED, unsigned char* EU, float* SD, float* SU, int r_lo, int r_hi, int w, int nw, int lane) {
    for (int r = r_lo + 2 * w; r < r_hi; r += 2 * nw) {
        const bool up = r >= NE; const int row = up ? r - NE : r;
        const float* s = (up ? e_up : e_down) + (size_t)row * D; unsigned char* d = (up ? EU : ED) + (size_t)row * ROWB; float* iv = (up ? SU : SD) + row;
        p0_rows_to_fp6(s, s + D, d, d + ROWB, iv, iv + 1, lane);
    }
}
__device__ __forceinline__ void p0_prologue(const Ctx& F, const float* x, const float* g1, const float* w_in, const float* w_out, const float* wq, const float* sk,
                                            const float* e_down, const float* e_up, bf16* WinT, bf16* WoutT, bf16* WeffT, bf16* H, unsigned char* ED, unsigned char* EU, float* SD, float* SU, const float* g2) {
    const int gw = F.bid * NWAVES + F.wave, NGW = F.G * NWAVES;
#if defined(TP_PHASE) && TP_PHASE == 12
    volatile unsigned long long* tsp12 = (volatile unsigned long long*)((unsigned char*)SD + 196608);
    if (F.bid == 0 && F.tid == 0) tsp12[0] = wall_clock64();
#endif
    for (int ph = 0; ph < 2; ++ph) {
    if ((ph == 0) == (((F.bid >> 3) & 1) == 0)) {
    {
        LAS float* scr = (LAS float*)(F.lds + RING_OFF + F.wave * 16384);
        constexpr int I_IN = (D / 64) * (NIN / 32), I_OUT = (D / 64) * (D / 32);
        for (int it = gw; it < I_IN + I_OUT; it += NGW) {
            if (it < I_IN) p0_transpose_item(w_in, D, NIN, WinT, scr, it, F.lane);
            else p0_transpose_item(w_out, D, D, WoutT, scr, it - I_IN, F.lane);
        }
    }
    __syncthreads();
    for (int it = gw; it < 16 * 64 * 2; it += NGW) {
        const int g = it & 15, dtile = (it >> 4) & 63, kh = it >> 10, p = g & 1, c = F.lane & 31, h = F.lane >> 5;
        const float* arow = wq + (size_t)(dtile * 32 + c) * 2048 + g * 128 + 8 * h;
        bf16x8 ah[8], al[8];
#pragma unroll
        for (int ks = 0; ks < 8; ++ks) { const f32x4 a0 = *(const f32x4*)(arow + 16 * ks), a1 = *(const f32x4*)(arow + 16 * ks + 4); split8(a0, a1, ah[ks], al[ks]); }
#pragma unroll 1
        for (int kt = 0; kt < 2; ++kt) {
            const int k0 = (kh * 2 + kt) * 32;
            const float* brow = sk + (size_t)(p * 128 + k0 + c) * 128 + 8 * h;
            f32x16 acc;
#pragma unroll
            for (int i = 0; i < 16; ++i) acc[i] = 0.f;
#pragma unroll
            for (int ks = 0; ks < 8; ++ks) { const f32x4 b0 = *(const f32x4*)(brow + 16 * ks), b1 = *(const f32x4*)(brow + 16 * ks + 4); bf16x8 bh, bl; split8(b0, b1, bh, bl);
                acc = __builtin_amdgcn_mfma_f32_32x32x16_bf16(al[ks], bh, acc, 0, 0, 0); acc = __builtin_amdgcn_mfma_f32_32x32x16_bf16(ah[ks], bl, acc, 0, 0, 0);
                acc = __builtin_amdgcn_mfma_f32_32x32x16_bf16(ah[ks], bh, acc, 0, 0, 0); }
            bf16* orow = WeffT + (size_t)(g * 128 + k0 + c) * 2048 + dtile * 32 + 4 * h;
#pragma unroll
            for (int q = 0; q < 4; ++q) { const f32x4 gq = *(const f32x4*)(g2 + dtile * 32 + 4 * h + 8 * q);
                v2u o; o.x = cvtpk(acc[4 * q] * gq[0], acc[4 * q + 1] * gq[1]); o.y = cvtpk(acc[4 * q + 2] * gq[2], acc[4 * q + 3] * gq[3]); *(v2u*)(orow + 8 * q) = o; }
        }
    }
#if defined(TP_PHASE) && TP_PHASE == 12
    __syncthreads(); if (F.bid == 0 && F.tid == 0) tsp12[1] = wall_clock64() - tsp12[0];
#endif
    } else {
    for (int rep_ = 0; rep_ < REP_P0C; ++rep_) convert_rows(e_down, e_up, ED, EU, SD, SU, 0, CONV_SPLIT, gw, NGW, F.lane);
    for (int m = gw; m < T; m += NGW) rms_row_to_bf16(x + (size_t)m * D, g1, H + (size_t)m * D, F.lane);
    }
    }
}

constexpr int SGU_VS = 136;
__device__ __forceinline__ void p2_sgu(const Ctx& F, const bf16* Z, const float* ln_g, const float* ln_b, const float* w_s, const float* b_s, bf16* MIX) {
    LAS bf16* vnT = (LAS bf16*)(F.lds + RING_OFF);
    LAS float* ps = (LAS float*)(F.lds + RING_OFF + 128 * SGU_VS * 2);
    LAS float* pq = ps + 512;
    const int s = F.tid & 127, dq = F.tid >> 7;
    const int c = F.lane & 31, h = F.lane >> 5, tt = F.wave >> 1;
    for (int unit = F.bid; unit < 512; unit += F.G) {
        const int g = unit & 7, t0 = (unit >> 3) * 128;
        __syncthreads();
        float v[32];
        { const bf16* vr = Z + (size_t)(t0 + s) * NIN + 1024 + g * 128 + dq * 32;
#pragma unroll
          for (int j = 0; j < 4; ++j) { const v4u q = *(const v4u*)(vr + 8 * j);
#pragma unroll
              for (int e = 0; e < 4; ++e) { v[8 * j + 2 * e] = bflo(q[e]); v[8 * j + 2 * e + 1] = bfhi(q[e]); } } }
        float sm = 0.f;
#pragma unroll
        for (int j = 0; j < 32; ++j) sm += v[j];
        ps[dq * 128 + s] = sm;
        __syncthreads();
        const float mean = (ps[s] + ps[128 + s] + ps[256 + s] + ps[384 + s]) * (1.f / 128.f);
        float sq = 0.f;
#pragma unroll
        for (int j = 0; j < 32; ++j) { v[j] -= mean; sq += v[j] * v[j]; }
        pq[dq * 128 + s] = sq;
        __syncthreads();
        const float rstd = rsqrtf((pq[s] + pq[128 + s] + pq[256 + s] + pq[384 + s]) * (1.f / 128.f) + EPS);
#pragma unroll
        for (int j = 0; j < 32; ++j) { const int d = dq * 32 + j; vnT[d * SGU_VS + s] = (bf16)f2bf(v[j] * rstd * ln_g[g * 128 + d] + ln_b[g * 128 + d]); }
        __syncthreads();
        f32x16 acc[2];
#pragma unroll
        for (int a = 0; a < 2; ++a)
#pragma unroll
            for (int i = 0; i < 16; ++i) acc[a][i] = 0.f;
        const int trow = 32 * tt + c;
        const float* wrow = w_s + ((size_t)g * 128 + trow) * 128;
        const int dt0 = 2 * (F.wave & 1);
        for (int ks = 0; ks < 2 * (tt + 1); ++ks) {
            const int s0 = 16 * ks + 8 * h;
            const f32x4 w0 = *(const f32x4*)(wrow + s0), w1 = *(const f32x4*)(wrow + s0 + 4);
            float w[8] = {w0[0], w0[1], w0[2], w0[3], w1[0], w1[1], w1[2], w1[3]};
#pragma unroll
            for (int j = 0; j < 8; ++j) w[j] = (s0 + j <= trow) ? w[j] : 0.f;
            const bf16x8 bf = pack8(w[0], w[1], w[2], w[3], w[4], w[5], w[6], w[7]);
#pragma unroll
            for (int a = 0; a < 2; ++a) { const bf16x8 af = *(const LAS bf16x8*)(vnT + (32 * (dt0 + a) + c) * SGU_VS + s0);
                acc[a] = __builtin_amdgcn_mfma_f32_32x32x16_bf16(af, bf, acc[a], 0, 0, 0); }
        }
        const float bias = b_s[g * 128 + trow];
        const size_t tok = (size_t)(t0 + trow);
#pragma unroll
        for (int a = 0; a < 2; ++a)
#pragma unroll
            for (int q = 0; q < 4; ++q) { const int d0 = 32 * (dt0 + a) + 8 * q + 4 * h;
                const v2u uu = *(const v2u*)(Z + tok * NIN + g * 128 + d0);
                v2u o; o.x = cvtpk(bflo(uu.x) * (acc[a][4 * q] + bias), bfhi(uu.x) * (acc[a][4 * q + 1] + bias));
                o.y = cvtpk(bflo(uu.y) * (acc[a][4 * q + 2] + bias), bfhi(uu.y) * (acc[a][4 * q + 3] + bias));
                *(v2u*)(MIX + tok * D + g * 128 + d0) = o; }
    }
}
constexpr int ATT_KS = 72, ATT_VS = 264;
__device__ __forceinline__ void p2_attn(const Ctx& F, const bf16* Z, const float* sinks, bf16* MIX) {
    LAS bf16* Ks = (LAS bf16*)(F.lds + RING_OFF);
    LAS bf16* Vt = (LAS bf16*)(F.lds + RING_OFF + 256 * ATT_KS * 2);
    const int c = F.lane & 31, h = F.lane >> 5;
    for (int unit = F.bid; unit < 256; unit += F.G) {
        const int hg = unit & 1, hk = (unit >> 1) & 1, n = (unit >> 2) & 15, b = unit >> 6;
        __syncthreads();
        for (int e = F.tid; e < 256 * 8; e += NTHR) {
            const int j = e >> 3, ch = e & 7, pos = (n - 1) * 128 + j;
            v4u kv = (v4u){0u, 0u, 0u, 0u}, vv = (v4u){0u, 0u, 0u, 0u};
            if (pos >= 0) { const bf16* row = Z + ((size_t)b * SEQ + pos) * NIN; kv = *(const v4u*)(row + 3072 + hk * 64 + ch * 8); vv = *(const v4u*)(row + 3200 + hk * 64 + ch * 8); }
            *(LAS v4u*)(Ks + j * ATT_KS + ch * 8) = kv;
#pragma unroll
            for (int jj = 0; jj < 8; ++jj) Vt[(ch * 8 + jj) * ATT_VS + j] = (bf16)((vv[jj >> 1] >> (16 * (jj & 1))) & 0xffffu);
        }
        __syncthreads();
        for (int tk = 0; tk < 2; ++tk) {
            const int hq = hk * 8 + hg * 4 + (F.wave >> 1), i0 = 32 * (2 * (F.wave & 1) + tk);
            const size_t tok = (size_t)b * SEQ + n * 128 + i0 + c;
            const bf16* qrow = Z + tok * NIN + 2048 + hq * 64;
            bf16x8 qf[4];
#pragma unroll
            for (int ks = 0; ks < 4; ++ks) qf[ks] = *(const bf16x8*)(qrow + 16 * ks + 8 * h);
            f32x16 sT[5];
#pragma unroll
            for (int kt = 0; kt < 5; ++kt) {
#pragma unroll
                for (int i = 0; i < 16; ++i) sT[kt][i] = 0.f;
#pragma unroll
                for (int ks = 0; ks < 4; ++ks) { const bf16x8 kf = *(const LAS bf16x8*)(Ks + (i0 + 32 * kt + c) * ATT_KS + 16 * ks + 8 * h);
                    sT[kt] = __builtin_amdgcn_mfma_f32_32x32x16_bf16(kf, qf[ks], sT[kt], 0, 0, 0); }
            }
            const float sink = sinks[hq]; float m = sink;
#pragma unroll
            for (int kt = 0; kt < 5; ++kt) {
                const bool tile_ok = (n > 0) || (i0 + 32 * kt >= 128);
#pragma unroll
                for (int i = 0; i < 16; ++i) { const int jj = (i & 3) + 8 * (i >> 2) + 4 * h;
                    bool ok = tile_ok; if (kt == 0) ok = ok && (jj > c); if (kt == 4) ok = ok && (jj <= c);
                    const float x = ok ? sT[kt][i] * 0.125f : -INFINITY; sT[kt][i] = x; m = fmaxf(m, x); }
            }
            m = fmaxf(m, __shfl_xor(m, 32));
            float l = 0.f;
#pragma unroll
            for (int kt = 0; kt < 5; ++kt)
#pragma unroll
                for (int i = 0; i < 16; ++i) { const float p = __expf(sT[kt][i] - m); sT[kt][i] = p; l += p; }
            l += __shfl_xor(l, 32); l += __expf(sink - m);
            f32x16 o[2];
#pragma unroll
            for (int a = 0; a < 2; ++a)
#pragma unroll
                for (int i = 0; i < 16; ++i) o[a][i] = 0.f;
#pragma unroll
            for (int kt = 0; kt < 5; ++kt)
#pragma unroll
                for (int st = 0; st < 2; ++st) {
                    const bf16x8 pf = pack8(sT[kt][8 * st], sT[kt][8 * st + 1], sT[kt][8 * st + 2], sT[kt][8 * st + 3], sT[kt][8 * st + 4], sT[kt][8 * st + 5], sT[kt][8 * st + 6], sT[kt][8 * st + 7]);
                    const int key0 = i0 + 32 * kt + 16 * st + 4 * h;
#pragma unroll
                    for (int a = 0; a < 2; ++a) { const LAS bf16* vp = Vt + (32 * a + c) * ATT_VS + key0;
                        const v2u lo = *(const LAS v2u*)vp, hi = *(const LAS v2u*)(vp + 8);
                        const v4u vw = (v4u){lo.x, lo.y, hi.x, hi.y};
                        o[a] = __builtin_amdgcn_mfma_f32_32x32x16_bf16(__builtin_bit_cast(bf16x8, vw), pf, o[a], 0, 0, 0); }
                }
            const float inv = 1.f / l;
#pragma unroll
            for (int a = 0; a < 2; ++a)
#pragma unroll
                for (int q = 0; q < 4; ++q) { const int d0 = 32 * a + 8 * q + 4 * h;
                    v2u w; w.x = cvtpk(o[a][4 * q] * inv, o[a][4 * q + 1] * inv); w.y = cvtpk(o[a][4 * q + 2] * inv, o[a][4 * q + 3] * inv);
                    *(v2u*)(MIX + tok * D + 1024 + hq * 64 + d0) = w; }
        }
    }
}

typedef __bf16 bf16x2_t __attribute__((ext_vector_type(2)));
constexpr int P5_TOK = 32;
constexpr int P5_WL = 2048;
__device__ __forceinline__ unsigned fkey(float f) { const unsigned u = __float_as_uint(f); return (u & 0x80000000u) ? ~u : (u | 0x80000000u); }
__device__ __forceinline__ float dot2bf(unsigned a, unsigned b, float c) { return __builtin_amdgcn_fdot2_f32_bf16(__builtin_bit_cast(bf16x2_t, a), __builtin_bit_cast(bf16x2_t, b), c, false); }
template <int CTRL, int RM, bool BC> __device__ __forceinline__ float dpp_f(float v) { return __builtin_bit_cast(float, __builtin_amdgcn_update_dpp(0, __builtin_bit_cast(int, v), CTRL, RM, 0xf, BC)); }
struct WaveLds { LAS int* eid; LAS float* gate; LAS float* sv; LAS float* tv; LAS int* ti; LAS int* ctab; };
template <int CTRL> __device__ __forceinline__ unsigned dppx_u(unsigned v) { return (unsigned)__builtin_amdgcn_update_dpp(0, (int)v, CTRL, 0xf, 0xf, true); }
template <int CTRL> __device__ __forceinline__ float dppx_f(float v) { return __builtin_bit_cast(float, __builtin_amdgcn_update_dpp(0, __builtin_bit_cast(int, v), CTRL, 0xf, 0xf, true)); }
__device__ __forceinline__ unsigned umax(unsigned a, unsigned b) { return a > b ? a : b; }
__device__ __forceinline__ unsigned umin(unsigned a, unsigned b) { return a < b ? a : b; }
__device__ __forceinline__ unsigned row_allmax_u(unsigned m) {
    m = umax(m, dppx_u<0xB1>(m)); m = umax(m, dppx_u<0x4E>(m)); m = umax(m, dppx_u<0x141>(m)); m = umax(m, dppx_u<0x140>(m)); return m; }
__device__ __forceinline__ float row_allmax_f(float m) { m = fmaxf(m, dppx_f<0xB1>(m)); m = fmaxf(m, dppx_f<0x4E>(m)); m = fmaxf(m, dppx_f<0x141>(m)); m = fmaxf(m, dppx_f<0x140>(m)); return m; }
__device__ __forceinline__ float row_allsum_f(float m) { m += dppx_f<0xB1>(m); m += dppx_f<0x4E>(m); m += dppx_f<0x141>(m); m += dppx_f<0x140>(m); return m; }
#define P5_CE(a, b) do { const unsigned _h = umax(a, b), _l = umin(a, b); a = _h; b = _l; } while (0)
__device__ __forceinline__ int cand_pair(int c) {
    return c < 16 ? c : c < 24 ? (1 << 4) | (c - 16) : c < 29 ? (2 << 4) | (c - 24) : c < 33 ? (3 << 4) | (c - 29) : c < 36 ? (4 << 4) | (c - 33) : c < 38 ? (5 << 4) | (c - 36)
         : c < 40 ? (6 << 4) | (c - 38) : c < 42 ? (7 << 4) | (c - 40) : c < 50 ? ((c - 34) << 4) : 0xff;
}
__device__ __forceinline__ void p5_topk_fetch(const WaveLds& W, const float* src, int half, int lane) {
#pragma unroll
    for (int i = 0; i < 4; ++i) __builtin_amdgcn_global_load_lds((const unsigned*)(src + i * 256 + lane * 4), (LAS unsigned*)(W.sv + half * 1024 + i * 256), 16, 0, 0);
}
__device__ __forceinline__ void p5_topk_token(const WaveLds& W, const float* sc  , const float* sc_next, float rs  , int lane) {
    const int r = lane >> 4, l15 = lane & 15;
#pragma unroll 1
    for (int pp = 0; pp < 2; ++pp) {
        unsigned k[2][8]; unsigned top[2] = {0u, 0u};
        asm volatile("s_waitcnt vmcnt(0)" ::: "memory");
        { const float* nsrc = pp == 0 ? sc + 1024 : sc_next; if (nsrc != nullptr) p5_topk_fetch(W, nsrc, 1 - pp, lane); }
#pragma unroll
        for (int u = 0; u < 2; ++u) {
            const int L = 4 * (2 * pp + u) + r;
            const f32x4 v0 = *(const LAS f32x4*)(W.sv + L * 128 + 8 * l15) * rs, v1 = *(const LAS f32x4*)(W.sv + L * 128 + 8 * l15 + 4) * rs;
#pragma unroll
            for (int j = 0; j < 4; ++j) { k[u][j] = (fkey(v0[j]) & ~127u) | (unsigned)(127 - (8 * l15 + j)); k[u][4 + j] = (fkey(v1[j]) & ~127u) | (unsigned)(127 - (8 * l15 + 4 + j)); }
            P5_CE(k[u][0], k[u][1]); P5_CE(k[u][2], k[u][3]); P5_CE(k[u][4], k[u][5]); P5_CE(k[u][6], k[u][7]);
            P5_CE(k[u][0], k[u][2]); P5_CE(k[u][1], k[u][3]); P5_CE(k[u][4], k[u][6]); P5_CE(k[u][5], k[u][7]);
            P5_CE(k[u][1], k[u][2]); P5_CE(k[u][5], k[u][6]);
            P5_CE(k[u][0], k[u][4]); P5_CE(k[u][1], k[u][5]); P5_CE(k[u][2], k[u][6]); P5_CE(k[u][3], k[u][7]);
            P5_CE(k[u][2], k[u][4]); P5_CE(k[u][3], k[u][5]);
            P5_CE(k[u][1], k[u][2]); P5_CE(k[u][3], k[u][4]); P5_CE(k[u][5], k[u][6]);
        }
#pragma unroll 4
        for (int it = 0; it < 16; ++it) {
#pragma unroll
            for (int u = 0; u < 2; ++u) {
                const unsigned m = row_allmax_u(k[u][0]); const bool sel = k[u][0] == m;
                top[u] = (l15 == it) ? m : top[u];
#pragma unroll
                for (int j = 0; j < 7; ++j) k[u][j] = sel ? k[u][j + 1] : k[u][j];
                k[u][7] = sel ? 0u : k[u][7];
            }
        }
        LDS_WAIT(); __builtin_amdgcn_wave_barrier();
#pragma unroll
        for (int u = 0; u < 2; ++u) { const int L = 4 * (2 * pp + u) + r; const int idx = 127 - (int)(top[u] & 127u);
            W.tv[L * 16 + l15] = W.sv[L * 128 + idx] * rs; W.ti[L * 16 + l15] = idx; }
    }
    LDS_WAIT(); __builtin_amdgcn_wave_barrier();
    int cij[4];
#pragma unroll
    for (int j = 0; j < 4; ++j) cij[j] = cand_pair(4 * l15 + j);
    unsigned ck[2][4]; unsigned top2[2] = {0u, 0u};
#pragma unroll
    for (int u = 0; u < 2; ++u) {
        const int hd = 4 * u + r; const LAS float* tv0 = W.tv + (2 * hd) * 16; const LAS float* tv1 = tv0 + 16;
#pragma unroll
        for (int j = 0; j < 4; ++j) { const float cs = tv0[(cij[j] >> 4) & 15] + tv1[cij[j] & 15]; const int s = 4 * l15 + j;
            ck[u][j] = (s < 50) ? ((fkey(cs) & ~63u) | (unsigned)(63 - s)) : 0u; }
        P5_CE(ck[u][0], ck[u][1]); P5_CE(ck[u][2], ck[u][3]); P5_CE(ck[u][0], ck[u][2]); P5_CE(ck[u][1], ck[u][3]); P5_CE(ck[u][1], ck[u][2]);
    }
#pragma unroll 4
    for (int it = 0; it < 16; ++it) {
#pragma unroll
        for (int u = 0; u < 2; ++u) {
            const unsigned m = row_allmax_u(ck[u][0]); const bool sel = ck[u][0] == m;
            top2[u] = (l15 == it) ? m : top2[u];
            ck[u][0] = sel ? ck[u][1] : ck[u][0]; ck[u][1] = sel ? ck[u][2] : ck[u][1]; ck[u][2] = sel ? ck[u][3] : ck[u][2]; ck[u][3] = sel ? 0u : ck[u][3];
        }
    }
#pragma unroll
    for (int u = 0; u < 2; ++u) {
        const int hd = 4 * u + r; const LAS float* tv0 = W.tv + (2 * hd) * 16; const LAS float* tv1 = tv0 + 16; const LAS int* ti0 = W.ti + (2 * hd) * 16; const LAS int* ti1 = ti0 + 16;
        const int ij = W.ctab[63 - (int)(top2[u] & 63u)];
        const int i1 = (ij >> 4) & 15, j1 = ij & 15;
        const float vs = tv0[i1] + tv1[j1]; const int e = ti0[i1] * 128 + ti1[j1];
        const float mx = row_allmax_f(vs), ex = __expf(vs - mx), sm = row_allsum_f(ex);
        W.gate[hd * 16 + l15] = ex / sm; W.eid[hd * 16 + l15] = e;
    }
    LDS_WAIT(); __builtin_amdgcn_wave_barrier();
}
constexpr int P5_R = 9;
constexpr int P5_NSL = 16, P5_SLSH = 10;
#ifndef REP_TOPK
#define REP_TOPK 1
#endif
#ifndef REP_DS
#define REP_DS 1
#endif
constexpr int P5_WL2 = 20480;
struct SweepLds { LAS unsigned char* ring; LAS int* feid; LAS float* fcf; LAS float* raw; };
__device__ __forceinline__ int mbcnt64(unsigned long long m) { return __builtin_amdgcn_mbcnt_hi((unsigned)(m >> 32), __builtin_amdgcn_mbcnt_lo((unsigned)m, 0u)); }
template <int CTRL, int RM, bool BC> __device__ __forceinline__ int dpp_i(int v) { return __builtin_amdgcn_update_dpp(0, v, CTRL, RM, 0xf, BC); }
__device__ __forceinline__ float wave_total63(float v) {
    v += dpp_f<0x111, 0xf, true>(v); v += dpp_f<0x112, 0xf, true>(v); v += dpp_f<0x114, 0xf, true>(v); v += dpp_f<0x118, 0xf, true>(v);
    v += dpp_f<0x142, 0xa, false>(v); v += dpp_f<0x143, 0xc, false>(v); return v; }
__device__ __forceinline__ int wave_incl_scan(int v) {
    v += dpp_i<0x111, 0xf, true>(v); v += dpp_i<0x112, 0xf, true>(v); v += dpp_i<0x114, 0xf, true>(v); v += dpp_i<0x118, 0xf, true>(v);
    v += dpp_i<0x142, 0xa, false>(v); v += dpp_i<0x143, 0xc, false>(v); return v; }
#define P5_WRAP(x) ((x) + 1 == P5_R ? 0 : (x) + 1)
#define P5_ISSUE(tab, id_) do { const unsigned char* _gp = (tab) + (size_t)(id_) * ROWB + lane * 16; LAS unsigned char* _lp = L.ring + pslot * ROWB; \
    __builtin_amdgcn_global_load_lds((const unsigned*)_gp, (LAS unsigned*)_lp, 16, 0, 0);                         \
    if (lane < 32) __builtin_amdgcn_global_load_lds((const unsigned*)(_gp + 1024), (LAS unsigned*)(_lp + 1024), 16, 0, 0);     \
    pslot = P5_WRAP(pslot); } while (0)
#define P5_ROWREAD(dst_, slot_) do { const LAS unsigned char* _rp = L.ring + (slot_) * ROWB + lane * 24; const v2u _a = *(const LAS v2u*)_rp, _b = *(const LAS v2u*)(_rp + 8), _c = *(const LAS v2u*)(_rp + 16); \
    dst_[0] = (int)_a.x; dst_[1] = (int)_a.y; dst_[2] = (int)_b.x; dst_[3] = (int)_b.y; dst_[4] = (int)_c.x; dst_[5] = (int)_c.y; } while (0)
typedef int v8i __attribute__((ext_vector_type(8)));
#define P5_V6(x_) ((v6u){(unsigned)x_[0], (unsigned)x_[1], (unsigned)x_[2], (unsigned)x_[3], (unsigned)x_[4], (unsigned)x_[5]})
#define P5_FEID(i_) __builtin_amdgcn_readfirstlane(L.feid[(i_) > 511 ? 511 : (i_)])
typedef _Float16 f16x32 __attribute__((ext_vector_type(32)));
typedef _Float16 f16x2v __attribute__((ext_vector_type(2)));
__device__ __forceinline__ void wave_total63x2(float& a, float& b) {
    a += dpp_f<0x111, 0xf, true>(a); b += dpp_f<0x111, 0xf, true>(b); a += dpp_f<0x112, 0xf, true>(a); b += dpp_f<0x112, 0xf, true>(b);
    a += dpp_f<0x114, 0xf, true>(a); b += dpp_f<0x114, 0xf, true>(b); a += dpp_f<0x118, 0xf, true>(a); b += dpp_f<0x118, 0xf, true>(b);
    a += dpp_f<0x142, 0xa, false>(a); b += dpp_f<0x142, 0xa, false>(b); a += dpp_f<0x143, 0xc, false>(a); b += dpp_f<0x143, 0xc, false>(b);
}
template <bool UP> __device__ __forceinline__ void p5_sweep(const SweepLds& L, const unsigned char* tab, unsigned (&hp)[4][16], const v8i (&hq)[4], const float (&hinv)[4], int lenv0, int lenv1, int lane) {
    const LAS int* cbits = (const LAS int*)L.fcf;
    int pslot = 0, cslot = 2, idx = 0;
    for (int i = 0; i < P5_R; ++i) { const int id = P5_FEID(i); P5_ISSUE(tab, id); }
    int nv0 = L.feid[P5_R], nv1 = L.feid[P5_R + 1];
    asm volatile("s_waitcnt vmcnt(14)" ::: "memory");
    v8i ra = {0, 0, 0, 0, 0, 0, 0, 0}, rb = {0, 0, 0, 0, 0, 0, 0, 0}; P5_ROWREAD(ra, 0); P5_ROWREAD(rb, 1);
    const bool dg0 = (lane & 3) == 0, dg1 = (lane & 3) == 1, dg2 = (lane & 3) == 2, dgv = ((lane & 15) >> 2) == (lane >> 4);
    int cav = 0, cbv = 0; if (UP) { cav = cbits[0]; cbv = cbits[1]; }
    for (int s = 0; s < P5_NSL; ++s) {
        const int lenv = s < 16 ? lenv0 : lenv1;
#pragma unroll
        for (int tok = 0; tok < 4; ++tok) {
            const int n = __builtin_amdgcn_readlane(lenv, (s & 15) * 4 + tok);
            int i = 0;
            for (; i + 1 < n; i += 2) {
                f16x32 xa, xb; f32x4 ma, mb;
                if (UP) { xa = __builtin_amdgcn_cvt_scalef32_pk32_f16_fp6(P5_V6(ra), 1.0f); xb = __builtin_amdgcn_cvt_scalef32_pk32_f16_fp6(P5_V6(rb), 1.0f); }
                else { const f32x4 z = {0.f, 0.f, 0.f, 0.f};
                    ma = __builtin_amdgcn_mfma_scale_f32_16x16x128_f8f6f4(ra, hq[tok], z, 2  , 2  , 0, 0, 0, 0);
                    mb = __builtin_amdgcn_mfma_scale_f32_16x16x128_f8f6f4(rb, hq[tok], z, 2, 2, 0, 0, 0, 0); }
                const f16x2v ca = __builtin_bit_cast(f16x2v, __builtin_amdgcn_readfirstlane(cav)), cb = __builtin_bit_cast(f16x2v, __builtin_amdgcn_readfirstlane(cbv));
                { const int id0 = __builtin_amdgcn_readfirstlane(nv0), id1 = __builtin_amdgcn_readfirstlane(nv1); P5_ISSUE(tab, id0); P5_ISSUE(tab, id1); }
                nv0 = L.feid[idx + 2 + P5_R > 511 ? 511 : idx + 2 + P5_R]; nv1 = L.feid[idx + 3 + P5_R > 511 ? 511 : idx + 3 + P5_R];
                if (UP) { cav = cbits[idx + 2 > 511 ? 511 : idx + 2]; cbv = cbits[idx + 3 > 511 ? 511 : idx + 3]; }
                asm volatile("s_waitcnt vmcnt(14)" ::: "memory");
                const int cs1 = P5_WRAP(cslot);
                P5_ROWREAD(ra, cslot); P5_ROWREAD(rb, cs1);
                cslot = P5_WRAP(cs1);
                __builtin_amdgcn_sched_barrier(0);
                if (!UP) {
                    float a0 = ma[0], a1 = ma[1], a2 = ma[2], a3 = ma[3], b0 = mb[0], b1 = mb[1], b2 = mb[2], b3 = mb[3];
                    asm volatile("" : "+v"(a0), "+v"(a1), "+v"(a2), "+v"(a3), "+v"(b0), "+v"(b1), "+v"(b2), "+v"(b3));
                    float ta = dg0 ? a0 : dg1 ? a1 : dg2 ? a2 : a3, tb = dg0 ? b0 : dg1 ? b1 : dg2 ? b2 : b3;
                    ta = dgv ? ta : 0.f; tb = dgv ? tb : 0.f; wave_total63x2(ta, tb);
                    L.raw[idx] = __builtin_bit_cast(float, __builtin_amdgcn_readlane(__builtin_bit_cast(int, ta), 63)) * hinv[tok];
                    L.raw[idx + 1] = __builtin_bit_cast(float, __builtin_amdgcn_readlane(__builtin_bit_cast(int, tb), 63)) * hinv[tok];
                } else {
#pragma unroll
                    for (int k = 0; k < 16; ++k) hp[tok][k] = __builtin_bit_cast(unsigned, __builtin_elementwise_fma((f16x2v){xa[2 * k], xa[2 * k + 1]}, ca, __builtin_bit_cast(f16x2v, hp[tok][k])));
                    __builtin_amdgcn_sched_barrier(0);
#pragma unroll
                    for (int k = 0; k < 16; ++k) hp[tok][k] = __builtin_bit_cast(unsigned, __builtin_elementwise_fma((f16x2v){xb[2 * k], xb[2 * k + 1]}, cb, __builtin_bit_cast(f16x2v, hp[tok][k])));
                }
                idx += 2;
            }
            if (i < n) {
                f16x32 xa; f32x4 ma;
                if (UP) xa = __builtin_amdgcn_cvt_scalef32_pk32_f16_fp6(P5_V6(ra), 1.0f);
                else { const f32x4 z = {0.f, 0.f, 0.f, 0.f}; ma = __builtin_amdgcn_mfma_scale_f32_16x16x128_f8f6f4(ra, hq[tok], z, 2, 2, 0, 0, 0, 0); }
                const f16x2v ca = __builtin_bit_cast(f16x2v, __builtin_amdgcn_readfirstlane(cav));
                ra = rb; cav = cbv;
                { const int id0 = __builtin_amdgcn_readfirstlane(nv0); P5_ISSUE(tab, id0); }
                nv0 = nv1; nv1 = L.feid[idx + 2 + P5_R > 511 ? 511 : idx + 2 + P5_R];
                if (UP) cbv = cbits[idx + 2 > 511 ? 511 : idx + 2];
                asm volatile("s_waitcnt vmcnt(14)" ::: "memory");
                P5_ROWREAD(rb, cslot);
                cslot = P5_WRAP(cslot);
                __builtin_amdgcn_sched_barrier(0);
                if (!UP) {
                    float a0 = ma[0], a1 = ma[1], a2 = ma[2], a3 = ma[3];
                    asm volatile("" : "+v"(a0), "+v"(a1), "+v"(a2), "+v"(a3));
                    float ta = dg0 ? a0 : dg1 ? a1 : dg2 ? a2 : a3; ta = wave_total63(dgv ? ta : 0.f);
                    L.raw[idx] = __builtin_bit_cast(float, __builtin_amdgcn_readlane(__builtin_bit_cast(int, ta), 63)) * hinv[tok];
                } else {
#pragma unroll
                    for (int k = 0; k < 16; ++k) hp[tok][k] = __builtin_bit_cast(unsigned, __builtin_elementwise_fma((f16x2v){xa[2 * k], xa[2 * k + 1]}, ca, __builtin_bit_cast(f16x2v, hp[tok][k])));
                }
                idx += 1;
            }
        }
    }
    asm volatile("s_waitcnt vmcnt(0)" ::: "memory");
}
__device__ __forceinline__ void p5_wave(LAS unsigned char* wl, const float* SC, const bf16* X1, const unsigned char* ED, const unsigned char* EU, const float* SD, const float* SU,
                                        const float* gf, float* out, int t0, int lane, const float* g2) {
    SweepLds L; L.ring = wl; L.feid = (LAS int*)(wl + 14336); L.fcf = (LAS float*)(wl + 14336 + 2048); L.raw = (LAS float*)(wl + 14336 + 4096);
    { LAS int* ctab = (LAS int*)(wl + 14336); ctab[lane] = cand_pair(lane); }
    unsigned hp[4][16]; float rsv[4]; v8i hq[4]; float hinv[4];
    {   f32x4 gl[8];
        int ls = lane; asm volatile("" : "+v"(ls));
#pragma unroll
        for (int i = 0; i < 8; ++i) gl[i] = *(const f32x4*)(g2 + i * 256 + ls * 4);
        v2u xq[4][8];
#pragma unroll
        for (int tk = 0; tk < 4; ++tk)
#pragma unroll
            for (int i = 0; i < 8; ++i) xq[tk][i] = *(const v2u*)(X1 + (size_t)(t0 + 8 * tk) * D + i * 256 + ls * 4);
#pragma unroll
        for (int tk = 0; tk < 4; ++tk) { float ss = 0.f;
#pragma unroll
            for (int i = 0; i < 8; ++i)
#pragma unroll
                for (int e = 0; e < 2; ++e) { const float a = bflo(xq[tk][i][e]), b = bfhi(xq[tk][i][e]); ss += a * a + b * b; }
            const float rs = __builtin_amdgcn_rsqf(wave_sum(ss) * (1.f / D) + EPS); rsv[tk] = rs;
            float hx[32]; float mx = 0.f;
#pragma unroll
            for (int i = 0; i < 8; ++i)
#pragma unroll
                for (int e = 0; e < 2; ++e) {
                    hx[4 * i + 2 * e] = bflo(xq[tk][i][e]) * rs * gl[i][2 * e]; hx[4 * i + 2 * e + 1] = bfhi(xq[tk][i][e]) * rs * gl[i][2 * e + 1];
                    mx = fmaxf(mx, fmaxf(fabsf(hx[4 * i + 2 * e]), fabsf(hx[4 * i + 2 * e + 1]))); }
#pragma unroll
            for (int o = 1; o < 64; o <<= 1) mx = fmaxf(mx, __shfl_xor(mx, o));
            const float hs = mx > 0.f ? 7.f / mx : 0.f; hinv[tk] = mx * (1.f / 7.f);
            bf16x32 hb;
#pragma unroll
            for (int k = 0; k < 32; ++k) hb[k] = (__bf16)(hx[k] * hs);
            const v6u pk = __builtin_amdgcn_cvt_scalef32_pk32_fp6_bf16(hb, 1.0f);
            hq[tk] = (v8i){(int)pk[0], (int)pk[1], (int)pk[2], (int)pk[3], (int)pk[4], (int)pk[5], 0, 0};
        }
    }
    LDS_WAIT(); __builtin_amdgcn_wave_barrier();
    for (int rep_ = 0; rep_ < REP_TOPK; ++rep_)
    for (int tk = 0; tk < 4; ++tk) {
        if (tk == 0) { WaveLds W0; W0.sv = (LAS float*)(wl + 4096); p5_topk_fetch(W0, SC + (size_t)t0 * 2048, 0, lane); }
        WaveLds W; W.eid = (LAS int*)(wl + 1024 * tk); W.gate = (LAS float*)(wl + 1024 * tk + 512);
        W.sv = (LAS float*)(wl + 4096); W.tv = (LAS float*)(wl + 12288); W.ti = (LAS int*)(wl + 13312); W.ctab = (LAS int*)(wl + 14336);
        p5_topk_token(W, SC + (size_t)(t0 + 8 * tk) * 2048, tk < 3 ? SC + (size_t)(t0 + 8 * tk + 8) * 2048 : nullptr, rsv[tk], lane);
    }
    int lenv0 = 0, lenv1 = 0;
#pragma unroll
    for (int tk = 0; tk < 4; ++tk) {
        const LAS int* ue = (const LAS int*)(wl + 1024 * tk); const int sl0 = ue[lane] >> P5_SLSH, sl1 = ue[lane + 64] >> P5_SLSH;
        for (int k = 0; k < P5_NSL; ++k) { const int c = __popcll(__ballot(sl0 == k)) + __popcll(__ballot(sl1 == k));
            if (lane == (k & 15) * 4 + tk) { if (k < 16) lenv0 = c; else lenv1 = c; } }
    }
    const int incl0 = wave_incl_scan(lenv0), tot0 = __builtin_amdgcn_readlane(incl0, 63);
    const int base0 = incl0 - lenv0, base1 = wave_incl_scan(lenv1) - lenv1 + tot0;
#pragma unroll
    for (int tk = 0; tk < 4; ++tk) {
        const LAS int* ue = (const LAS int*)(wl + 1024 * tk); const LAS float* ug = (const LAS float*)(wl + 1024 * tk + 512);
        const int e0 = ue[lane], e1 = ue[lane + 64], sl0 = e0 >> P5_SLSH, sl1 = e1 >> P5_SLSH; const float g0 = ug[lane], g1 = ug[lane + 64];
        int r0 = 0, r1 = 0;
        for (int k = 0; k < P5_NSL; ++k) { const unsigned long long m0 = __ballot(sl0 == k), m1 = __ballot(sl1 == k);
            if (sl0 == k) r0 = mbcnt64(m0);
            if (sl1 == k) r1 = __popcll(m0) + mbcnt64(m1); }
        const int b00 = __shfl(base0, (sl0 & 15) * 4 + tk), b01 = __shfl(base1, (sl0 & 15) * 4 + tk), b10 = __shfl(base0, (sl1 & 15) * 4 + tk), b11 = __shfl(base1, (sl1 & 15) * 4 + tk);
        const int p0 = (sl0 < 16 ? b00 : b01) + r0, p1 = (sl1 < 16 ? b10 : b11) + r1;
        L.feid[p0] = e0; L.fcf[p0] = g0; L.feid[p1] = e1; L.fcf[p1] = g1;
    }
    LDS_WAIT(); __builtin_amdgcn_wave_barrier();
    for (int rep_ = 0; rep_ < REP_DS; ++rep_) p5_sweep<false>(L, ED, hp, hq, hinv, lenv0, lenv1, lane);
    LDS_WAIT(); __builtin_amdgcn_wave_barrier();
    float cmax = 0.f;
    {   float sdv[8], suv[8], cv[8];
#pragma unroll
        for (int k = 0; k < 8; ++k) { const int id = L.feid[lane + 64 * k]; sdv[k] = SD[id]; suv[k] = SU[id]; }
#pragma unroll
        for (int k = 0; k < 8; ++k) { const int i = lane + 64 * k; cv[k] = gelu_erf(L.raw[i] * sdv[k]) * L.fcf[i] * suv[k]; cmax = fmaxf(cmax, fabsf(cv[k])); }
#pragma unroll
        for (int o = 1; o < 64; o <<= 1) cmax = fmaxf(cmax, __shfl_xor(cmax, o));
        const float cinv = cmax > 0.f ? 1.f / cmax : 0.f;
#pragma unroll
        for (int k = 0; k < 8; ++k) { const _Float16 h = (_Float16)(cv[k] * cinv); ((LAS unsigned*)L.fcf)[lane + 64 * k] = __builtin_bit_cast(unsigned, (f16x2v){h, h}); }
    }
    LDS_WAIT(); __builtin_amdgcn_wave_barrier();
    asm volatile("s_waitcnt vmcnt(0)" ::: "memory");
#pragma unroll
    for (int tk = 0; tk < 4; ++tk)
#pragma unroll
        for (int q = 0; q < 16; ++q) hp[tk][q] = 0u;
    p5_sweep<true>(L, EU, hp, hq, hinv, lenv0, lenv1, lane);
    int le = lane; asm volatile("" : "+v"(le));
#pragma unroll
    for (int tk = 0; tk < 4; ++tk) {
        const size_t ro = (size_t)(t0 + 8 * tk) * D; float ss = 0.f; float st[32];
#pragma unroll
        for (int i = 0; i < 8; ++i) { const v2u xa = __builtin_nontemporal_load((const v2u*)(X1 + ro + i * 256 + le * 4));
#pragma unroll
            for (int c = 0; c < 2; ++c) { const int k = 4 * i + 2 * c; const f16x2v a = __builtin_bit_cast(f16x2v, hp[tk][k >> 1]);
                st[k] = (float)a.x * cmax + bflo(xa[c]); st[k + 1] = (float)a.y * cmax + bfhi(xa[c]); ss += st[k] * st[k] + st[k + 1] * st[k + 1]; } }
        const float r = rsqrtf(wave_sum(ss) * (1.f / D) + EPS);
#pragma unroll
        for (int i = 0; i < 8; ++i) { const f32x4 g = *(const f32x4*)(gf + i * 256 + le * 4); f32x4 a;
#pragma unroll
            for (int c = 0; c < 4; ++c) a[c] = st[4 * i + c] * r * g[c];
            __builtin_nontemporal_store(a, (f32x4*)(out + ro + i * 256 + le * 4)); }
    }
}
__device__ __forceinline__ void p5_peer(const Ctx& F, const float* SC, const bf16* X1, const unsigned char* ED, const unsigned char* EU, const float* SD, const float* SU, const float* gf, float* out, const float* g2) {
    for (int tile = F.bid; tile < T / P5_TOK; tile += F.G)
        p5_wave(F.lds + F.wave * P5_WL2, SC, X1, ED, EU, SD, SU, gf, out, tile * P5_TOK + F.wave, F.lane, g2);
}

struct Args { const float* in[15]; float* out; unsigned char* ws; };
__global__ void __launch_bounds__(NTHR, 2) mega_fwd(Args args) {
    extern __shared__ __attribute__((aligned(16))) unsigned char lds_raw[];
    Ctx F; F.lds = (LAS unsigned char*)lds_raw; F.tid = threadIdx.x; F.lane = F.tid & 63; F.wave = __builtin_amdgcn_readfirstlane(F.tid >> 6); F.G = gridDim.x; F.bid = blockIdx.x;
    volatile LAS unsigned* MISC = (volatile LAS unsigned*)(F.lds + MISC_OFF);
    unsigned char* ws = args.ws; unsigned* ctl = (unsigned*)(ws + WS_CTL);
    const float* x = args.in[0]; const float* norm1_g = args.in[1]; const float* w_in = args.in[2]; const float* sgu_ln_g = args.in[3]; const float* sgu_ln_b = args.in[4];
    const float* w_spatial = args.in[5]; const float* b_spatial = args.in[6]; const float* attn_sinks = args.in[7]; const float* w_out = args.in[8]; const float* norm2_g = args.in[9];
    const float* w_query = args.in[10]; const float* sub_keys = args.in[11]; const float* expert_down = args.in[12]; const float* expert_up = args.in[13]; const float* norm_f_g = args.in[14];
    bf16* WinT = (bf16*)(ws + WS_WIN); bf16* WoutT = (bf16*)(ws + WS_WOUT); bf16* WeffT = (bf16*)(ws + WS_WEFF); bf16* H = (bf16*)(ws + WS_H);
    bf16* Z = (bf16*)(ws + WS_Z); bf16* MIX = (bf16*)(ws + WS_MIX); bf16* X1 = (bf16*)(ws + WS_X1); float* SC = (float*)(ws + WS_SC);
    unsigned char* ED = ws + WS_ED; unsigned char* EU = ws + WS_EU; float* SD = (float*)(ws + WS_SD); float* SU = (float*)(ws + WS_SU);
    for (int u = F.tid; u < (LDS_BYTES - LDSCTL_OFF) / 4; u += NTHR) ((LAS unsigned*)(F.lds + LDSCTL_OFF))[u] = 0u;
    __syncthreads();
    XcdBarrier bar = xcd_barrier_post(ctl + CW_BAR, MISC + 8);
#ifdef TP_PHASE
    volatile unsigned long long* tsp = (volatile unsigned long long*)(ws + WS_TP);
#define TP_BEGIN(k) do { if ((k) == TP_PHASE && F.bid == 0 && F.tid == 0) tsp[0] = wall_clock64(); } while (0)
#define TP_END(k) do { if ((k) == TP_PHASE && F.bid == 0 && F.tid == 0) tsp[1] = wall_clock64() - tsp[0]; } while (0)
#else
#define TP_BEGIN(k) do { } while (0)
#define TP_END(k) do { } while (0)
#endif
    TP_BEGIN(0);

    for (int rep = 0; rep < REP_P0; ++rep) p0_prologue(F, x, norm1_g, w_in, w_out, w_query, sub_keys, expert_down, expert_up, WinT, WoutT, WeffT, H, ED, EU, SD, SU, norm2_g);
    xcd_barrier(bar); TP_END(0); TP_BEGIN(1);
#if defined(TP_PHASE) && TP_PHASE == 11
    if (F.bid == F.G - 1 && F.tid == 0) tsp[0] = wall_clock64();
#endif
    for (int rep_ = 0; rep_ < REP_P1; ++rep_)
    {   pg8::Gemm g{H, WinT, T, NIN, D}; pg8::StaticOrder S; S.init(T, NIN, F.G, F.bid);
        pg8::EpiZ E{Z, NIN, 8};
        pg8::gemm_phase<pg8::EpiZ, pg8::StaticOrder, true, true>(F.lds + RING_OFF, g, S, E); }
    {
        const int nU = (T / 256) * (NIN / 256), maxu = (nU + F.G - 1) / F.G, nfull = nU - (maxu - 1) * F.G;
        const bool all = nfull == F.G; const int nidle = all ? F.G : F.G - nfull, q = all ? F.bid : F.bid - nfull;
        if (q >= 0) convert_rows(expert_down, expert_up, ED, EU, SD, SU, CONV_SPLIT, 2 * NE, q * NWAVES + F.wave, nidle * NWAVES, F.lane);
#if defined(TP_PHASE) && TP_PHASE == 11
        __syncthreads(); if (F.bid == F.G - 1 && F.tid == 0) tsp[1] = wall_clock64() - tsp[0];
#endif
    }
    xcd_barrier(bar); TP_END(1); TP_BEGIN(2);
    for (int rep = 0; rep < REP_P2; ++rep) { p2_sgu(F, Z, sgu_ln_g, sgu_ln_b, w_spatial, b_spatial, MIX); p2_attn(F, Z, attn_sinks, MIX); }
    {   pg8::Gemm g{MIX, WoutT, T, D, D}; pg8::StaticOrder S; S.init(T, D, F.G, F.bid);
        pg8::EpiX1 E{x, X1, D};
        pg8::f32x4 acc[2][2][4][2]; pg8::Unit u0; const bool has0 = S.next(0, u0);
        const int wr_ = F.wave >> 2, wc_ = F.wave & 3, fr_ = F.lane & 15, fq_ = F.lane >> 4;
        xcd_barrier_pre(bar, [&]() { if (has0) E.init(acc, u0, wr_, wc_, fr_, fq_); }); TP_END(2); TP_BEGIN(3);
        pg8::gemm_phase_acc<pg8::EpiX1, pg8::StaticOrder, true, true, true>(F.lds + RING_OFF, g, S, E, acc); }
    xcd_barrier(bar); TP_END(3); TP_BEGIN(4);
    {   pg8::Gemm g{X1, WeffT, T, D, D}; pg8::StaticOrder S; S.init(T, D, F.G, F.bid);
        pg8::EpiF32<false> E{nullptr, SC, D};
        pg8::gemm_phase<pg8::EpiF32<false>, pg8::StaticOrder, true, true>(F.lds + RING_OFF, g, S, E); }
    xcd_barrier(bar); TP_END(4); TP_BEGIN(5);
    for (int rep = 0; rep < REP_P5; ++rep) p5_peer(F, SC, X1, ED, EU, SD, SU, norm_f_g, args.out, norm2_g);
#ifdef TP_PHASE
    xcd_barrier(bar); TP_END(5);
    if (F.bid == 0 && F.tid == 0) { const unsigned long long t0 = wall_clock64(), w = (unsigned long long)TP_W * tsp[1]; while (wall_clock64() - t0 < w) __builtin_amdgcn_s_sleep(16); }
#endif
}

extern "C" void kernel_launch(void* const* d_in, const int* in_sizes, int n_in, void* d_out, int out_size, void* d_ws, size_t ws_size, hipStream_t stream) {
    static int grid = 0;
    if (grid == 0) {
        if (n_in != 15 || ws_size < WS_END) { fprintf(stderr, "kernel_launch: unexpected inputs / workspace\n"); grid = -1; return; }
        int dev = 0, cus = 0, per_cu = 0;
        if (hipGetDevice(&dev) != hipSuccess || hipDeviceGetAttribute(&cus, hipDeviceAttributeMultiprocessorCount, dev) != hipSuccess) { grid = -1; return; }
        if (hipFuncSetAttribute((const void*)mega_fwd, hipFuncAttributeMaxDynamicSharedMemorySize, LDS_BYTES) != hipSuccess) { fprintf(stderr, "kernel_launch: hipFuncSetAttribute failed\n"); grid = -1; return; }
        if (hipOccupancyMaxActiveBlocksPerMultiprocessor(&per_cu, (const void*)mega_fwd, NTHR, LDS_BYTES) != hipSuccess || per_cu < 1)
            fprintf(stderr, "kernel_launch: note: occupancy query reports %d workgroups per CU\n", per_cu);
        (void)hipGetLastError();
        grid = cus;
    }
    if (grid < 0) return;
    if (hipMemsetAsync((char*)d_ws + WS_CTL, 0, CTL_ZERO_BYTES, stream) != hipSuccess) return;
    Args a{};
    for (int i = 0; i < 15; ++i) a.in[i] = (const float*)d_in[i];
    a.out = (float*)d_out; a.ws = (unsigned char*)d_ws;
    hipLaunchKernelGGL(mega_fwd, dim3(grid), dim3(NTHR), LDS_BYTES, stream, a);
}
```

```cpp
#include <hip/hip_runtime.h>
#include <cstdio>
#include <cstdint>
#include <math.h>
namespace pg8 {
#define PG8_LAS __attribute__((address_space(3)))
typedef unsigned short bf16_t;
typedef short bf16x8 __attribute__((ext_vector_type(8)));
typedef float f32x4 __attribute__((ext_vector_type(4)));
typedef unsigned u32x4 __attribute__((ext_vector_type(4)));
constexpr int BM = 256, BK = 64, HALF = 128, HTB = HALF * BK * 2  , STAGE_BYTES = 8 * HTB, NXCD = 8, WGM = 8;

__host__ __device__ __forceinline__ int lds_byte(int r, int c) { const int st = (r >> 4) * 2 + (c >> 5), rr = r & 15, cc = c & 31, ob = rr * 64 + cc * 2; return st * 1024 + (ob ^ (((ob >> 9) & 1) << 5)); }
__host__ __device__ __forceinline__ void stage_rc(int b, int& R, int& C) { const int st = b / 1024, sb = b % 1024, swz = sb ^ (((sb >> 9) & 1) << 5); R = (st >> 1) * 16 + swz / 64; C = (st & 1) * 32 + (swz % 64) / 2; }
__host__ __device__ __forceinline__ int perm32(int rho) { const int n = rho >> 4, i = rho & 15; return 8 * (i >> 2) + 4 * n + (i & 3); }

struct Unit { int pm, pn; };
struct Gemm { const bf16_t* A; const bf16_t* Bt; int M, N, K; };

struct StaticOrder {
    int nM, nN, nwg, G, c;
    __host__ __device__ void init(int M, int N, int G_, int c_) { nM = M / BM; nN = N / BM; nwg = nM * nN; G = G_; c = c_; }
    __host__ __device__ bool next(int i, Unit& u) const {
        const long L = (long)i * G + c; if (L >= nwg) return false;
        int wgid = (int)L; { const int q = nwg / NXCD, r = nwg % NXCD, xcd = wgid % NXCD, off = wgid / NXCD; wgid = (xcd < r ? xcd * (q + 1) : r * (q + 1) + (xcd - r) * q) + off; }
        const int nig = WGM * nN, gid = wgid / nig, fm = gid * WGM, gsz = (nM - fm) < WGM ? (nM - fm) : WGM;
        u.pm = fm + ((wgid % nig) % gsz); u.pn = (wgid % nig) / gsz; return true;
    }
    __device__ __forceinline__ void a_ready(const Unit&) const {}
    __device__ __forceinline__ void done(const Unit&) const {}
};

__device__ __forceinline__ unsigned cvt_pk_bf16(float lo, float hi) { unsigned r; asm volatile("v_cvt_pk_bf16_f32 %0, %1, %2" : "=v"(r) : "v"(lo), "v"(hi)); return r; }
typedef float f32x2 __attribute__((ext_vector_type(2)));
__device__ __forceinline__ f32x2 gelu_pk(f32x2 v) {
    const f32x2 av = __builtin_elementwise_abs(v), d = av * 0.2316418882f + 1.0f;
    f32x2 t; t.x = __builtin_amdgcn_rcpf(d.x); t.y = __builtin_amdgcn_rcpf(d.y);
    f32x2 q = t * 0.5307027145f + (-0.7265760135f); q = q * t + 0.7107068705f; q = q * t + (-0.142248368f); q = q * t + 0.127414796f; q = q * t;
    const f32x2 s = (v * v) * (-0.72134752044f);
    f32x2 e; e.x = __builtin_amdgcn_exp2f(s.x); e.y = __builtin_amdgcn_exp2f(s.y);
    const f32x2 m = v * (q * e), r = v - m;
    f32x2 o; o.x = v.x < 0.f ? m.x : r.x; o.y = v.y < 0.f ? m.y : r.y; return o;
}
struct EpiZ {
    static constexpr bool PERM = true, AFTER_DRAIN = false;
    bf16_t* O; int ldc; int gelu_tiles;
    __device__ __forceinline__ void operator()(const f32x4 (&acc)[2][2][4][2], const Unit& u, int wr, int wc, int fr, int fq) const {
        const int row0 = u.pm * BM + wr * 64 + fr, col0 = u.pn * BM + wc * 32 + 8 * fq;
        const bool act = u.pn < gelu_tiles;
#pragma unroll
        for (int ai = 0; ai < 2; ++ai)
#pragma unroll
            for (int m = 0; m < 4; ++m) { bf16_t* rowp = O + (size_t)(row0 + ai * HALF + m * 16) * ldc + col0;
#pragma unroll
                for (int bj = 0; bj < 2; ++bj) { f32x4 v0 = acc[ai][bj][m][0], v1 = acc[ai][bj][m][1];
                    if (act) { f32x2 a = gelu_pk((f32x2){v0[0], v0[1]}), b = gelu_pk((f32x2){v0[2], v0[3]}), c = gelu_pk((f32x2){v1[0], v1[1]}), d = gelu_pk((f32x2){v1[2], v1[3]});
                        v0 = (f32x4){a.x, a.y, b.x, b.y}; v1 = (f32x4){c.x, c.y, d.x, d.y}; }
                    u32x4 w; w.x = cvt_pk_bf16(v0[0], v0[1]); w.y = cvt_pk_bf16(v0[2], v0[3]); w.z = cvt_pk_bf16(v1[0], v1[1]); w.w = cvt_pk_bf16(v1[2], v1[3]);
                    *(u32x4*)(rowp + bj * HALF) = w; } }
    }
};
template <bool RES> struct EpiF32 {
    static constexpr bool PERM = false, AFTER_DRAIN = false;
    const float* base; float* C; int ldc;
    __device__ __forceinline__ void operator()(const f32x4 (&acc)[2][2][4][2], const Unit& u, int wr, int wc, int fr, int fq) const {
        const int row0 = u.pm * BM + wr * 64 + fr, col0 = u.pn * BM + wc * 32 + 4 * fq;
#pragma unroll
        for (int ai = 0; ai < 2; ++ai)
#pragma unroll
            for (int m = 0; m < 4; ++m) { const size_t off = (size_t)(row0 + ai * HALF + m * 16) * ldc + col0;
#pragma unroll
                for (int bj = 0; bj < 2; ++bj)
#pragma unroll
                    for (int n = 0; n < 2; ++n) { const size_t o = off + bj * HALF + n * 16; f32x4 v = acc[ai][bj][m][n];
                        if (RES) v = v + *(const f32x4*)(base + o);
                        *(f32x4*)(C + o) = v; } }
    }
};
struct EpiX1 {
    static constexpr bool PERM = false, AFTER_DRAIN = false;
    const float* base; bf16_t* X1; int ldc;
    __device__ __forceinline__ void init(f32x4 (&acc)[2][2][4][2], const Unit& u, int wr, int wc, int fr, int fq) const {
        const int row0 = u.pm * BM + wr * 64 + fr, col0 = u.pn * BM + wc * 32 + 4 * fq;
#pragma unroll
        for (int ai = 0; ai < 2; ++ai)
#pragma unroll
            for (int m = 0; m < 4; ++m) { const size_t off = (size_t)(row0 + ai * HALF + m * 16) * ldc + col0;
#pragma unroll
                for (int bj = 0; bj < 2; ++bj)
#pragma unroll
                    for (int n = 0; n < 2; ++n) acc[ai][bj][m][n] = *(const f32x4*)(base + off + bj * HALF + n * 16); }
    }
    __device__ __forceinline__ void operator()(const f32x4 (&acc)[2][2][4][2], const Unit& u, int wr, int wc, int fr, int fq) const {
        const int row0 = u.pm * BM + wr * 64 + fr, col0 = u.pn * BM + wc * 32 + 4 * fq;
        typedef __bf16 bf2 __attribute__((ext_vector_type(2)));
        typedef unsigned u2 __attribute__((ext_vector_type(2)));
#pragma unroll
        for (int ai = 0; ai < 2; ++ai)
#pragma unroll
            for (int m = 0; m < 4; ++m) { const size_t off = (size_t)(row0 + ai * HALF + m * 16) * ldc + col0;
#pragma unroll
                for (int bj = 0; bj < 2; ++bj)
#pragma unroll
                    for (int n = 0; n < 2; ++n) { const f32x4 v = acc[ai][bj][m][n]; const f32x2 lo = {v[0], v[1]}, hi = {v[2], v[3]};
                        u2 pk; pk.x = __builtin_bit_cast(unsigned, __builtin_convertvector(lo, bf2)); pk.y = __builtin_bit_cast(unsigned, __builtin_convertvector(hi, bf2));
                        *(u2*)(X1 + off + bj * HALF + n * 16) = pk; } }
    }
};
template <class Epi, class Sched, bool ALIGN_EPI = false, bool SP2 = false, bool PRE = false>
__device__ __forceinline__ void gemm_phase_acc(PG8_LAS unsigned char* lds, const Gemm g, const Sched& S, const Epi& E, f32x4 (&acc)[2][2][4][2]) {
    const int tid = threadIdx.x, wid = __builtin_amdgcn_readfirstlane(tid >> 6), lane = tid & 63, wr = wid >> 2, wc = wid & 3, fr = lane & 15, fq = lane >> 4;
    const int K = g.K, nt = K / BK;
    unsigned voffA[2], voffB[2];
#pragma unroll
    for (int i = 0; i < 2; ++i) { int R, C; stage_rc(tid * 16 + i * 8192, R, C); const int Rb = Epi::PERM ? ((R & ~31) + perm32(R & 31)) : R;
        voffA[i] = (unsigned)(R * K + C) * 2u; voffB[i] = (unsigned)(Rb * K + C) * 2u; }
    const size_t kstep = (size_t)(BK * 2);
    const size_t hstep = (size_t)HALF * K * 2;
    const size_t tstep = 2 * hstep;
    const unsigned ldsw = (unsigned)wid * 1024u;
    const int aoff = lds_byte(wr * 64 + fr, fq * 8), boff = lds_byte(wc * 32 + fr, fq * 8);
#define PG8_SA(b, h) (((b) * 2 + (h)) * HTB)
#define PG8_SB(b, h) ((4 + (b) * 2 + (h)) * HTB)
#define PG8_STAGE(bufoff, gbase, voff) do { _Pragma("unroll") for (int _i = 0; _i < 2; ++_i) \
        __builtin_amdgcn_global_load_lds((const unsigned*)((const char*)(gbase) + (voff)[_i]), (PG8_LAS unsigned*)(lds + (bufoff) + ldsw + _i * 8192), 16, 0, 0); } while (0)
#define PG8_LDA(dst, b, h) do { _Pragma("unroll") for (int m = 0; m < 4; ++m) _Pragma("unroll") for (int k = 0; k < 2; ++k) dst[m][k] = *(const PG8_LAS bf16x8*)(lds + PG8_SA(b, h) + aoff + m * 2048 + k * 1024); } while (0)
#define PG8_LDB(dst, b, h) do { _Pragma("unroll") for (int n = 0; n < 2; ++n) _Pragma("unroll") for (int k = 0; k < 2; ++k) dst[n][k] = *(const PG8_LAS bf16x8*)(lds + PG8_SB(b, h) + boff + n * 2048 + k * 1024); } while (0)
#define PG8_MMA(ai, bj, At, Bt) do { __builtin_amdgcn_s_setprio(1); _Pragma("unroll") for (int m = 0; m < 4; ++m) _Pragma("unroll") for (int n = 0; n < 2; ++n) _Pragma("unroll") for (int k = 0; k < 2; ++k) \
        acc[ai][bj][m][n] = __builtin_amdgcn_mfma_f32_16x16x32_bf16(Bt[n][k], At[m][k], acc[ai][bj][m][n], 0, 0, 0); __builtin_amdgcn_s_setprio(0); } while (0)
#define PG8_WAIT_V(n) asm volatile("s_waitcnt vmcnt(" #n ")" ::: "memory")
#define PG8_WAIT_L(n) asm volatile("s_waitcnt lgkmcnt(" #n ")" ::: "memory")
#define PG8_BAR __builtin_amdgcn_s_barrier()
#define PG8_SCHED __builtin_amdgcn_sched_barrier(0)
    Unit cur, nxt; int ui = 0;
    if (!S.next(0, cur)) return;
    if constexpr (!PRE) {
#pragma unroll
    for (int a = 0; a < 2; ++a)
#pragma unroll
        for (int b = 0; b < 2; ++b)
#pragma unroll
            for (int m = 0; m < 4; ++m)
#pragma unroll
                for (int n = 0; n < 2; ++n) acc[a][b][m][n] = (f32x4){0.f, 0.f, 0.f, 0.f};
    }
    bf16x8 At[4][2], B0[2][2], B1[2][2];
    const char* cA = (const char*)g.A + (size_t)cur.pm * tstep; const char* cB = (const char*)g.Bt + (size_t)cur.pn * tstep;
    S.a_ready(cur);
    if constexpr (SP2) {
        PG8_STAGE(PG8_SB(0, 0), cB, voffB); PG8_STAGE(PG8_SB(0, 1), cB + hstep, voffB); PG8_STAGE(PG8_SA(0, 0), cA, voffA); PG8_STAGE(PG8_SA(0, 1), cA + hstep, voffA);
        if (wr == 1) PG8_BAR;
        PG8_WAIT_V(2); PG8_BAR;
        PG8_STAGE(PG8_SB(1, 0), cB + kstep, voffB); PG8_STAGE(PG8_SA(1, 0), cA + kstep, voffA); PG8_STAGE(PG8_SB(1, 1), cB + hstep + kstep, voffB);
        PG8_WAIT_V(6); PG8_BAR;
    } else {
        PG8_STAGE(PG8_SB(0, 0), cB, voffB); PG8_STAGE(PG8_SA(0, 0), cA, voffA); PG8_STAGE(PG8_SB(0, 1), cB + hstep, voffB); PG8_STAGE(PG8_SA(0, 1), cA + hstep, voffA);
        if (wr == 1) PG8_BAR;
        PG8_WAIT_V(4); PG8_BAR;
        PG8_STAGE(PG8_SB(1, 0), cB + kstep, voffB); PG8_STAGE(PG8_SA(1, 0), cA + kstep, voffA); PG8_STAGE(PG8_SB(1, 1), cB + hstep + kstep, voffB);
        PG8_WAIT_V(6); PG8_BAR;
    }
    for (;;) {
        const bool has_next = S.next(ui + 1, nxt);
        const char* nA = has_next ? (const char*)g.A + (size_t)nxt.pm * tstep : cA; const char* nB = has_next ? (const char*)g.Bt + (size_t)nxt.pn * tstep : cB;
        for (int t = 0; t < nt; t += 2) {
            const bool last = (t == nt - 2);
            const char* a1 = cA + (size_t)(t + 1) * kstep;
            const char* a2 = last ? nA : cA + (size_t)(t + 2) * kstep; const char* b2 = last ? nB : cB + (size_t)(t + 2) * kstep;
            const char* a3 = a2 + kstep; const char* b3 = b2 + kstep;
            if (last && has_next) S.a_ready(nxt);
            if constexpr (SP2) {
            PG8_LDB(B0, 0, 0); PG8_LDB(B1, 0, 1); PG8_SCHED; PG8_LDA(At, 0, 0); PG8_STAGE(PG8_SA(1, 1), a1 + hstep, voffA);
            PG8_WAIT_V(8); PG8_WAIT_L(0); PG8_BAR; PG8_MMA(0, 0, At, B0); PG8_MMA(0, 1, At, B1); PG8_BAR; PG8_SCHED;
            PG8_LDA(At, 0, 1); PG8_STAGE(PG8_SB(0, 0), b2, voffB); PG8_STAGE(PG8_SB(0, 1), b2 + hstep, voffB); PG8_STAGE(PG8_SA(0, 0), a2, voffA);
            PG8_WAIT_V(8); PG8_WAIT_L(0); PG8_BAR; PG8_MMA(1, 0, At, B0); PG8_MMA(1, 1, At, B1); PG8_BAR; PG8_SCHED;
            PG8_LDB(B0, 1, 0); PG8_LDB(B1, 1, 1); PG8_SCHED; PG8_LDA(At, 1, 0); PG8_STAGE(PG8_SA(0, 1), a2 + hstep, voffA);
            PG8_WAIT_V(8); PG8_WAIT_L(0); PG8_BAR; PG8_MMA(0, 0, At, B0); PG8_MMA(0, 1, At, B1); PG8_BAR; PG8_SCHED;
            PG8_LDA(At, 1, 1); PG8_STAGE(PG8_SB(1, 0), b3, voffB); PG8_STAGE(PG8_SB(1, 1), b3 + hstep, voffB); PG8_STAGE(PG8_SA(1, 0), a3, voffA);
            PG8_WAIT_V(8); PG8_WAIT_L(0); PG8_BAR; PG8_MMA(1, 0, At, B0); PG8_MMA(1, 1, At, B1); PG8_BAR; PG8_SCHED;
            } else {
            PG8_LDB(B0, 0, 0); PG8_SCHED; PG8_LDA(At, 0, 0); PG8_STAGE(PG8_SA(1, 1), a1 + hstep, voffA);
            PG8_WAIT_L(8); PG8_BAR; PG8_WAIT_L(0); PG8_MMA(0, 0, At, B0); PG8_BAR; PG8_SCHED;
            PG8_LDB(B1, 0, 1); PG8_STAGE(PG8_SB(0, 0), b2, voffB);
            PG8_BAR; PG8_WAIT_L(0); PG8_MMA(0, 1, At, B1); PG8_BAR;
            PG8_LDA(At, 0, 1); PG8_STAGE(PG8_SA(0, 0), a2, voffA);
            PG8_BAR; PG8_WAIT_L(0); PG8_MMA(1, 0, At, B0); PG8_BAR; PG8_SCHED;
            PG8_STAGE(PG8_SB(0, 1), b2 + hstep, voffB);
            PG8_WAIT_V(6); PG8_BAR; PG8_MMA(1, 1, At, B1); PG8_BAR;
            PG8_LDB(B0, 1, 0); PG8_SCHED; PG8_LDA(At, 1, 0); PG8_STAGE(PG8_SA(0, 1), a2 + hstep, voffA);
            PG8_WAIT_L(8); PG8_BAR; PG8_WAIT_L(0); PG8_MMA(0, 0, At, B0); PG8_BAR; PG8_SCHED;
            PG8_LDB(B1, 1, 1); PG8_STAGE(PG8_SB(1, 0), b3, voffB);
            PG8_BAR; PG8_WAIT_L(0); PG8_MMA(0, 1, At, B1); PG8_BAR;
            PG8_LDA(At, 1, 1); PG8_STAGE(PG8_SA(1, 0), a3, voffA);
            PG8_BAR; PG8_WAIT_L(0); PG8_MMA(1, 0, At, B0); PG8_BAR; PG8_SCHED;
            PG8_STAGE(PG8_SB(1, 1), b3 + hstep, voffB);
            PG8_WAIT_V(6); PG8_BAR; PG8_MMA(1, 1, At, B1); PG8_BAR;
            }
        }
        if constexpr (ALIGN_EPI) { if (wr == 0) PG8_BAR; }
        if constexpr (!Epi::AFTER_DRAIN) { E(acc, cur, wr, wc, fr, fq); S.done(cur); }
        if (!has_next) break;
        if constexpr (PRE) E.init(acc, nxt, wr, wc, fr, fq);
        else {
#pragma unroll
        for (int a = 0; a < 2; ++a)
#pragma unroll
            for (int b = 0; b < 2; ++b)
#pragma unroll
                for (int m = 0; m < 4; ++m)
#pragma unroll
                    for (int n = 0; n < 2; ++n) acc[a][b][m][n] = (f32x4){0.f, 0.f, 0.f, 0.f};
        }
        cur = nxt; cA = nA; cB = nB; ++ui;
        if constexpr (ALIGN_EPI) { if (wr == 1) PG8_BAR; }
    }
    PG8_WAIT_V(0);
    if constexpr (!ALIGN_EPI) { if (wr == 0) PG8_BAR; }
    PG8_BAR;
    if constexpr (Epi::AFTER_DRAIN) { E.fused(acc, cur, wr, wc, fr, fq, lds, wid, lane); S.done(cur); }
#undef PG8_SA
#undef PG8_SB
#undef PG8_STAGE
#undef PG8_LDA
#undef PG8_LDB
#undef PG8_MMA
#undef PG8_WAIT_V
#undef PG8_WAIT_L
#undef PG8_BAR
#undef PG8_SCHED
}
template <class Epi, class Sched, bool ALIGN_EPI = false, bool SP2 = false>
__device__ __forceinline__ void gemm_phase(PG8_LAS unsigned char* lds, const Gemm g, const Sched& S, const Epi& E) { f32x4 acc[2][2][4][2]; gemm_phase_acc<Epi, Sched, ALIGN_EPI, SP2, false>(lds, g, S, E, acc); }
}
#ifndef REP_P5
#define REP_P5 1
#endif
#ifndef REP_P0
#define REP_P0 1
#endif
#ifndef REP_P1
#define REP_P1 1
#endif
#ifndef REP_P4
#define REP_P4 1
#endif
#ifndef REP_P0B
#define REP_P0B 1
#endif
#ifndef REP_P0C
#define REP_P0C 1
#endif
#ifndef REP_P2
#define REP_P2 1
#endif
constexpr int T = 8192, D = 2048, NIN = 3328, SEQ = 2048, NE = 16384;
constexpr float EPS = 1e-6f;
constexpr int NWAVES = 8, NTHR = 512;
constexpr size_t MiB = 1u << 20;
constexpr size_t WS_CTL = 0, CTL_ZERO_BYTES = 1 * MiB;
constexpr size_t WS_WIN = 2 * MiB;
constexpr size_t WS_WOUT = 16 * MiB;
constexpr size_t WS_WEFF = 24 * MiB;
constexpr size_t WS_H = 32 * MiB;
constexpr size_t WS_Z = 64 * MiB;
constexpr size_t WS_MIX = 116 * MiB;
constexpr size_t WS_X1 = 148 * MiB;
constexpr size_t WS_SC = 212 * MiB;
constexpr size_t WS_ED = 284 * MiB;
constexpr size_t WS_EU = 316 * MiB;
constexpr int ROWB = 1536;
constexpr size_t WS_SD = 348 * MiB;
constexpr size_t WS_SU = 348 * MiB + 65536;
constexpr size_t WS_TP = 348 * MiB + 196608;
constexpr size_t WS_END = 349 * MiB;
constexpr int CW_TMO = 0, CW_BAR = 4096;
constexpr int RING_OFF = 0, RING_BYTES = 131072;
constexpr int LDSCTL_OFF = RING_BYTES, MISC_OFF = LDSCTL_OFF + 320;
constexpr int LDS_BYTES = 163840;

#define GAS __attribute__((address_space(1)))
#define LAS __attribute__((address_space(3)))
typedef unsigned short bf16;
typedef unsigned v4u __attribute__((ext_vector_type(4)));
typedef unsigned v2u __attribute__((ext_vector_type(2)));
typedef float f32x4 __attribute__((ext_vector_type(4)));
typedef GAS unsigned gu32;
#define LDS_WAIT() asm volatile("s_waitcnt lgkmcnt(0)" ::: "memory")
#define VM_WAIT() asm volatile("s_waitcnt vmcnt(0)" ::: "memory")
__device__ __forceinline__ unsigned f2bf(float f) { unsigned u = __builtin_bit_cast(unsigned, f); return (u + 0x7fffu + ((u >> 16) & 1u)) >> 16; }
__device__ __forceinline__ unsigned pk2(float lo, float hi) { return f2bf(lo) | (f2bf(hi) << 16); }
__device__ __forceinline__ float bf2f(bf16 h) { return __uint_as_float(((unsigned)h) << 16); }
__device__ __forceinline__ float bflo(unsigned w) { return __uint_as_float(w << 16); }
__device__ __forceinline__ float bfhi(unsigned w) { return __uint_as_float(w & 0xffff0000u); }
__device__ __forceinline__ float gelu_erf(float v) { return 0.5f * v * (1.0f + erff(v * 0.70710678118654752f)); }
__device__ __forceinline__ float wave_sum(float v) {
#pragma unroll
    for (int o = 1; o < 64; o <<= 1) v += __shfl_xor(v, o);
    return v;
}

#define XB_TMO      128
#define XB_XCNT(j)  (256  + 64 * (j))
#define XB_XSUB(j)  (1280 + 64 * (j))
#define XB_XGEN(j)  (2304 + 64 * (j))
#define XB_TOP      3328
#define XB_TOPGEN   3392
#define XCD_BAR_WORDS 3456
#define XB_SPIN_CAP (1u << 18)

__device__ __forceinline__ unsigned xb_ld(unsigned* p)              { return __hip_atomic_load(p, __ATOMIC_RELAXED, __HIP_MEMORY_SCOPE_AGENT); }
__device__ __forceinline__ unsigned xb_add(unsigned* p, unsigned v) { return __hip_atomic_fetch_add(p, v, __ATOMIC_RELAXED, __HIP_MEMORY_SCOPE_AGENT); }
__device__ __forceinline__ unsigned xb_xcc_id() { return (unsigned)__builtin_amdgcn_s_getreg((3 << 11) | 20) & 0xFu; }
#define XB_SPIN(cond, bar) do { unsigned _sp = 0; while (cond) { __builtin_amdgcn_s_sleep(1); \
    if ((++_sp & 255u) == 0u) { if (xb_ld(&(bar)[XB_TMO])) break; if (_sp > XB_SPIN_CAP) { atomicAdd(&(bar)[XB_TMO], 1u); break; } } } } while (0)

struct XcdBarrier {
    unsigned* bar; unsigned x;
    volatile LAS unsigned* st;
};

__device__ __forceinline__ XcdBarrier xcd_barrier_post(unsigned* bar, volatile LAS unsigned* st) {
    XcdBarrier b; b.bar = bar; b.x = xb_xcc_id(); b.st = st;
    if (threadIdx.x == 0) (void)xb_add(&bar[XB_XCNT(b.x)], 1u);
    return b;
}
__device__ __forceinline__ void xcd_barrier_complete(unsigned* bar, unsigned x, unsigned& nloc, unsigned& nx) {
    const unsigned G = gridDim.x * gridDim.y * gridDim.z;
    unsigned sum, cnt, mine, sp = 0u;
    for (;;) {
        sum = 0u; cnt = 0u; mine = 0u;
#pragma unroll
        for (unsigned j = 0; j < 16; ++j) { const unsigned c = xb_ld(&bar[XB_XCNT(j)]); sum += c; cnt += (c > 0u) ? 1u : 0u; mine = (j == x) ? c : mine; }
        if (sum == G) break;
        __builtin_amdgcn_s_sleep(1);
        if ((++sp & 255u) == 0u) { if (xb_ld(&bar[XB_TMO])) break; if (sp > XB_SPIN_CAP) { atomicAdd(&bar[XB_TMO], 1u); break; } }
    }
    nloc = mine > 0u ? mine : 1u; nx = cnt > 0u ? cnt : 1u;
}

__device__ __forceinline__ void xcd_barrier_t0(const XcdBarrier& b) {
    {
        unsigned* bar = b.bar;
        __builtin_amdgcn_s_waitcnt(0);
        unsigned nloc = b.st[0], nx = b.st[1];
        if (nloc == 0u) { xcd_barrier_complete(bar, b.x, nloc, nx); b.st[0] = nloc; b.st[1] = nx; }
        const unsigned old = xb_add(&bar[XB_XSUB(b.x)], 1u);
        const unsigned gen = old / nloc;
        if (old + 1u == (gen + 1u) * nloc) {
            __builtin_amdgcn_fence(__ATOMIC_RELEASE, "agent");
            asm volatile("s_waitcnt vmcnt(0)" ::: "memory");
            const unsigned og = xb_add(&bar[XB_TOP], 1u);
            const unsigned tg = og / nx;
            if (og + 1u == (tg + 1u) * nx) xb_add(&bar[XB_TOPGEN], 1u);
            else XB_SPIN(xb_ld(&bar[XB_TOPGEN]) == tg, bar);
            __builtin_amdgcn_fence(__ATOMIC_ACQUIRE, "agent");
            xb_add(&bar[XB_XGEN(b.x)], 1u);
            asm volatile("s_waitcnt vmcnt(0)" ::: "memory");
        } else {
            XB_SPIN(xb_ld(&bar[XB_XGEN(b.x)]) == gen, bar);
            __builtin_amdgcn_fence(__ATOMIC_ACQUIRE, "agent");
            asm volatile("s_waitcnt vmcnt(0)" ::: "memory");
        }
    }
}
__device__ __forceinline__ void xcd_barrier(const XcdBarrier& b) {
    asm volatile("s_waitcnt vmcnt(0)" ::: "memory");
    __syncthreads();
    if (threadIdx.x == 0) xcd_barrier_t0(b);
    __syncthreads();
}
template <class Pre> __device__ __forceinline__ void xcd_barrier_pre(const XcdBarrier& b, const Pre& pre) {
    asm volatile("s_waitcnt vmcnt(0)" ::: "memory");
    __syncthreads();
    const int w_ = __builtin_amdgcn_readfirstlane((int)threadIdx.x >> 6);
    if (w_ != 0) pre();
    if (threadIdx.x == 0) xcd_barrier_t0(b);
    __syncthreads();
    if (w_ == 0) pre();
}

struct Ctx { LAS unsigned char* lds; int tid, lane, wave, G, bid; };

__device__ __forceinline__ void p0_transpose_item(const float* W, int K, int N, bf16* WT, LAS float* scr, int item, int lane) {
    const int nblk = N / 32, kb = item / nblk, nb = item % nblk, k0 = 64 * kb, n0 = 32 * nb;
    float wv[32];
#pragma unroll
    for (int i = 0; i < 32; ++i) wv[i] = W[(size_t)(k0 + 2 * i + (lane >> 5)) * N + n0 + (lane & 31)];
#pragma unroll
    for (int i = 0; i < 32; ++i) scr[(2 * i + (lane >> 5)) * 33 + (lane & 31)] = wv[i];
    LDS_WAIT(); asm volatile("" ::: "memory");
    const int c = lane & 7;
#pragma unroll
    for (int j = 0; j < 4; ++j) { const int n = (lane >> 3) + 8 * j; const LAS float* s = scr + (8 * c) * 33 + n;
        v4u o; o.x = pk2(s[0 * 33], s[1 * 33]); o.y = pk2(s[2 * 33], s[3 * 33]); o.z = pk2(s[4 * 33], s[5 * 33]); o.w = pk2(s[6 * 33], s[7 * 33]);
        *(v4u*)(WT + (size_t)(n0 + n) * K + k0 + 8 * c) = o; }
    LDS_WAIT(); asm volatile("" ::: "memory");
}
__device__ __forceinline__ void rms_row_to_bf16(const float* xr, const float* g, bf16* orow, int lane) {
    f32x4 v[8]; float s = 0.f;
#pragma unroll
    for (int j = 0; j < 8; ++j) { v[j] = *(const f32x4*)(xr + j * 256 + lane * 4); s += (v[j].x * v[j].x + v[j].y * v[j].y) + (v[j].z * v[j].z + v[j].w * v[j].w); }
    const float r = rsqrtf(wave_sum(s) * (1.f / D) + EPS);
#pragma unroll
    for (int j = 0; j < 8; ++j) { const f32x4 gg = *(const f32x4*)(g + j * 256 + lane * 4);
        v2u o; o.x = pk2(v[j].x * r * gg.x, v[j].y * r * gg.y); o.y = pk2(v[j].z * r * gg.z, v[j].w * r * gg.w);
        *(v2u*)(orow + j * 256 + lane * 4) = o; }
}
typedef float f32x2 __attribute__((ext_vector_type(2)));
typedef __bf16 bf16x2v __attribute__((ext_vector_type(2)));
__device__ __forceinline__ unsigned cvtpk(float lo, float hi) { const f32x2 v = {lo, hi}; return __builtin_bit_cast(unsigned, __builtin_convertvector(v, bf16x2v)); }
typedef short bf16x8 __attribute__((ext_vector_type(8)));
typedef float f32x16 __attribute__((ext_vector_type(16)));
__device__ __forceinline__ bf16x8 pack8(float a0, float a1, float a2, float a3, float a4, float a5, float a6, float a7) {
    v4u w; w.x = cvtpk(a0, a1); w.y = cvtpk(a2, a3); w.z = cvtpk(a4, a5); w.w = cvtpk(a6, a7); return __builtin_bit_cast(bf16x8, w); }
__device__ __forceinline__ void split8(const f32x4 a0, const f32x4 a1, bf16x8& hi, bf16x8& lo) {
    hi = pack8(a0[0], a0[1], a0[2], a0[3], a1[0], a1[1], a1[2], a1[3]);
    const v4u w = __builtin_bit_cast(v4u, hi);
    lo = pack8(a0[0] - bflo(w[0]), a0[1] - bfhi(w[0]), a0[2] - bflo(w[1]), a0[3] - bfhi(w[1]), a1[0] - bflo(w[2]), a1[1] - bfhi(w[2]), a1[2] - bflo(w[3]), a1[3] - bfhi(w[3]));
}
typedef __bf16 bf16x32 __attribute__((ext_vector_type(32)));
typedef unsigned v6u __attribute__((ext_vector_type(6)));
typedef float f32x32 __attribute__((ext_vector_type(32)));
__device__ __forceinline__ void p0_rows_to_fp6(const float* ra, const float* rb, unsigned char* da, unsigned char* db, float* ia, float* ib, int lane) {
    f32x4 va[8], vb[8]; float ma = 0.f, mb = 0.f;
#pragma unroll
    for (int i = 0; i < 8; ++i) { va[i] = __builtin_nontemporal_load((const f32x4*)(ra + i * 256 + lane * 4)); vb[i] = __builtin_nontemporal_load((const f32x4*)(rb + i * 256 + lane * 4)); }
#pragma unroll
    for (int i = 0; i < 8; ++i) { const f32x4 t = va[i], u = vb[i];
        ma = fmaxf(fmaxf(ma, fmaxf(fabsf(t.x), fabsf(t.y))), fmaxf(fabsf(t.z), fabsf(t.w))); mb = fmaxf(fmaxf(mb, fmaxf(fabsf(u.x), fabsf(u.y))), fmaxf(fabsf(u.z), fabsf(u.w))); }
#pragma unroll
    for (int o = 1; o < 64; o <<= 1) { ma = fmaxf(ma, __shfl_xor(ma, o)); mb = fmaxf(mb, __shfl_xor(mb, o)); }
    const float sa = ma > 0.f ? 7.f / ma : 0.f, sb = mb > 0.f ? 7.f / mb : 0.f;
    bf16x32 xa, xb;
#pragma unroll
    for (int k = 0; k < 32; ++k) { xa[k] = (__bf16)(va[k >> 2][k & 3] * sa); xb[k] = (__bf16)(vb[k >> 2][k & 3] * sb); }
    const v6u pa = __builtin_amdgcn_cvt_scalef32_pk32_fp6_bf16(xa, 1.0f), pb = __builtin_amdgcn_cvt_scalef32_pk32_fp6_bf16(xb, 1.0f);
#pragma unroll
    for (int q = 0; q < 3; ++q) { *(v2u*)(da + 24 * lane + 8 * q) = (v2u){pa[2 * q], pa[2 * q + 1]}; *(v2u*)(db + 24 * lane + 8 * q) = (v2u){pb[2 * q], pb[2 * q + 1]}; }
    if (lane == 0) { *ia = ma * (1.f / 7.f); *ib = mb * (1.f / 7.f); }
}
constexpr int CONV_SPLIT = 12800;
__device__ __forceinline__ void convert_rows(const float* e_down, const float* e_up, unsigned char* ED, unsigned char* EU, float* SD, float* SU, int r_lo, int r_hi, int w, int nw, int lane) {
    for (int r = r_lo + 2 * w; r < r_hi; r += 2 * nw) {
        const bool up = r >= NE; const int row = up ? r - NE : r;
        const float* s = (up ? e_up : e_down) + (size_t)row * D; unsigned char* d = (up ? EU : ED) + (size_t)row * ROWB; float* iv = (up ? SU : SD) + row;
        p0_rows_to_fp6(s, s + D, d, d + ROWB, iv, iv + 1, lane);
    }
}
__device__ __forceinline__ void p0_prologue(const Ctx& F, const float* x, const float* g1, const float* w_in, const float* w_out, const float* wq, const float* sk,
                                            const float* e_down, const float* e_up, bf16* WinT, bf16* WoutT, bf16* WeffT, bf16* H, unsigned char* ED, unsigned char* EU, float* SD, float* SU, const float* g2) {
    const int gw = F.bid * NWAVES + F.wave, NGW = F.G * NWAVES;
#if defined(TP_PHASE) && TP_PHASE == 12
    volatile unsigned long long* tsp12 = (volatile unsigned long long*)((unsigned char*)SD + 196608);
    if (F.bid == 0 && F.tid == 0) tsp12[0] = wall_clock64();
#endif
    for (int ph = 0; ph < 2; ++ph) {
    if ((ph == 0) == (((F.bid >> 3) & 1) == 0)) {
    {
        LAS float* scr = (LAS float*)(F.lds + RING_OFF + F.wave * 16384);
        constexpr int I_IN = (D / 64) * (NIN / 32), I_OUT = (D / 64) * (D / 32);
        for (int it = gw; it < I_IN + I_OUT; it += NGW) {
            if (it < I_IN) p0_transpose_item(w_in, D, NIN, WinT, scr, it, F.lane);
            else p0_transpose_item(w_out, D, D, WoutT, scr, it - I_IN, F.lane);
        }
    }
    __syncthreads();
    for (int it = gw; it < 16 * 64 * 2; it += NGW) {
        const int g = it & 15, dtile = (it >> 4) & 63, kh = it >> 10, p = g & 1, c = F.lane & 31, h = F.lane >> 5;
        const float* arow = wq + (size_t)(dtile * 32 + c) * 2048 + g * 128 + 8 * h;
        bf16x8 ah[8], al[8];
#pragma unroll
        for (int ks = 0; ks < 8; ++ks) { const f32x4 a0 = *(const f32x4*)(arow + 16 * ks), a1 = *(const f32x4*)(arow + 16 * ks + 4); split8(a0, a1, ah[ks], al[ks]); }
#pragma unroll 1
        for (int kt = 0; kt < 2; ++kt) {
            const int k0 = (kh * 2 + kt) * 32;
            const float* brow = sk + (size_t)(p * 128 + k0 + c) * 128 + 8 * h;
            f32x16 acc;
#pragma unroll
            for (int i = 0; i < 16; ++i) acc[i] = 0.f;
#pragma unroll
            for (int ks = 0; ks < 8; ++ks) { const f32x4 b0 = *(const f32x4*)(brow + 16 * ks), b1 = *(const f32x4*)(brow + 16 * ks + 4); bf16x8 bh, bl; split8(b0, b1, bh, bl);
                acc = __builtin_amdgcn_mfma_f32_32x32x16_bf16(al[ks], bh, acc, 0, 0, 0); acc = __builtin_amdgcn_mfma_f32_32x32x16_bf16(ah[ks], bl, acc, 0, 0, 0);
                acc = __builtin_amdgcn_mfma_f32_32x32x16_bf16(ah[ks], bh, acc, 0, 0, 0); }
            bf16* orow = WeffT + (size_t)(g * 128 + k0 + c) * 2048 + dtile * 32 + 4 * h;
#pragma unroll
            for (int q = 0; q < 4; ++q) { const f32x4 gq = *(const f32x4*)(g2 + dtile * 32 + 4 * h + 8 * q);
                v2u o; o.x = cvtpk(acc[4 * q] * gq[0], acc[4 * q + 1] * gq[1]); o.y = cvtpk(acc[4 * q + 2] * gq[2], acc[4 * q + 3] * gq[3]); *(v2u*)(orow + 8 * q) = o; }
        }
    }
#if defined(TP_PHASE) && TP_PHASE == 12
    __syncthreads(); if (F.bid == 0 && F.tid == 0) tsp12[1] = wall_clock64() - tsp12[0];
#endif
    } else {
    for (int rep_ = 0; rep_ < REP_P0C; ++rep_) convert_rows(e_down, e_up, ED, EU, SD, SU, 0, CONV_SPLIT, gw, NGW, F.lane);
    for (int m = gw; m < T; m += NGW) rms_row_to_bf16(x + (size_t)m * D, g1, H + (size_t)m * D, F.lane);
    }
    }
}

constexpr int SGU_VS = 136;
__device__ __forceinline__ void p2_sgu(const Ctx& F, const bf16* Z, const float* ln_g, const float* ln_b, const float* w_s, const float* b_s, bf16* MIX) {
    LAS bf16* vnT = (LAS bf16*)(F.lds + RING_OFF);
    LAS float* ps = (LAS float*)(F.lds + RING_OFF + 128 * SGU_VS * 2);
    LAS float* pq = ps + 512;
    const int s = F.tid & 127, dq = F.tid >> 7;
    const int c = F.lane & 31, h = F.lane >> 5, tt = F.wave >> 1;
    for (int unit = F.bid; unit < 512; unit += F.G) {
        const int g = unit & 7, t0 = (unit >> 3) * 128;
        __syncthreads();
        float v[32];
        { const bf16* vr = Z + (size_t)(t0 + s) * NIN + 1024 + g * 128 + dq * 32;
#pragma unroll
          for (int j = 0; j < 4; ++j) { const v4u q = *(const v4u*)(vr + 8 * j);
#pragma unroll
              for (int e = 0; e < 4; ++e) { v[8 * j + 2 * e] = bflo(q[e]); v[8 * j + 2 * e + 1] = bfhi(q[e]); } } }
        float sm = 0.f;
#pragma unroll
        for (int j = 0; j < 32; ++j) sm += v[j];
        ps[dq * 128 + s] = sm;
        __syncthreads();
        const float mean = (ps[s] + ps[128 + s] + ps[256 + s] + ps[384 + s]) * (1.f / 128.f);
        float sq = 0.f;
#pragma unroll
        for (int j = 0; j < 32; ++j) { v[j] -= mean; sq += v[j] * v[j]; }
        pq[dq * 128 + s] = sq;
        __syncthreads();
        const float rstd = rsqrtf((pq[s] + pq[128 + s] + pq[256 + s] + pq[384 + s]) * (1.f / 128.f) + EPS);
#pragma unroll
        for (int j = 0; j < 32; ++j) { const int d = dq * 32 + j; vnT[d * SGU_VS + s] = (bf16)f2bf(v[j] * rstd * ln_g[g * 128 + d] + ln_b[g * 128 + d]); }
        __syncthreads();
        f32x16 acc[2];
#pragma unroll
        for (int a = 0; a < 2; ++a)
#pragma unroll
            for (int i = 0; i < 16; ++i) acc[a][i] = 0.f;
        const int trow = 32 * tt + c;
        const float* wrow = w_s + ((size_t)g * 128 + trow) * 128;
        const int dt0 = 2 * (F.wave & 1);
        for (int ks = 0; ks < 2 * (tt + 1); ++ks) {
            const int s0 = 16 * ks + 8 * h;
            const f32x4 w0 = *(const f32x4*)(wrow + s0), w1 = *(const f32x4*)(wrow + s0 + 4);
            float w[8] = {w0[0], w0[1], w0[2], w0[3], w1[0], w1[1], w1[2], w1[3]};
#pragma unroll
            for (int j = 0; j < 8; ++j) w[j] = (s0 + j <= trow) ? w[j] : 0.f;
            const bf16x8 bf = pack8(w[0], w[1], w[2], w[3], w[4], w[5], w[6], w[7]);
#pragma unroll
            for (int a = 0; a < 2; ++a) { const bf16x8 af = *(const LAS bf16x8*)(vnT + (32 * (dt0 + a) + c) * SGU_VS + s0);
                acc[a] = __builtin_amdgcn_mfma_f32_32x32x16_bf16(af, bf, acc[a], 0, 0, 0); }
        }
        const float bias = b_s[g * 128 + trow];
        const size_t tok = (size_t)(t0 + trow);
#pragma unroll
        for (int a = 0; a < 2; ++a)
#pragma unroll
            for (int q = 0; q < 4; ++q) { const int d0 = 32 * (dt0 + a) + 8 * q + 4 * h;
                const v2u uu = *(const v2u*)(Z + tok * NIN + g * 128 + d0);
                v2u o; o.x = cvtpk(bflo(uu.x) * (acc[a][4 * q] + bias), bfhi(uu.x) * (acc[a][4 * q + 1] + bias));
                o.y = cvtpk(bflo(uu.y) * (acc[a][4 * q + 2] + bias), bfhi(uu.y) * (acc[a][4 * q + 3] + bias));
                *(v2u*)(MIX + tok * D + g * 128 + d0) = o; }
    }
}
constexpr int ATT_KS = 72, ATT_VS = 264;
__device__ __forceinline__ void p2_attn(const Ctx& F, const bf16* Z, const float* sinks, bf16* MIX) {
    LAS bf16* Ks = (LAS bf16*)(F.lds + RING_OFF);
    LAS bf16* Vt = (LAS bf16*)(F.lds + RING_OFF + 256 * ATT_KS * 2);
    const int c = F.lane & 31, h = F.lane >> 5;
    for (int unit = F.bid; unit < 256; unit += F.G) {
        const int hg = unit & 1, hk = (unit >> 1) & 1, n = (unit >> 2) & 15, b = unit >> 6;
        __syncthreads();
        for (int e = F.tid; e < 256 * 8; e += NTHR) {
            const int j = e >> 3, ch = e & 7, pos = (n - 1) * 128 + j;
            v4u kv = (v4u){0u, 0u, 0u, 0u}, vv = (v4u){0u, 0u, 0u, 0u};
            if (pos >= 0) { const bf16* row = Z + ((size_t)b * SEQ + pos) * NIN; kv = *(const v4u*)(row + 3072 + hk * 64 + ch * 8); vv = *(const v4u*)(row + 3200 + hk * 64 + ch * 8); }
            *(LAS v4u*)(Ks + j * ATT_KS + ch * 8) = kv;
#pragma unroll
            for (int jj = 0; jj < 8; ++jj) Vt[(ch * 8 + jj) * ATT_VS + j] = (bf16)((vv[jj >> 1] >> (16 * (jj & 1))) & 0xffffu);
        }
        __syncthreads();
        for (int tk = 0; tk < 2; ++tk) {
            const int hq = hk * 8 + hg * 4 + (F.wave >> 1), i0 = 32 * (2 * (F.wave & 1) + tk);
            const size_t tok = (size_t)b * SEQ + n * 128 + i0 + c;
            const bf16* qrow = Z + tok * NIN + 2048 + hq * 64;
            bf16x8 qf[4];
#pragma unroll
            for (int ks = 0; ks < 4; ++ks) qf[ks] = *(const bf16x8*)(qrow + 16 * ks + 8 * h);
            f32x16 sT[5];
#pragma unroll
            for (int kt = 0; kt < 5; ++kt) {
#pragma unroll
                for (int i = 0; i < 16; ++i) sT[kt][i] = 0.f;
#pragma unroll
                for (int ks = 0; ks < 4; ++ks) { const bf16x8 kf = *(const LAS bf16x8*)(Ks + (i0 + 32 * kt + c) * ATT_KS + 16 * ks + 8 * h);
                    sT[kt] = __builtin_amdgcn_mfma_f32_32x32x16_bf16(kf, qf[ks], sT[kt], 0, 0, 0); }
            }
            const float sink = sinks[hq]; float m = sink;
#pragma unroll
            for (int kt = 0; kt < 5; ++kt) {
                const bool tile_ok = (n > 0) || (i0 + 32 * kt >= 128);
#pragma unroll
                for (int i = 0; i < 16; ++i) { const int jj = (i & 3) + 8 * (i >> 2) + 4 * h;
                    bool ok = tile_ok; if (kt == 0) ok = ok && (jj > c); if (kt == 4) ok = ok && (jj <= c);
                    const float x = ok ? sT[kt][i] * 0.125f : -INFINITY; sT[kt][i] = x; m = fmaxf(m, x); }
            }
            m = fmaxf(m, __shfl_xor(m, 32));
            float l = 0.f;
#pragma unroll
            for (int kt = 0; kt < 5; ++kt)
#pragma unroll
                for (int i = 0; i < 16; ++i) { const float p = __expf(sT[kt][i] - m); sT[kt][i] = p; l += p; }
            l += __shfl_xor(l, 32); l += __expf(sink - m);
            f32x16 o[2];
#pragma unroll
            for (int a = 0; a < 2; ++a)
#pragma unroll
                for (int i = 0; i < 16; ++i) o[a][i] = 0.f;
#pragma unroll
            for (int kt = 0; kt < 5; ++kt)
#pragma unroll
                for (int st = 0; st < 2; ++st) {
                    const bf16x8 pf = pack8(sT[kt][8 * st], sT[kt][8 * st + 1], sT[kt][8 * st + 2], sT[kt][8 * st + 3], sT[kt][8 * st + 4], sT[kt][8 * st + 5], sT[kt][8 * st + 6], sT[kt][8 * st + 7]);
                    const int key0 = i0 + 32 * kt + 16 * st + 4 * h;
#pragma unroll
                    for (int a = 0; a < 2; ++a) { const LAS bf16* vp = Vt + (32 * a + c) * ATT_VS + key0;
                        const v2u lo = *(const LAS v2u*)vp, hi = *(const LAS v2u*)(vp + 8);
                        const v4u vw = (v4u){lo.x, lo.y, hi.x, hi.y};
                        o[a] = __builtin_amdgcn_mfma_f32_32x32x16_bf16(__builtin_bit_cast(bf16x8, vw), pf, o[a], 0, 0, 0); }
                }
            const float inv = 1.f / l;
#pragma unroll
            for (int a = 0; a < 2; ++a)
#pragma unroll
                for (int q = 0; q < 4; ++q) { const int d0 = 32 * a + 8 * q + 4 * h;
                    v2u w; w.x = cvtpk(o[a][4 * q] * inv, o[a][4 * q + 1] * inv); w.y = cvtpk(o[a][4 * q + 2] * inv, o[a][4 * q + 3] * inv);
                    *(v2u*)(MIX + tok * D + 1024 + hq * 64 + d0) = w; }
        }
    }
}

typedef __bf16 bf16x2_t __attribute__((ext_vector_type(2)));
constexpr int P5_TOK = 32;
constexpr int P5_WL = 2048;
__device__ __forceinline__ unsigned fkey(float f) { const unsigned u = __float_as_uint(f); return (u & 0x80000000u) ? ~u : (u | 0x80000000u); }
__device__ __forceinline__ float dot2bf(unsigned a, unsigned b, float c) { return __builtin_amdgcn_fdot2_f32_bf16(__builtin_bit_cast(bf16x2_t, a), __builtin_bit_cast(bf16x2_t, b), c, false); }
template <int CTRL, int RM, bool BC> __device__ __forceinline__ float dpp_f(float v) { return __builtin_bit_cast(float, __builtin_amdgcn_update_dpp(0, __builtin_bit_cast(int, v), CTRL, RM, 0xf, BC)); }
struct WaveLds { LAS int* eid; LAS float* gate; LAS float* sv; LAS float* tv; LAS int* ti; LAS int* ctab; };
template <int CTRL> __device__ __forceinline__ unsigned dppx_u(unsigned v) { return (unsigned)__builtin_amdgcn_update_dpp(0, (int)v, CTRL, 0xf, 0xf, true); }
template <int CTRL> __device__ __forceinline__ float dppx_f(float v) { return __builtin_bit_cast(float, __builtin_amdgcn_update_dpp(0, __builtin_bit_cast(int, v), CTRL, 0xf, 0xf, true)); }
__device__ __forceinline__ unsigned umax(unsigned a, unsigned b) { return a > b ? a : b; }
__device__ __forceinline__ unsigned umin(unsigned a, unsigned b) { return a < b ? a : b; }
__device__ __forceinline__ unsigned row_allmax_u(unsigned m) {
    m = umax(m, dppx_u<0xB1>(m)); m = umax(m, dppx_u<0x4E>(m)); m = umax(m, dppx_u<0x141>(m)); m = umax(m, dppx_u<0x140>(m)); return m; }
__device__ __forceinline__ float row_allmax_f(float m) { m = fmaxf(m, dppx_f<0xB1>(m)); m = fmaxf(m, dppx_f<0x4E>(m)); m = fmaxf(m, dppx_f<0x141>(m)); m = fmaxf(m, dppx_f<0x140>(m)); return m; }
__device__ __forceinline__ float row_allsum_f(float m) { m += dppx_f<0xB1>(m); m += dppx_f<0x4E>(m); m += dppx_f<0x141>(m); m += dppx_f<0x140>(m); return m; }
#define P5_CE(a, b) do { const unsigned _h = umax(a, b), _l = umin(a, b); a = _h; b = _l; } while (0)
__device__ __forceinline__ int cand_pair(int c) {
    return c < 16 ? c : c < 24 ? (1 << 4) | (c - 16) : c < 29 ? (2 << 4) | (c - 24) : c < 33 ? (3 << 4) | (c - 29) : c < 36 ? (4 << 4) | (c - 33) : c < 38 ? (5 << 4) | (c - 36)
         : c < 40 ? (6 << 4) | (c - 38) : c < 42 ? (7 << 4) | (c - 40) : c < 50 ? ((c - 34) << 4) : 0xff;
}
__device__ __forceinline__ void p5_topk_fetch(const WaveLds& W, const float* src, int half, int lane) {
#pragma unroll
    for (int i = 0; i < 4; ++i) __builtin_amdgcn_global_load_lds((const unsigned*)(src + i * 256 + lane * 4), (LAS unsigned*)(W.sv + half * 1024 + i * 256), 16, 0, 0);
}
__device__ __forceinline__ void p5_topk_token(const WaveLds& W, const float* sc  , const float* sc_next, float rs  , int lane) {
    const int r = lane >> 4, l15 = lane & 15;
#pragma unroll 1
    for (int pp = 0; pp < 2; ++pp) {
        unsigned k[2][8]; unsigned top[2] = {0u, 0u};
        asm volatile("s_waitcnt vmcnt(0)" ::: "memory");
        { const float* nsrc = pp == 0 ? sc + 1024 : sc_next; if (nsrc != nullptr) p5_topk_fetch(W, nsrc, 1 - pp, lane); }
#pragma unroll
        for (int u = 0; u < 2; ++u) {
            const int L = 4 * (2 * pp + u) + r;
            const f32x4 v0 = *(const LAS f32x4*)(W.sv + L * 128 + 8 * l15) * rs, v1 = *(const LAS f32x4*)(W.sv + L * 128 + 8 * l15 + 4) * rs;
#pragma unroll
            for (int j = 0; j < 4; ++j) { k[u][j] = (fkey(v0[j]) & ~127u) | (unsigned)(127 - (8 * l15 + j)); k[u][4 + j] = (fkey(v1[j]) & ~127u) | (unsigned)(127 - (8 * l15 + 4 + j)); }
            P5_CE(k[u][0], k[u][1]); P5_CE(k[u][2], k[u][3]); P5_CE(k[u][4], k[u][5]); P5_CE(k[u][6], k[u][7]);
            P5_CE(k[u][0], k[u][2]); P5_CE(k[u][1], k[u][3]); P5_CE(k[u][4], k[u][6]); P5_CE(k[u][5], k[u][7]);
            P5_CE(k[u][1], k[u][2]); P5_CE(k[u][5], k[u][6]);
            P5_CE(k[u][0], k[u][4]); P5_CE(k[u][1], k[u][5]); P5_CE(k[u][2], k[u][6]); P5_CE(k[u][3], k[u][7]);
            P5_CE(k[u][2], k[u][4]); P5_CE(k[u][3], k[u][5]);
            P5_CE(k[u][1], k[u][2]); P5_CE(k[u][3], k[u][4]); P5_CE(k[u][5], k[u][6]);
        }
#pragma unroll 4
        for (int it = 0; it < 16; ++it) {
#pragma unroll
            for (int u = 0; u < 2; ++u) {
                const unsigned m = row_allmax_u(k[u][0]); const bool sel = k[u][0] == m;
                top[u] = (l15 == it) ? m : top[u];
#pragma unroll
                for (int j = 0; j < 7; ++j) k[u][j] = sel ? k[u][j + 1] : k[u][j];
                k[u][7] = sel ? 0u : k[u][7];
            }
        }
        LDS_WAIT(); __builtin_amdgcn_wave_barrier();
#pragma unroll
        for (int u = 0; u < 2; ++u) { const int L = 4 * (2 * pp + u) + r; const int idx = 127 - (int)(top[u] & 127u);
            W.tv[L * 16 + l15] = W.sv[L * 128 + idx] * rs; W.ti[L * 16 + l15] = idx; }
    }
    LDS_WAIT(); __builtin_amdgcn_wave_barrier();
    int cij[4];
#pragma unroll
    for (int j = 0; j < 4; ++j) cij[j] = cand_pair(4 * l15 + j);
    unsigned ck[2][4]; unsigned top2[2] = {0u, 0u};
#pragma unroll
    for (int u = 0; u < 2; ++u) {
        const int hd = 4 * u + r; const LAS float* tv0 = W.tv + (2 * hd) * 16; const LAS float* tv1 = tv0 + 16;
#pragma unroll
        for (int j = 0; j < 4; ++j) { const float cs = tv0[(cij[j] >> 4) & 15] + tv1[cij[j] & 15]; const int s = 4 * l15 + j;
            ck[u][j] = (s < 50) ? ((fkey(cs) & ~63u) | (unsigned)(63 - s)) : 0u; }
        P5_CE(ck[u][0], ck[u][1]); P5_CE(ck[u][2], ck[u][3]); P5_CE(ck[u][0], ck[u][2]); P5_CE(ck[u][1], ck[u][3]); P5_CE(ck[u][1], ck[u][2]);
    }
#pragma unroll 4
    for (int it = 0; it < 16; ++it) {
#pragma unroll
        for (int u = 0; u < 2; ++u) {
            const unsigned m = row_allmax_u(ck[u][0]); const bool sel = ck[u][0] == m;
            top2[u] = (l15 == it) ? m : top2[u];
            ck[u][0] = sel ? ck[u][1] : ck[u][0]; ck[u][1] = sel ? ck[u][2] : ck[u][1]; ck[u][2] = sel ? ck[u][3] : ck[u][2]; ck[u][3] = sel ? 0u : ck[u][3];
        }
    }
#pragma unroll
    for (int u = 0; u < 2; ++u) {
        const int hd = 4 * u + r; const LAS float* tv0 = W.tv + (2 * hd) * 16; const LAS float* tv1 = tv0 + 16; const LAS int* ti0 = W.ti + (2 * hd) * 16; const LAS int* ti1 = ti0 + 16;
        const int ij = W.ctab[63 - (int)(top2[u] & 63u)];
        const int i1 = (ij >> 4) & 15, j1 = ij & 15;
        const float vs = tv0[i1] + tv1[j1]; const int e = ti0[i1] * 128 + ti1[j1];
        const float mx = row_allmax_f(vs), ex = __expf(vs - mx), sm = row_allsum_f(ex);
        W.gate[hd * 16 + l15] = ex / sm; W.eid[hd * 16 + l15] = e;
    }
    LDS_WAIT(); __builtin_amdgcn_wave_barrier();
}
constexpr int P5_R = 9;
constexpr int P5_NSL = 8, P5_SLSH = 11;
#ifndef REP_TOPK
#define REP_TOPK 1
#endif
#ifndef REP_DS
#define REP_DS 1
#endif
constexpr int P5_WL2 = 20480;
struct SweepLds { LAS unsigned char* ring; LAS int* feid; LAS float* fcf; LAS float* raw; };
__device__ __forceinline__ int mbcnt64(unsigned long long m) { return __builtin_amdgcn_mbcnt_hi((unsigned)(m >> 32), __builtin_amdgcn_mbcnt_lo((unsigned)m, 0u)); }
template <int CTRL, int RM, bool BC> __device__ __forceinline__ int dpp_i(int v) { return __builtin_amdgcn_update_dpp(0, v, CTRL, RM, 0xf, BC); }
__device__ __forceinline__ float wave_total63(float v) {
    v += dpp_f<0x111, 0xf, true>(v); v += dpp_f<0x112, 0xf, true>(v); v += dpp_f<0x114, 0xf, true>(v); v += dpp_f<0x118, 0xf, true>(v);
    v += dpp_f<0x142, 0xa, false>(v); v += dpp_f<0x143, 0xc, false>(v); return v; }
__device__ __forceinline__ int wave_incl_scan(int v) {
    v += dpp_i<0x111, 0xf, true>(v); v += dpp_i<0x112, 0xf, true>(v); v += dpp_i<0x114, 0xf, true>(v); v += dpp_i<0x118, 0xf, true>(v);
    v += dpp_i<0x142, 0xa, false>(v); v += dpp_i<0x143, 0xc, false>(v); return v; }
#define P5_WRAP(x) ((x) + 1 == P5_R ? 0 : (x) + 1)
#define P5_ISSUE(tab, id_) do { const unsigned char* _gp = (tab) + (size_t)(id_) * ROWB + lane * 16; LAS unsigned char* _lp = L.ring + pslot * ROWB; \
    __builtin_amdgcn_global_load_lds((const unsigned*)_gp, (LAS unsigned*)_lp, 16, 0, 0);                         \
    if (lane < 32) __builtin_amdgcn_global_load_lds((const unsigned*)(_gp + 1024), (LAS unsigned*)(_lp + 1024), 16, 0, 0);     \
    pslot = P5_WRAP(pslot); } while (0)
#define P5_ROWREAD(dst_, slot_) do { const LAS unsigned char* _rp = L.ring + (slot_) * ROWB + lane * 24; const v2u _a = *(const LAS v2u*)_rp, _b = *(const LAS v2u*)(_rp + 8), _c = *(const LAS v2u*)(_rp + 16); \
    dst_[0] = (int)_a.x; dst_[1] = (int)_a.y; dst_[2] = (int)_b.x; dst_[3] = (int)_b.y; dst_[4] = (int)_c.x; dst_[5] = (int)_c.y; } while (0)
typedef int v8i __attribute__((ext_vector_type(8)));
#define P5_V6(x_) ((v6u){(unsigned)x_[0], (unsigned)x_[1], (unsigned)x_[2], (unsigned)x_[3], (unsigned)x_[4], (unsigned)x_[5]})
#define P5_FEID(i_) __builtin_amdgcn_readfirstlane(L.feid[(i_) > 511 ? 511 : (i_)])
typedef _Float16 f16x32 __attribute__((ext_vector_type(32)));
typedef _Float16 f16x2v __attribute__((ext_vector_type(2)));
__device__ __forceinline__ void wave_total63x2(float& a, float& b) {
    a += dpp_f<0x111, 0xf, true>(a); b += dpp_f<0x111, 0xf, true>(b); a += dpp_f<0x112, 0xf, true>(a); b += dpp_f<0x112, 0xf, true>(b);
    a += dpp_f<0x114, 0xf, true>(a); b += dpp_f<0x114, 0xf, true>(b); a += dpp_f<0x118, 0xf, true>(a); b += dpp_f<0x118, 0xf, true>(b);
    a += dpp_f<0x142, 0xa, false>(a); b += dpp_f<0x142, 0xa, false>(b); a += dpp_f<0x143, 0xc, false>(a); b += dpp_f<0x143, 0xc, false>(b);
}
template <bool UP> __device__ __forceinline__ void p5_sweep(const SweepLds& L, const unsigned char* tab, unsigned (&hp)[4][16], const v8i (&hq)[4], const float (&hinv)[4], int lenv0, int lenv1, int lane) {
    const LAS int* cbits = (const LAS int*)L.fcf;
    int pslot = 0, cslot = 2, idx = 0;
    for (int i = 0; i < P5_R; ++i) { const int id = P5_FEID(i); P5_ISSUE(tab, id); }
    int nv0 = L.feid[P5_R], nv1 = L.feid[P5_R + 1];
    asm volatile("s_waitcnt vmcnt(14)" ::: "memory");
    v8i ra = {0, 0, 0, 0, 0, 0, 0, 0}, rb = {0, 0, 0, 0, 0, 0, 0, 0}; P5_ROWREAD(ra, 0); P5_ROWREAD(rb, 1);
    const bool dg0 = (lane & 3) == 0, dg1 = (lane & 3) == 1, dg2 = (lane & 3) == 2, dgv = ((lane & 15) >> 2) == (lane >> 4);
    int cav = 0, cbv = 0; if (UP) { cav = cbits[0]; cbv = cbits[1]; }
    for (int s = 0; s < P5_NSL; ++s) {
        const int lenv = s < 16 ? lenv0 : lenv1;
#pragma unroll
        for (int tok = 0; tok < 4; ++tok) {
            const int n = __builtin_amdgcn_readlane(lenv, (s & 15) * 4 + tok);
            int i = 0;
            for (; i + 1 < n; i += 2) {
                f16x32 xa, xb; f32x4 ma, mb;
                if (UP) { xa = __builtin_amdgcn_cvt_scalef32_pk32_f16_fp6(P5_V6(ra), 1.0f); xb = __builtin_amdgcn_cvt_scalef32_pk32_f16_fp6(P5_V6(rb), 1.0f); }
                else { const f32x4 z = {0.f, 0.f, 0.f, 0.f};
                    ma = __builtin_amdgcn_mfma_scale_f32_16x16x128_f8f6f4(ra, hq[tok], z, 2  , 2  , 0, 0, 0, 0);
                    mb = __builtin_amdgcn_mfma_scale_f32_16x16x128_f8f6f4(rb, hq[tok], z, 2, 2, 0, 0, 0, 0); }
                const f16x2v ca = __builtin_bit_cast(f16x2v, __builtin_amdgcn_readfirstlane(cav)), cb = __builtin_bit_cast(f16x2v, __builtin_amdgcn_readfirstlane(cbv));
                { const int id0 = __builtin_amdgcn_readfirstlane(nv0), id1 = __builtin_amdgcn_readfirstlane(nv1); P5_ISSUE(tab, id0); P5_ISSUE(tab, id1); }
                nv0 = L.feid[idx + 2 + P5_R > 511 ? 511 : idx + 2 + P5_R]; nv1 = L.feid[idx + 3 + P5_R > 511 ? 511 : idx + 3 + P5_R];
                if (UP) { cav = cbits[idx + 2 > 511 ? 511 : idx + 2]; cbv = cbits[idx + 3 > 511 ? 511 : idx + 3]; }
                asm volatile("s_waitcnt vmcnt(14)" ::: "memory");
                const int cs1 = P5_WRAP(cslot);
                P5_ROWREAD(ra, cslot); P5_ROWREAD(rb, cs1);
                cslot = P5_WRAP(cs1);
                __builtin_amdgcn_sched_barrier(0);
                if (!UP) {
                    float a0 = ma[0], a1 = ma[1], a2 = ma[2], a3 = ma[3], b0 = mb[0], b1 = mb[1], b2 = mb[2], b3 = mb[3];
                    asm volatile("" : "+v"(a0), "+v"(a1), "+v"(a2), "+v"(a3), "+v"(b0), "+v"(b1), "+v"(b2), "+v"(b3));
                    float ta = dg0 ? a0 : dg1 ? a1 : dg2 ? a2 : a3, tb = dg0 ? b0 : dg1 ? b1 : dg2 ? b2 : b3;
                    ta = dgv ? ta : 0.f; tb = dgv ? tb : 0.f; wave_total63x2(ta, tb);
                    L.raw[idx] = __builtin_bit_cast(float, __builtin_amdgcn_readlane(__builtin_bit_cast(int, ta), 63)) * hinv[tok];
                    L.raw[idx + 1] = __builtin_bit_cast(float, __builtin_amdgcn_readlane(__builtin_bit_cast(int, tb), 63)) * hinv[tok];
                } else {
#pragma unroll
                    for (int k = 0; k < 16; ++k) hp[tok][k] = __builtin_bit_cast(unsigned, __builtin_elementwise_fma((f16x2v){xa[2 * k], xa[2 * k + 1]}, ca, __builtin_bit_cast(f16x2v, hp[tok][k])));
                    __builtin_amdgcn_sched_barrier(0);
#pragma unroll
                    for (int k = 0; k < 16; ++k) hp[tok][k] = __builtin_bit_cast(unsigned, __builtin_elementwise_fma((f16x2v){xb[2 * k], xb[2 * k + 1]}, cb, __builtin_bit_cast(f16x2v, hp[tok][k])));
                }
                idx += 2;
            }
            if (i < n) {
                f16x32 xa; f32x4 ma;
                if (UP) xa = __builtin_amdgcn_cvt_scalef32_pk32_f16_fp6(P5_V6(ra), 1.0f);
                else { const f32x4 z = {0.f, 0.f, 0.f, 0.f}; ma = __builtin_amdgcn_mfma_scale_f32_16x16x128_f8f6f4(ra, hq[tok], z, 2, 2, 0, 0, 0, 0); }
                const f16x2v ca = __builtin_bit_cast(f16x2v, __builtin_amdgcn_readfirstlane(cav));
                ra = rb; cav = cbv;
                { const int id0 = __builtin_amdgcn_readfirstlane(nv0); P5_ISSUE(tab, id0); }
                nv0 = nv1; nv1 = L.feid[idx + 2 + P5_R > 511 ? 511 : idx + 2 + P5_R];
                if (UP) cbv = cbits[idx + 2 > 511 ? 511 : idx + 2];
                asm volatile("s_waitcnt vmcnt(14)" ::: "memory");
                P5_ROWREAD(rb, cslot);
                cslot = P5_WRAP(cslot);
                __builtin_amdgcn_sched_barrier(0);
                if (!UP) {
                    float a0 = ma[0], a1 = ma[1], a2 = ma[2], a3 = ma[3];
                    asm volatile("" : "+v"(a0), "+v"(a1), "+v"(a2), "+v"(a3));
                    float ta = dg0 ? a0 : dg1 ? a1 : dg2 ? a2 : a3; ta = wave_total63(dgv ? ta : 0.f);
                    L.raw[idx] = __builtin_bit_cast(float, __builtin_amdgcn_readlane(__builtin_bit_cast(int, ta), 63)) * hinv[tok];
                } else {
#pragma unroll
                    for (int k = 0; k < 16; ++k) hp[tok][k] = __builtin_bit_cast(unsigned, __builtin_elementwise_fma((f16x2v){xa[2 * k], xa[2 * k + 1]}, ca, __builtin_bit_cast(f16x2v, hp[tok][k])));
                }
                idx += 1;
            }
        }
    }
    asm volatile("s_waitcnt vmcnt(0)" ::: "memory");
}
__device__ __forceinline__ void p5_wave(LAS unsigned char* wl, const float* SC, const bf16* X1, const unsigned char* ED, const unsigned char* EU, const float* SD, const float* SU,
                                        const float* gf, float* out, int t0, int lane, const float* g2) {
    SweepLds L; L.ring = wl; L.feid = (LAS int*)(wl + 14336); L.fcf = (LAS float*)(wl + 14336 + 2048); L.raw = (LAS float*)(wl + 14336 + 4096);
    { LAS int* ctab = (LAS int*)(wl + 14336); ctab[lane] = cand_pair(lane); }
    unsigned hp[4][16]; float rsv[4]; v8i hq[4]; float hinv[4];
    {   f32x4 gl[8];
        int ls = lane; asm volatile("" : "+v"(ls));
#pragma unroll
        for (int i = 0; i < 8; ++i) gl[i] = *(const f32x4*)(g2 + i * 256 + ls * 4);
        v2u xq[4][8];
#pragma unroll
        for (int tk = 0; tk < 4; ++tk)
#pragma unroll
            for (int i = 0; i < 8; ++i) xq[tk][i] = *(const v2u*)(X1 + (size_t)(t0 + 8 * tk) * D + i * 256 + ls * 4);
#pragma unroll
        for (int tk = 0; tk < 4; ++tk) { float ss = 0.f;
#pragma unroll
            for (int i = 0; i < 8; ++i)
#pragma unroll
                for (int e = 0; e < 2; ++e) { const float a = bflo(xq[tk][i][e]), b = bfhi(xq[tk][i][e]); ss += a * a + b * b; }
            const float rs = __builtin_amdgcn_rsqf(wave_sum(ss) * (1.f / D) + EPS); rsv[tk] = rs;
            float hx[32]; float mx = 0.f;
#pragma unroll
            for (int i = 0; i < 8; ++i)
#pragma unroll
                for (int e = 0; e < 2; ++e) {
                    hx[4 * i + 2 * e] = bflo(xq[tk][i][e]) * rs * gl[i][2 * e]; hx[4 * i + 2 * e + 1] = bfhi(xq[tk][i][e]) * rs * gl[i][2 * e + 1];
                    mx = fmaxf(mx, fmaxf(fabsf(hx[4 * i + 2 * e]), fabsf(hx[4 * i + 2 * e + 1]))); }
#pragma unroll
            for (int o = 1; o < 64; o <<= 1) mx = fmaxf(mx, __shfl_xor(mx, o));
            const float hs = mx > 0.f ? 7.f / mx : 0.f; hinv[tk] = mx * (1.f / 7.f);
            bf16x32 hb;
#pragma unroll
            for (int k = 0; k < 32; ++k) hb[k] = (__bf16)(hx[k] * hs);
            const v6u pk = __builtin_amdgcn_cvt_scalef32_pk32_fp6_bf16(hb, 1.0f);
            hq[tk] = (v8i){(int)pk[0], (int)pk[1], (int)pk[2], (int)pk[3], (int)pk[4], (int)pk[5], 0, 0};
        }
    }
    LDS_WAIT(); __builtin_amdgcn_wave_barrier();
    for (int rep_ = 0; rep_ < REP_TOPK; ++rep_)
    for (int tk = 0; tk < 4; ++tk) {
        if (tk == 0) { WaveLds W0; W0.sv = (LAS float*)(wl + 4096); p5_topk_fetch(W0, SC + (size_t)t0 * 2048, 0, lane); }
        WaveLds W; W.eid = (LAS int*)(wl + 1024 * tk); W.gate = (LAS float*)(wl + 1024 * tk + 512);
        W.sv = (LAS float*)(wl + 4096); W.tv = (LAS float*)(wl + 12288); W.ti = (LAS int*)(wl + 13312); W.ctab = (LAS int*)(wl + 14336);
        p5_topk_token(W, SC + (size_t)(t0 + 8 * tk) * 2048, tk < 3 ? SC + (size_t)(t0 + 8 * tk + 8) * 2048 : nullptr, rsv[tk], lane);
    }
    int lenv0 = 0, lenv1 = 0;
#pragma unroll
    for (int tk = 0; tk < 4; ++tk) {
        const LAS int* ue = (const LAS int*)(wl + 1024 * tk); const int sl0 = ue[lane] >> P5_SLSH, sl1 = ue[lane + 64] >> P5_SLSH;
        for (int k = 0; k < P5_NSL; ++k) { const int c = __popcll(__ballot(sl0 == k)) + __popcll(__ballot(sl1 == k));
            if (lane == (k & 15) * 4 + tk) { if (k < 16) lenv0 = c; else lenv1 = c; } }
    }
    const int incl0 = wave_incl_scan(lenv0), tot0 = __builtin_amdgcn_readlane(incl0, 63);
    const int base0 = incl0 - lenv0, base1 = wave_incl_scan(lenv1) - lenv1 + tot0;
#pragma unroll
    for (int tk = 0; tk < 4; ++tk) {
        const LAS int* ue = (const LAS int*)(wl + 1024 * tk); const LAS float* ug = (const LAS float*)(wl + 1024 * tk + 512);
        const int e0 = ue[lane], e1 = ue[lane + 64], sl0 = e0 >> P5_SLSH, sl1 = e1 >> P5_SLSH; const float g0 = ug[lane], g1 = ug[lane + 64];
        int r0 = 0, r1 = 0;
        for (int k = 0; k < P5_NSL; ++k) { const unsigned long long m0 = __ballot(sl0 == k), m1 = __ballot(sl1 == k);
            if (sl0 == k) r0 = mbcnt64(m0);
            if (sl1 == k) r1 = __popcll(m0) + mbcnt64(m1); }
        const int b00 = __shfl(base0, (sl0 & 15) * 4 + tk), b01 = __shfl(base1, (sl0 & 15) * 4 + tk), b10 = __shfl(base0, (sl1 & 15) * 4 + tk), b11 = __shfl(base1, (sl1 & 15) * 4 + tk);
        const int p0 = (sl0 < 16 ? b00 : b01) + r0, p1 = (sl1 < 16 ? b10 : b11) + r1;
        L.feid[p0] = e0; L.fcf[p0] = g0; L.feid[p1] = e1; L.fcf[p1] = g1;
    }
    LDS_WAIT(); __builtin_amdgcn_wave_barrier();
    for (int rep_ = 0; rep_ < REP_DS; ++rep_) p5_sweep<false>(L, ED, hp, hq, hinv, lenv0, lenv1, lane);
    LDS_WAIT(); __builtin_amdgcn_wave_barrier();
    float cmax = 0.f;
    {   float sdv[8], suv[8], cv[8];
#pragma unroll
        for (int k = 0; k < 8; ++k) { const int id = L.feid[lane + 64 * k]; sdv[k] = SD[id]; suv[k] = SU[id]; }
#pragma unroll
        for (int k = 0; k < 8; ++k) { const int i = lane + 64 * k; cv[k] = gelu_erf(L.raw[i] * sdv[k]) * L.fcf[i] * suv[k]; cmax = fmaxf(cmax, fabsf(cv[k])); }
#pragma unroll
        for (int o = 1; o < 64; o <<= 1) cmax = fmaxf(cmax, __shfl_xor(cmax, o));
        const float cinv = cmax > 0.f ? 1.f / cmax : 0.f;
#pragma unroll
        for (int k = 0; k < 8; ++k) { const _Float16 h = (_Float16)(cv[k] * cinv); ((LAS unsigned*)L.fcf)[lane + 64 * k] = __builtin_bit_cast(unsigned, (f16x2v){h, h}); }
    }
    LDS_WAIT(); __builtin_amdgcn_wave_barrier();
    asm volatile("s_waitcnt vmcnt(0)" ::: "memory");
#pragma unroll
    for (int tk = 0; tk < 4; ++tk)
#pragma unroll
        for (int q = 0; q < 16; ++q) hp[tk][q] = 0u;
    p5_sweep<true>(L, EU, hp, hq, hinv, lenv0, lenv1, lane);
    int le = lane; asm volatile("" : "+v"(le));
#pragma unroll
    for (int tk = 0; tk < 4; ++tk) {
        const size_t ro = (size_t)(t0 + 8 * tk) * D; float ss = 0.f; float st[32];
#pragma unroll
        for (int i = 0; i < 8; ++i) { const v2u xa = __builtin_nontemporal_load((const v2u*)(X1 + ro + i * 256 + le * 4));
#pragma unroll
            for (int c = 0; c < 2; ++c) { const int k = 4 * i + 2 * c; const f16x2v a = __builtin_bit_cast(f16x2v, hp[tk][k >> 1]);
                st[k] = (float)a.x * cmax + bflo(xa[c]); st[k + 1] = (float)a.y * cmax + bfhi(xa[c]); ss += st[k] * st[k] + st[k + 1] * st[k + 1]; } }
        const float r = rsqrtf(wave_sum(ss) * (1.f / D) + EPS);
#pragma unroll
        for (int i = 0; i < 8; ++i) { const f32x4 g = *(const f32x4*)(gf + i * 256 + le * 4); f32x4 a;
#pragma unroll
            for (int c = 0; c < 4; ++c) a[c] = st[4 * i + c] * r * g[c];
            __builtin_nontemporal_store(a, (f32x4*)(out + ro + i * 256 + le * 4)); }
    }
}
__device__ __forceinline__ void p5_peer(const Ctx& F, const float* SC, const bf16* X1, const unsigned char* ED, const unsigned char* EU, const float* SD, const float* SU, const float* gf, float* out, const float* g2) {
    for (int tile = F.bid; tile < T / P5_TOK; tile += F.G)
        p5_wave(F.lds + F.wave * P5_WL2, SC, X1, ED, EU, SD, SU, gf, out, tile * P5_TOK + F.wave, F.lane, g2);
}

struct Args { const float* in[15]; float* out; unsigned char* ws; };
__global__ void __launch_bounds__(NTHR, 2) mega_fwd(Args args) {
    extern __shared__ __attribute__((aligned(16))) unsigned char lds_raw[];
    Ctx F; F.lds = (LAS unsigned char*)lds_raw; F.tid = threadIdx.x; F.lane = F.tid & 63; F.wave = __builtin_amdgcn_readfirstlane(F.tid >> 6); F.G = gridDim.x; F.bid = blockIdx.x;
    volatile LAS unsigned* MISC = (volatile LAS unsigned*)(F.lds + MISC_OFF);
    unsigned char* ws = args.ws; unsigned* ctl = (unsigned*)(ws + WS_CTL);
    const float* x = args.in[0]; const float* norm1_g = args.in[1]; const float* w_in = args.in[2]; const float* sgu_ln_g = args.in[3]; const float* sgu_ln_b = args.in[4];
    const float* w_spatial = args.in[5]; const float* b_spatial = args.in[6]; const float* attn_sinks = args.in[7]; const float* w_out = args.in[8]; const float* norm2_g = args.in[9];
    const float* w_query = args.in[10]; const float* sub_keys = args.in[11]; const float* expert_down = args.in[12]; const float* expert_up = args.in[13]; const float* norm_f_g = args.in[14];
    bf16* WinT = (bf16*)(ws + WS_WIN); bf16* WoutT = (bf16*)(ws + WS_WOUT); bf16* WeffT = (bf16*)(ws + WS_WEFF); bf16* H = (bf16*)(ws + WS_H);
    bf16* Z = (bf16*)(ws + WS_Z); bf16* MIX = (bf16*)(ws + WS_MIX); bf16* X1 = (bf16*)(ws + WS_X1); float* SC = (float*)(ws + WS_SC);
    unsigned char* ED = ws + WS_ED; unsigned char* EU = ws + WS_EU; float* SD = (float*)(ws + WS_SD); float* SU = (float*)(ws + WS_SU);
    for (int u = F.tid; u < (LDS_BYTES - LDSCTL_OFF) / 4; u += NTHR) ((LAS unsigned*)(F.lds + LDSCTL_OFF))[u] = 0u;
    __syncthreads();
    XcdBarrier bar = xcd_barrier_post(ctl + CW_BAR, MISC + 8);
#ifdef TP_PHASE
    volatile unsigned long long* tsp = (volatile unsigned long long*)(ws + WS_TP);
#define TP_BEGIN(k) do { if ((k) == TP_PHASE && F.bid == 0 && F.tid == 0) tsp[0] = wall_clock64(); } while (0)
#define TP_END(k) do { if ((k) == TP_PHASE && F.bid == 0 && F.tid == 0) tsp[1] = wall_clock64() - tsp[0]; } while (0)
#else
#define TP_BEGIN(k) do { } while (0)
#define TP_END(k) do { } while (0)
#endif
    TP_BEGIN(0);

    for (int rep = 0; rep < REP_P0; ++rep) p0_prologue(F, x, norm1_g, w_in, w_out, w_query, sub_keys, expert_down, expert_up, WinT, WoutT, WeffT, H, ED, EU, SD, SU, norm2_g);
    xcd_barrier(bar); TP_END(0); TP_BEGIN(1);
#if defined(TP_PHASE) && TP_PHASE == 11
    if (F.bid == F.G - 1 && F.tid == 0) tsp[0] = wall_clock64();
#endif
    for (int rep_ = 0; rep_ < REP_P1; ++rep_)
    {   pg8::Gemm g{H, WinT, T, NIN, D}; pg8::StaticOrder S; S.init(T, NIN, F.G, F.bid);
        pg8::EpiZ E{Z, NIN, 8};
        pg8::gemm_phase<pg8::EpiZ, pg8::StaticOrder, true, true>(F.lds + RING_OFF, g, S, E); }
    {
        const int nU = (T / 256) * (NIN / 256), maxu = (nU + F.G - 1) / F.G, nfull = nU - (maxu - 1) * F.G;
        const bool all = nfull == F.G; const int nidle = all ? F.G : F.G - nfull, q = all ? F.bid : F.bid - nfull;
        if (q >= 0) convert_rows(expert_down, expert_up, ED, EU, SD, SU, CONV_SPLIT, 2 * NE, q * NWAVES + F.wave, nidle * NWAVES, F.lane);
#if defined(TP_PHASE) && TP_PHASE == 11
        __syncthreads(); if (F.bid == F.G - 1 && F.tid == 0) tsp[1] = wall_clock64() - tsp[0];
#endif
    }
    xcd_barrier(bar); TP_END(1); TP_BEGIN(2);
    for (int rep = 0; rep < REP_P2; ++rep) { p2_sgu(F, Z, sgu_ln_g, sgu_ln_b, w_spatial, b_spatial, MIX); p2_attn(F, Z, attn_sinks, MIX); }
    {   pg8::Gemm g{MIX, WoutT, T, D, D}; pg8::StaticOrder S; S.init(T, D, F.G, F.bid);
        pg8::EpiX1 E{x, X1, D};
        pg8::f32x4 acc[2][2][4][2]; pg8::Unit u0; const bool has0 = S.next(0, u0);
        const int wr_ = F.wave >> 2, wc_ = F.wave & 3, fr_ = F.lane & 15, fq_ = F.lane >> 4;
        xcd_barrier_pre(bar, [&]() { if (has0) E.init(acc, u0, wr_, wc_, fr_, fq_); }); TP_END(2); TP_BEGIN(3);
        pg8::gemm_phase_acc<pg8::EpiX1, pg8::StaticOrder, true, true, true>(F.lds + RING_OFF, g, S, E, acc); }
    xcd_barrier(bar); TP_END(3); TP_BEGIN(4);
    {   pg8::Gemm g{X1, WeffT, T, D, D}; pg8::StaticOrder S; S.init(T, D, F.G, F.bid);
        pg8::EpiF32<false> E{nullptr, SC, D};
        pg8::gemm_phase<pg8::EpiF32<false>, pg8::StaticOrder, true, true>(F.lds + RING_OFF, g, S, E); }
    xcd_barrier(bar); TP_END(4); TP_BEGIN(5);
    for (int rep = 0; rep < REP_P5; ++rep) p5_peer(F, SC, X1, ED, EU, SD, SU, norm_f_g, args.out, norm2_g);
#ifdef TP_PHASE
    xcd_barrier(bar); TP_END(5);
    if (F.bid == 0 && F.tid == 0) { const unsigned long long t0 = wall_clock64(), w = (unsigned long long)TP_W * tsp[1]; while (wall_clock64() - t0 < w) __builtin_amdgcn_s_sleep(16); }
#endif
}

extern "C" void kernel_launch(void* const* d_in, const int* in_sizes, int n_in, void* d_out, int out_size, void* d_ws, size_t ws_size, hipStream_t stream) {
    static int grid = 0;
    if (grid == 0) {
        if (n_in != 15 || ws_size < WS_END) { fprintf(stderr, "kernel_launch: unexpected inputs / workspace\n"); grid = -1; return; }
        int dev = 0, cus = 0, per_cu = 0;
        if (hipGetDevice(&dev) != hipSuccess || hipDeviceGetAttribute(&cus, hipDeviceAttributeMultiprocessorCount, dev) != hipSuccess) { grid = -1; return; }
        if (hipFuncSetAttribute((const void*)mega_fwd, hipFuncAttributeMaxDynamicSharedMemorySize, LDS_BYTES) != hipSuccess) { fprintf(stderr, "kernel_launch: hipFuncSetAttribute failed\n"); grid = -1; return; }
        if (hipOccupancyMaxActiveBlocksPerMultiprocessor(&per_cu, (const void*)mega_fwd, NTHR, LDS_BYTES) != hipSuccess || per_cu < 1)
            fprintf(stderr, "kernel_launch: note: occupancy query reports %d workgroups per CU\n", per_cu);
        (void)hipGetLastError();
        grid = cus;
    }
    if (grid < 0) return;
    if (hipMemsetAsync((char*)d_ws + WS_CTL, 0, CTL_ZERO_BYTES, stream) != hipSuccess) return;
    Args a{};
    for (int i = 0; i < 15; ++i) a.in[i] = (const float*)d_in[i];
    a.out = (float*)d_out; a.ws = (unsigned char*)d_ws;
    hipLaunchKernelGGL(mega_fwd, dim3(grid), dim3(NTHR), LDS_BYTES, stream, a);
}
```

```cpp
#include <hip/hip_runtime.h>
#include <cstdio>
#include <cstdint>
#include <math.h>
namespace pg8 {
#define PG8_LAS __attribute__((address_space(3)))
typedef unsigned short bf16_t;
typedef short bf16x8 __attribute__((ext_vector_type(8)));
typedef float f32x4 __attribute__((ext_vector_type(4)));
typedef unsigned u32x4 __attribute__((ext_vector_type(4)));
constexpr int BM = 256, BK = 64, HALF = 128, HTB = HALF * BK * 2  , STAGE_BYTES = 8 * HTB, NXCD = 8, WGM = 8;

__host__ __device__ __forceinline__ int lds_byte(int r, int c) { const int st = (r >> 4) * 2 + (c >> 5), rr = r & 15, cc = c & 31, ob = rr * 64 + cc * 2; return st * 1024 + (ob ^ (((ob >> 9) & 1) << 5)); }
__host__ __device__ __forceinline__ void stage_rc(int b, int& R, int& C) { const int st = b / 1024, sb = b % 1024, swz = sb ^ (((sb >> 9) & 1) << 5); R = (st >> 1) * 16 + swz / 64; C = (st & 1) * 32 + (swz % 64) / 2; }
__host__ __device__ __forceinline__ int perm32(int rho) { const int n = rho >> 4, i = rho & 15; return 8 * (i >> 2) + 4 * n + (i & 3); }

struct Unit { int pm, pn; };
struct Gemm { const bf16_t* A; const bf16_t* Bt; int M, N, K; };

struct StaticOrder {
    int nM, nN, nwg, G, c;
    __host__ __device__ void init(int M, int N, int G_, int c_) { nM = M / BM; nN = N / BM; nwg = nM * nN; G = G_; c = c_; }
    __host__ __device__ bool next(int i, Unit& u) const {
        const long L = (long)i * G + c; if (L >= nwg) return false;
        int wgid = (int)L; { const int q = nwg / NXCD, r = nwg % NXCD, xcd = wgid % NXCD, off = wgid / NXCD; wgid = (xcd < r ? xcd * (q + 1) : r * (q + 1) + (xcd - r) * q) + off; }
        const int nig = WGM * nN, gid = wgid / nig, fm = gid * WGM, gsz = (nM - fm) < WGM ? (nM - fm) : WGM;
        u.pm = fm + ((wgid % nig) % gsz); u.pn = (wgid % nig) / gsz; return true;
    }
    __device__ __forceinline__ void a_ready(const Unit&) const {}
    __device__ __forceinline__ void done(const Unit&) const {}
};

__device__ __forceinline__ unsigned cvt_pk_bf16(float lo, float hi) { unsigned r; asm volatile("v_cvt_pk_bf16_f32 %0, %1, %2" : "=v"(r) : "v"(lo), "v"(hi)); return r; }
typedef float f32x2 __attribute__((ext_vector_type(2)));
__device__ __forceinline__ f32x2 gelu_pk(f32x2 v) {
    const f32x2 av = __builtin_elementwise_abs(v), d = av * 0.2316418882f + 1.0f;
    f32x2 t; t.x = __builtin_amdgcn_rcpf(d.x); t.y = __builtin_amdgcn_rcpf(d.y);
    f32x2 q = t * 0.5307027145f + (-0.7265760135f); q = q * t + 0.7107068705f; q = q * t + (-0.142248368f); q = q * t + 0.127414796f; q = q * t;
    const f32x2 s = (v * v) * (-0.72134752044f);
    f32x2 e; e.x = __builtin_amdgcn_exp2f(s.x); e.y = __builtin_amdgcn_exp2f(s.y);
    const f32x2 m = v * (q * e), r = v - m;
    f32x2 o; o.x = v.x < 0.f ? m.x : r.x; o.y = v.y < 0.f ? m.y : r.y; return o;
}
struct EpiZ {
    static constexpr bool PERM = true, AFTER_DRAIN = false;
    bf16_t* O; int ldc; int gelu_tiles;
    __device__ __forceinline__ void operator()(const f32x4 (&acc)[2][2][4][2], const Unit& u, int wr, int wc, int fr, int fq) const {
        const int row0 = u.pm * BM + wr * 64 + fr, col0 = u.pn * BM + wc * 32 + 8 * fq;
        const bool act = u.pn < gelu_tiles;
#pragma unroll
        for (int ai = 0; ai < 2; ++ai)
#pragma unroll
            for (int m = 0; m < 4; ++m) { bf16_t* rowp = O + (size_t)(row0 + ai * HALF + m * 16) * ldc + col0;
#pragma unroll
                for (int bj = 0; bj < 2; ++bj) { f32x4 v0 = acc[ai][bj][m][0], v1 = acc[ai][bj][m][1];
                    if (act) { f32x2 a = gelu_pk((f32x2){v0[0], v0[1]}), b = gelu_pk((f32x2){v0[2], v0[3]}), c = gelu_pk((f32x2){v1[0], v1[1]}), d = gelu_pk((f32x2){v1[2], v1[3]});
                        v0 = (f32x4){a.x, a.y, b.x, b.y}; v1 = (f32x4){c.x, c.y, d.x, d.y}; }
                    u32x4 w; w.x = cvt_pk_bf16(v0[0], v0[1]); w.y = cvt_pk_bf16(v0[2], v0[3]); w.z = cvt_pk_bf16(v1[0], v1[1]); w.w = cvt_pk_bf16(v1[2], v1[3]);
                    *(u32x4*)(rowp + bj * HALF) = w; } }
    }
};
template <bool RES> struct EpiF32 {
    static constexpr bool PERM = false, AFTER_DRAIN = false;
    const float* base; float* C; int ldc;
    __device__ __forceinline__ void operator()(const f32x4 (&acc)[2][2][4][2], const Unit& u, int wr, int wc, int fr, int fq) const {
        const int row0 = u.pm * BM + wr * 64 + fr, col0 = u.pn * BM + wc * 32 + 4 * fq;
#pragma unroll
        for (int ai = 0; ai < 2; ++ai)
#pragma unroll
            for (int m = 0; m < 4; ++m) { const size_t off = (size_t)(row0 + ai * HALF + m * 16) * ldc + col0;
#pragma unroll
                for (int bj = 0; bj < 2; ++bj)
#pragma unroll
                    for (int n = 0; n < 2; ++n) { const size_t o = off + bj * HALF + n * 16; f32x4 v = acc[ai][bj][m][n];
                        if (RES) v = v + *(const f32x4*)(base + o);
                        *(f32x4*)(C + o) = v; } }
    }
};
struct EpiX1 {
    static constexpr bool PERM = false, AFTER_DRAIN = false;
    const float* base; bf16_t* X1; int ldc;
    __device__ __forceinline__ void init(f32x4 (&acc)[2][2][4][2], const Unit& u, int wr, int wc, int fr, int fq) const {
        const int row0 = u.pm * BM + wr * 64 + fr, col0 = u.pn * BM + wc * 32 + 4 * fq;
#pragma unroll
        for (int ai = 0; ai < 2; ++ai)
#pragma unroll
            for (int m = 0; m < 4; ++m) { const size_t off = (size_t)(row0 + ai * HALF + m * 16) * ldc + col0;
#pragma unroll
                for (int bj = 0; bj < 2; ++bj)
#pragma unroll
                    for (int n = 0; n < 2; ++n) acc[ai][bj][m][n] = *(const f32x4*)(base + off + bj * HALF + n * 16); }
    }
    __device__ __forceinline__ void operator()(const f32x4 (&acc)[2][2][4][2], const Unit& u, int wr, int wc, int fr, int fq) const {
        const int row0 = u.pm * BM + wr * 64 + fr, col0 = u.pn * BM + wc * 32 + 4 * fq;
        typedef __bf16 bf2 __attribute__((ext_vector_type(2)));
        typedef unsigned u2 __attribute__((ext_vector_type(2)));
#pragma unroll
        for (int ai = 0; ai < 2; ++ai)
#pragma unroll
            for (int m = 0; m < 4; ++m) { const size_t off = (size_t)(row0 + ai * HALF + m * 16) * ldc + col0;
#pragma unroll
                for (int bj = 0; bj < 2; ++bj)
#pragma unroll
                    for (int n = 0; n < 2; ++n) { const f32x4 v = acc[ai][bj][m][n]; const f32x2 lo = {v[0], v[1]}, hi = {v[2], v[3]};
                        u2 pk; pk.x = __builtin_bit_cast(unsigned, __builtin_convertvector(lo, bf2)); pk.y = __builtin_bit_cast(unsigned, __builtin_convertvector(hi, bf2));
                        *(u2*)(X1 + off + bj * HALF + n * 16) = pk; } }
    }
};
template <class Epi, class Sched, bool ALIGN_EPI = false, bool SP2 = false, bool PRE = false>
__device__ __forceinline__ void gemm_phase_acc(PG8_LAS unsigned char* lds, const Gemm g, const Sched& S, const Epi& E, f32x4 (&acc)[2][2][4][2]) {
    const int tid = threadIdx.x, wid = __builtin_amdgcn_readfirstlane(tid >> 6), lane = tid & 63, wr = wid >> 2, wc = wid & 3, fr = lane & 15, fq = lane >> 4;
    const int K = g.K, nt = K / BK;
    unsigned voffA[2], voffB[2];
#pragma unroll
    for (int i = 0; i < 2; ++i) { int R, C; stage_rc(tid * 16 + i * 8192, R, C); const int Rb = Epi::PERM ? ((R & ~31) + perm32(R & 31)) : R;
        voffA[i] = (unsigned)(R * K + C) * 2u; voffB[i] = (unsigned)(Rb * K + C) * 2u; }
    const size_t kstep = (size_t)(BK * 2);
    const size_t hstep = (size_t)HALF * K * 2;
    const size_t tstep = 2 * hstep;
    const unsigned ldsw = (unsigned)wid * 1024u;
    const int aoff = lds_byte(wr * 64 + fr, fq * 8), boff = lds_byte(wc * 32 + fr, fq * 8);
#define PG8_SA(b, h) (((b) * 2 + (h)) * HTB)
#define PG8_SB(b, h) ((4 + (b) * 2 + (h)) * HTB)
#define PG8_STAGE(bufoff, gbase, voff) do { _Pragma("unroll") for (int _i = 0; _i < 2; ++_i) \
        __builtin_amdgcn_global_load_lds((const unsigned*)((const char*)(gbase) + (voff)[_i]), (PG8_LAS unsigned*)(lds + (bufoff) + ldsw + _i * 8192), 16, 0, 0); } while (0)
#define PG8_LDA(dst, b, h) do { _Pragma("unroll") for (int m = 0; m < 4; ++m) _Pragma("unroll") for (int k = 0; k < 2; ++k) dst[m][k] = *(const PG8_LAS bf16x8*)(lds + PG8_SA(b, h) + aoff + m * 2048 + k * 1024); } while (0)
#define PG8_LDB(dst, b, h) do { _Pragma("unroll") for (int n = 0; n < 2; ++n) _Pragma("unroll") for (int k = 0; k < 2; ++k) dst[n][k] = *(const PG8_LAS bf16x8*)(lds + PG8_SB(b, h) + boff + n * 2048 + k * 1024); } while (0)
#define PG8_MMA(ai, bj, At, Bt) do { __builtin_amdgcn_s_setprio(1); _Pragma("unroll") for (int m = 0; m < 4; ++m) _Pragma("unroll") for (int n = 0; n < 2; ++n) _Pragma("unroll") for (int k = 0; k < 2; ++k) \
        acc[ai][bj][m][n] = __builtin_amdgcn_mfma_f32_16x16x32_bf16(Bt[n][k], At[m][k], acc[ai][bj][m][n], 0, 0, 0); __builtin_amdgcn_s_setprio(0); } while (0)
#define PG8_WAIT_V(n) asm volatile("s_waitcnt vmcnt(" #n ")" ::: "memory")
#define PG8_WAIT_L(n) asm volatile("s_waitcnt lgkmcnt(" #n ")" ::: "memory")
#define PG8_BAR __builtin_amdgcn_s_barrier()
#define PG8_SCHED __builtin_amdgcn_sched_barrier(0)
    Unit cur, nxt; int ui = 0;
    if (!S.next(0, cur)) return;
    if constexpr (!PRE) {
#pragma unroll
    for (int a = 0; a < 2; ++a)
#pragma unroll
        for (int b = 0; b < 2; ++b)
#pragma unroll
            for (int m = 0; m < 4; ++m)
#pragma unroll
                for (int n = 0; n < 2; ++n) acc[a][b][m][n] = (f32x4){0.f, 0.f, 0.f, 0.f};
    }
    bf16x8 At[4][2], B0[2][2], B1[2][2];
    const char* cA = (const char*)g.A + (size_t)cur.pm * tstep; const char* cB = (const char*)g.Bt + (size_t)cur.pn * tstep;
    S.a_ready(cur);
    if constexpr (SP2) {
        PG8_STAGE(PG8_SB(0, 0), cB, voffB); PG8_STAGE(PG8_SB(0, 1), cB + hstep, voffB); PG8_STAGE(PG8_SA(0, 0), cA, voffA); PG8_STAGE(PG8_SA(0, 1), cA + hstep, voffA);
        if (wr == 1) PG8_BAR;
        PG8_WAIT_V(2); PG8_BAR;
        PG8_STAGE(PG8_SB(1, 0), cB + kstep, voffB); PG8_STAGE(PG8_SA(1, 0), cA + kstep, voffA); PG8_STAGE(PG8_SB(1, 1), cB + hstep + kstep, voffB);
        PG8_WAIT_V(6); PG8_BAR;
    } else {
        PG8_STAGE(PG8_SB(0, 0), cB, voffB); PG8_STAGE(PG8_SA(0, 0), cA, voffA); PG8_STAGE(PG8_SB(0, 1), cB + hstep, voffB); PG8_STAGE(PG8_SA(0, 1), cA + hstep, voffA);
        if (wr == 1) PG8_BAR;
        PG8_WAIT_V(4); PG8_BAR;
        PG8_STAGE(PG8_SB(1, 0), cB + kstep, voffB); PG8_STAGE(PG8_SA(1, 0), cA + kstep, voffA); PG8_STAGE(PG8_SB(1, 1), cB + hstep + kstep, voffB);
        PG8_WAIT_V(6); PG8_BAR;
    }
    for (;;) {
        const bool has_next = S.next(ui + 1, nxt);
        const char* nA = has_next ? (const char*)g.A + (size_t)nxt.pm * tstep : cA; const char* nB = has_next ? (const char*)g.Bt + (size_t)nxt.pn * tstep : cB;
        for (int t = 0; t < nt; t += 2) {
            const bool last = (t == nt - 2);
            const char* a1 = cA + (size_t)(t + 1) * kstep;
            const char* a2 = last ? nA : cA + (size_t)(t + 2) * kstep; const char* b2 = last ? nB : cB + (size_t)(t + 2) * kstep;
            const char* a3 = a2 + kstep; const char* b3 = b2 + kstep;
            if (last && has_next) S.a_ready(nxt);
            if constexpr (SP2) {
            PG8_LDB(B0, 0, 0); PG8_LDB(B1, 0, 1); PG8_SCHED; PG8_LDA(At, 0, 0); PG8_STAGE(PG8_SA(1, 1), a1 + hstep, voffA);
            PG8_WAIT_V(8); PG8_WAIT_L(0); PG8_BAR; PG8_MMA(0, 0, At, B0); PG8_MMA(0, 1, At, B1); PG8_BAR; PG8_SCHED;
            PG8_LDA(At, 0, 1); PG8_STAGE(PG8_SB(0, 0), b2, voffB); PG8_STAGE(PG8_SB(0, 1), b2 + hstep, voffB); PG8_STAGE(PG8_SA(0, 0), a2, voffA);
            PG8_WAIT_V(8); PG8_WAIT_L(0); PG8_BAR; PG8_MMA(1, 0, At, B0); PG8_MMA(1, 1, At, B1); PG8_BAR; PG8_SCHED;
            PG8_LDB(B0, 1, 0); PG8_LDB(B1, 1, 1); PG8_SCHED; PG8_LDA(At, 1, 0); PG8_STAGE(PG8_SA(0, 1), a2 + hstep, voffA);
            PG8_WAIT_V(8); PG8_WAIT_L(0); PG8_BAR; PG8_MMA(0, 0, At, B0); PG8_MMA(0, 1, At, B1); PG8_BAR; PG8_SCHED;
            PG8_LDA(At, 1, 1); PG8_STAGE(PG8_SB(1, 0), b3, voffB); PG8_STAGE(PG8_SB(1, 1), b3 + hstep, voffB); PG8_STAGE(PG8_SA(1, 0), a3, voffA);
            PG8_WAIT_V(8); PG8_WAIT_L(0); PG8_BAR; PG8_MMA(1, 0, At, B0); PG8_MMA(1, 1, At, B1); PG8_BAR; PG8_SCHED;
            } else {
            PG8_LDB(B0, 0, 0); PG8_SCHED; PG8_LDA(At, 0, 0); PG8_STAGE(PG8_SA(1, 1), a1 + hstep, voffA);
            PG8_WAIT_L(8); PG8_BAR; PG8_WAIT_L(0); PG8_MMA(0, 0, At, B0); PG8_BAR; PG8_SCHED;
            PG8_LDB(B1, 0, 1); PG8_STAGE(PG8_SB(0, 0), b2, voffB);
            PG8_BAR; PG8_WAIT_L(0); PG8_MMA(0, 1, At, B1); PG8_BAR;
            PG8_LDA(At, 0, 1); PG8_STAGE(PG8_SA(0, 0), a2, voffA);
            PG8_BAR; PG8_WAIT_L(0); PG8_MMA(1, 0, At, B0); PG8_BAR; PG8_SCHED;
            PG8_STAGE(PG8_SB(0, 1), b2 + hstep, voffB);
            PG8_WAIT_V(6); PG8_BAR; PG8_MMA(1, 1, At, B1); PG8_BAR;
            PG8_LDB(B0, 1, 0); PG8_SCHED; PG8_LDA(At, 1, 0); PG8_STAGE(PG8_SA(0, 1), a2 + hstep, voffA);
            PG8_WAIT_L(8); PG8_BAR; PG8_WAIT_L(0); PG8_MMA(0, 0, At, B0); PG8_BAR; PG8_SCHED;
            PG8_LDB(B1, 1, 1); PG8_STAGE(PG8_SB(1, 0), b3, voffB);
            PG8_BAR; PG8_WAIT_L(0); PG8_MMA(0, 1, At, B1); PG8_BAR;
            PG8_LDA(At, 1, 1); PG8_STAGE(PG8_SA(1, 0), a3, voffA);
            PG8_BAR; PG8_WAIT_L(0); PG8_MMA(1, 0, At, B0); PG8_BAR; PG8_SCHED;
            PG8_STAGE(PG8_SB(1, 1), b3 + hstep, voffB);
            PG8_WAIT_V(6); PG8_BAR; PG8_MMA(1, 1, At, B1); PG8_BAR;
            }
        }
        if constexpr (ALIGN_EPI) { if (wr == 0) PG8_BAR; }
        if constexpr (!Epi::AFTER_DRAIN) { E(acc, cur, wr, wc, fr, fq); S.done(cur); }
        if (!has_next) break;
        if constexpr (PRE) E.init(acc, nxt, wr, wc, fr, fq);
        else {
#pragma unroll
        for (int a = 0; a < 2; ++a)
#pragma unroll
            for (int b = 0; b < 2; ++b)
#pragma unroll
                for (int m = 0; m < 4; ++m)
#pragma unroll
                    for (int n = 0; n < 2; ++n) acc[a][b][m][n] = (f32x4){0.f, 0.f, 0.f, 0.f};
        }
        cur = nxt; cA = nA; cB = nB; ++ui;
        if constexpr (ALIGN_EPI) { if (wr == 1) PG8_BAR; }
    }
    PG8_WAIT_V(0);
    if constexpr (!ALIGN_EPI) { if (wr == 0) PG8_BAR; }
    PG8_BAR;
    if constexpr (Epi::AFTER_DRAIN) { E.fused(acc, cur, wr, wc, fr, fq, lds, wid, lane); S.done(cur); }
#undef PG8_SA
#undef PG8_SB
#undef PG8_STAGE
#undef PG8_LDA
#undef PG8_LDB
#undef PG8_MMA
#undef PG8_WAIT_V
#undef PG8_WAIT_L
#undef PG8_BAR
#undef PG8_SCHED
}
template <class Epi, class Sched, bool ALIGN_EPI = false, bool SP2 = false>
__device__ __forceinline__ void gemm_phase(PG8_LAS unsigned char* lds, const Gemm g, const Sched& S, const Epi& E) { f32x4 acc[2][2][4][2]; gemm_phase_acc<Epi, Sched, ALIGN_EPI, SP2, false>(lds, g, S, E, acc); }
}
#ifndef REP_P5
#define REP_P5 1
#endif
#ifndef REP_P0
#define REP_P0 1
#endif
#ifndef REP_P1
#define REP_P1 1
#endif
#ifndef REP_P4
#define REP_P4 1
#endif
#ifndef REP_P0B
#define REP_P0B 1
#endif
#ifndef REP_P0C
#define REP_P0C 1
#endif
#ifndef REP_P2
#define REP_P2 1
#endif
constexpr int T = 8192, D = 2048, NIN = 3328, SEQ = 2048, NE = 16384;
constexpr float EPS = 1e-6f;
constexpr int NWAVES = 8, NTHR = 512;
constexpr size_t MiB = 1u << 20;
constexpr size_t WS_CTL = 0, CTL_ZERO_BYTES = 1 * MiB;
constexpr size_t WS_WIN = 2 * MiB;
constexpr size_t WS_WOUT = 16 * MiB;
constexpr size_t WS_WEFF = 24 * MiB;
constexpr size_t WS_H = 32 * MiB;
constexpr size_t WS_Z = 64 * MiB;
constexpr size_t WS_MIX = 116 * MiB;
constexpr size_t WS_X1 = 148 * MiB;
constexpr size_t WS_SC = 212 * MiB;
constexpr size_t WS_ED = 284 * MiB;
constexpr size_t WS_EU = 316 * MiB;
constexpr int ROWB = 1536;
constexpr size_t WS_SD = 348 * MiB;
constexpr size_t WS_SU = 348 * MiB + 65536;
constexpr size_t WS_TP = 348 * MiB + 196608;
constexpr size_t WS_END = 349 * MiB;
constexpr int CW_TMO = 0, CW_BAR = 4096;
constexpr int RING_OFF = 0, RING_BYTES = 131072;
constexpr int LDSCTL_OFF = RING_BYTES, MISC_OFF = LDSCTL_OFF + 320;
constexpr int LDS_BYTES = 163840;

#define GAS __attribute__((address_space(1)))
#define LAS __attribute__((address_space(3)))
typedef unsigned short bf16;
typedef unsigned v4u __attribute__((ext_vector_type(4)));
typedef unsigned v2u __attribute__((ext_vector_type(2)));
typedef float f32x4 __attribute__((ext_vector_type(4)));
typedef GAS unsigned gu32;
#define LDS_WAIT() asm volatile("s_waitcnt lgkmcnt(0)" ::: "memory")
#define VM_WAIT() asm volatile("s_waitcnt vmcnt(0)" ::: "memory")
__device__ __forceinline__ unsigned f2bf(float f) { unsigned u = __builtin_bit_cast(unsigned, f); return (u + 0x7fffu + ((u >> 16) & 1u)) >> 16; }
__device__ __forceinline__ unsigned pk2(float lo, float hi) { return f2bf(lo) | (f2bf(hi) << 16); }
__device__ __forceinline__ float bf2f(bf16 h) { return __uint_as_float(((unsigned)h) << 16); }
__device__ __forceinline__ float bflo(unsigned w) { return __uint_as_float(w << 16); }
__device__ __forceinline__ float bfhi(unsigned w) { return __uint_as_float(w & 0xffff0000u); }
__device__ __forceinline__ float gelu_erf(float v) { return 0.5f * v * (1.0f + erff(v * 0.70710678118654752f)); }
__device__ __forceinline__ float wave_sum(float v) {
#pragma unroll
    for (int o = 1; o < 64; o <<= 1) v += __shfl_xor(v, o);
    return v;
}

#define XB_TMO      128
#define XB_XCNT(j)  (256  + 64 * (j))
#define XB_XSUB(j)  (1280 + 64 * (j))
#define XB_XGEN(j)  (2304 + 64 * (j))
#define XB_TOP      3328
#define XB_TOPGEN   3392
#define XCD_BAR_WORDS 3456
#define XB_SPIN_CAP (1u << 18)

__device__ __forceinline__ unsigned xb_ld(unsigned* p)              { return __hip_atomic_load(p, __ATOMIC_RELAXED, __HIP_MEMORY_SCOPE_AGENT); }
__device__ __forceinline__ unsigned xb_add(unsigned* p, unsigned v) { return __hip_atomic_fetch_add(p, v, __ATOMIC_RELAXED, __HIP_MEMORY_SCOPE_AGENT); }
__device__ __forceinline__ unsigned xb_xcc_id() { return (unsigned)__builtin_amdgcn_s_getreg((3 << 11) | 20) & 0xFu; }
#define XB_SPIN(cond, bar) do { unsigned _sp = 0; while (cond) { __builtin_amdgcn_s_sleep(1); \
    if ((++_sp & 255u) == 0u) { if (xb_ld(&(bar)[XB_TMO])) break; if (_sp > XB_SPIN_CAP) { atomicAdd(&(bar)[XB_TMO], 1u); break; } } } } while (0)

struct XcdBarrier {
    unsigned* bar; unsigned x;
    volatile LAS unsigned* st;
};

__device__ __forceinline__ XcdBarrier xcd_barrier_post(unsigned* bar, volatile LAS unsigned* st) {
    XcdBarrier b; b.bar = bar; b.x = xb_xcc_id(); b.st = st;
    if (threadIdx.x == 0) (void)xb_add(&bar[XB_XCNT(b.x)], 1u);
    return b;
}
__device__ __forceinline__ void xcd_barrier_complete(unsigned* bar, unsigned x, unsigned& nloc, unsigned& nx) {
    const unsigned G = gridDim.x * gridDim.y * gridDim.z;
    unsigned sum, cnt, mine, sp = 0u;
    for (;;) {
        sum = 0u; cnt = 0u; mine = 0u;
#pragma unroll
        for (unsigned j = 0; j < 16; ++j) { const unsigned c = xb_ld(&bar[XB_XCNT(j)]); sum += c; cnt += (c > 0u) ? 1u : 0u; mine = (j == x) ? c : mine; }
        if (sum == G) break;
        __builtin_amdgcn_s_sleep(1);
        if ((++sp & 255u) == 0u) { if (xb_ld(&bar[XB_TMO])) break; if (sp > XB_SPIN_CAP) { atomicAdd(&bar[XB_TMO], 1u); break; } }
    }
    nloc = mine > 0u ? mine : 1u; nx = cnt > 0u ? cnt : 1u;
}

__device__ __forceinline__ void xcd_barrier_t0(const XcdBarrier& b) {
    {
        unsigned* bar = b.bar;
        __builtin_amdgcn_s_waitcnt(0);
        unsigned nloc = b.st[0], nx = b.st[1];
        if (nloc == 0u) { xcd_barrier_complete(bar, b.x, nloc, nx); b.st[0] = nloc; b.st[1] = nx; }
        const unsigned old = xb_add(&bar[XB_XSUB(b.x)], 1u);
        const unsigned gen = old / nloc;
        if (old + 1u == (gen + 1u) * nloc) {
            __builtin_amdgcn_fence(__ATOMIC_RELEASE, "agent");
            asm volatile("s_waitcnt vmcnt(0)" ::: "memory");
            const unsigned og = xb_add(&bar[XB_TOP], 1u);
            const unsigned tg = og / nx;
            if (og + 1u == (tg + 1u) * nx) xb_add(&bar[XB_TOPGEN], 1u);
            else XB_SPIN(xb_ld(&bar[XB_TOPGEN]) == tg, bar);
            __builtin_amdgcn_fence(__ATOMIC_ACQUIRE, "agent");
            xb_add(&bar[XB_XGEN(b.x)], 1u);
            asm volatile("s_waitcnt vmcnt(0)" ::: "memory");
        } else {
            XB_SPIN(xb_ld(&bar[XB_XGEN(b.x)]) == gen, bar);
            __builtin_amdgcn_fence(__ATOMIC_ACQUIRE, "agent");
            asm volatile("s_waitcnt vmcnt(0)" ::: "memory");
        }
    }
}
__device__ __forceinline__ void xcd_barrier(const XcdBarrier& b) {
    asm volatile("s_waitcnt vmcnt(0)" ::: "memory");
    __syncthreads();
    if (threadIdx.x == 0) xcd_barrier_t0(b);
    __syncthreads();
}
template <class Pre> __device__ __forceinline__ void xcd_barrier_pre(const XcdBarrier& b, const Pre& pre) {
    asm volatile("s_waitcnt vmcnt(0)" ::: "memory");
    __syncthreads();
    const int w_ = __builtin_amdgcn_readfirstlane((int)threadIdx.x >> 6);
    if (w_ != 0) pre();
    if (threadIdx.x == 0) xcd_barrier_t0(b);
    __syncthreads();
    if (w_ == 0) pre();
}

struct Ctx { LAS unsigned char* lds; int tid, lane, wave, G, bid; };

__device__ __forceinline__ void p0_transpose_item(const float* W, int K, int N, bf16* WT, LAS float* scr, int item, int lane) {
    const int nblk = N / 32, kb = item / nblk, nb = item % nblk, k0 = 64 * kb, n0 = 32 * nb;
    float wv[32];
#pragma unroll
    for (int i = 0; i < 32; ++i) wv[i] = W[(size_t)(k0 + 2 * i + (lane >> 5)) * N + n0 + (lane & 31)];
#pragma unroll
    for (int i = 0; i < 32; ++i) scr[(2 * i + (lane >> 5)) * 33 + (lane & 31)] = wv[i];
    LDS_WAIT(); asm volatile("" ::: "memory");
    const int c = lane & 7;
#pragma unroll
    for (int j = 0; j < 4; ++j) { const int n = (lane >> 3) + 8 * j; const LAS float* s = scr + (8 * c) * 33 + n;
        v4u o; o.x = pk2(s[0 * 33], s[1 * 33]); o.y = pk2(s[2 * 33], s[3 * 33]); o.z = pk2(s[4 * 33], s[5 * 33]); o.w = pk2(s[6 * 33], s[7 * 33]);
        *(v4u*)(WT + (size_t)(n0 + n) * K + k0 + 8 * c) = o; }
    LDS_WAIT(); asm volatile("" ::: "memory");
}
__device__ __forceinline__ void rms_row_to_bf16(const float* xr, const float* g, bf16* orow, int lane) {
    f32x4 v[8]; float s = 0.f;
#pragma unroll
    for (int j = 0; j < 8; ++j) { v[j] = *(const f32x4*)(xr + j * 256 + lane * 4); s += (v[j].x * v[j].x + v[j].y * v[j].y) + (v[j].z * v[j].z + v[j].w * v[j].w); }
    const float r = rsqrtf(wave_sum(s) * (1.f / D) + EPS);
#pragma unroll
    for (int j = 0; j < 8; ++j) { const f32x4 gg = *(const f32x4*)(g + j * 256 + lane * 4);
        v2u o; o.x = pk2(v[j].x * r * gg.x, v[j].y * r * gg.y); o.y = pk2(v[j].z * r * gg.z, v[j].w * r * gg.w);
        *(v2u*)(orow + j * 256 + lane * 4) = o; }
}
typedef float f32x2 __attribute__((ext_vector_type(2)));
typedef __bf16 bf16x2v __attribute__((ext_vector_type(2)));
__device__ __forceinline__ unsigned cvtpk(float lo, float hi) { const f32x2 v = {lo, hi}; return __builtin_bit_cast(unsigned, __builtin_convertvector(v, bf16x2v)); }
typedef short bf16x8 __attribute__((ext_vector_type(8)));
typedef float f32x16 __attribute__((ext_vector_type(16)));
__device__ __forceinline__ bf16x8 pack8(float a0, float a1, float a2, float a3, float a4, float a5, float a6, float a7) {
    v4u w; w.x = cvtpk(a0, a1); w.y = cvtpk(a2, a3); w.z = cvtpk(a4, a5); w.w = cvtpk(a6, a7); return __builtin_bit_cast(bf16x8, w); }
__device__ __forceinline__ void split8(const f32x4 a0, const f32x4 a1, bf16x8& hi, bf16x8& lo) {
    hi = pack8(a0[0], a0[1], a0[2], a0[3], a1[0], a1[1], a1[2], a1[3]);
    const v4u w = __builtin_bit_cast(v4u, hi);
    lo = pack8(a0[0] - bflo(w[0]), a0[1] - bfhi(w[0]), a0[2] - bflo(w[1]), a0[3] - bfhi(w[1]), a1[0] - bflo(w[2]), a1[1] - bfhi(w[2]), a1[2] - bflo(w[3]), a1[3] - bfhi(w[3]));
}
typedef __bf16 bf16x32 __attribute__((ext_vector_type(32)));
typedef unsigned v6u __attribute__((ext_vector_type(6)));
typedef float f32x32 __attribute__((ext_vector_type(32)));
__device__ __forceinline__ void p0_rows_to_fp6(const float* ra, const float* rb, unsigned char* da, unsigned char* db, float* ia, float* ib, int lane) {
    f32x4 va[8], vb[8]; float ma = 0.f, mb = 0.f;
#pragma unroll
    for (int i = 0; i < 8; ++i) { va[i] = __builtin_nontemporal_load((const f32x4*)(ra + i * 256 + lane * 4)); vb[i] = __builtin_nontemporal_load((const f32x4*)(rb + i * 256 + lane * 4)); }
#pragma unroll
    for (int i = 0; i < 8; ++i) { const f32x4 t = va[i], u = vb[i];
        ma = fmaxf(fmaxf(ma, fmaxf(fabsf(t.x), fabsf(t.y))), fmaxf(fabsf(t.z), fabsf(t.w))); mb = fmaxf(fmaxf(mb, fmaxf(fabsf(u.x), fabsf(u.y))), fmaxf(fabsf(u.z), fabsf(u.w))); }
#pragma unroll
    for (int o = 1; o < 64; o <<= 1) { ma = fmaxf(ma, __shfl_xor(ma, o)); mb = fmaxf(mb, __shfl_xor(mb, o)); }
    const float sa = ma > 0.f ? 7.f / ma : 0.f, sb = mb > 0.f ? 7.f / mb : 0.f;
    bf16x32 xa, xb;
#pragma unroll
    for (int k = 0; k < 32; ++k) { xa[k] = (__bf16)(va[k >> 2][k & 3] * sa); xb[k] = (__bf16)(vb[k >> 2][k & 3] * sb); }
    const v6u pa = __builtin_amdgcn_cvt_scalef32_pk32_fp6_bf16(xa, 1.0f), pb = __builtin_amdgcn_cvt_scalef32_pk32_fp6_bf16(xb, 1.0f);
#pragma unroll
    for (int q = 0; q < 3; ++q) { *(v2u*)(da + 24 * lane + 8 * q) = (v2u){pa[2 * q], pa[2 * q + 1]}; *(v2u*)(db + 24 * lane + 8 * q) = (v2u){pb[2 * q], pb[2 * q + 1]}; }
    if (lane == 0) { *ia = ma * (1.f / 7.f); *ib = mb * (1.f / 7.f); }
}
constexpr int CONV_SPLIT = 12800;
__device__ __forceinline__ void convert_rows(const float* e_down, const float* e_up, unsigned char* ED, unsigned char* EU, float* SD, float* SU, int r_lo, int r_hi, int w, int nw, int lane) {
    for (int r = r_lo + 2 * w; r < r_hi; r += 2 * nw) {
        const bool up = r >= NE; const int row = up ? r - NE : r;
        const float* s = (up ? e_up : e_down) + (size_t)row * D; unsigned char* d = (up ? EU : ED) + (size_t)row * ROWB; float* iv = (up ? SU : SD) + row;
        p0_rows_to_fp6(s, s + D, d, d + ROWB, iv, iv + 1, lane);
    }
}
__device__ __forceinline__ void p0_prologue(const Ctx& F, const float* x, const float* g1, const float* w_in, const float* w_out, const float* wq, const float* sk,
                                            const float* e_down, const float* e_up, bf16* WinT, bf16* WoutT, bf16* WeffT, bf16* H, unsigned char* ED, unsigned char* EU, float* SD, float* SU, const float* g2) {
    const int gw = F.bid * NWAVES + F.wave, NGW = F.G * NWAVES;
#if defined(TP_PHASE) && TP_PHASE == 12
    volatile unsigned long long* tsp12 = (volatile unsigned long long*)((unsigned char*)SD + 196608);
    if (F.bid == 0 && F.tid == 0) tsp12[0] = wall_clock64();
#endif
    for (int ph = 0; ph < 2; ++ph) {
    if ((ph == 0) == (((F.bid >> 3) & 1) == 0)) {
    {
        LAS float* scr = (LAS float*)(F.lds + RING_OFF + F.wave * 16384);
        constexpr int I_IN = (D / 64) * (NIN / 32), I_OUT = (D / 64) * (D / 32);
        for (int it = gw; it < I_IN + I_OUT; it += NGW) {
            if (it < I_IN) p0_transpose_item(w_in, D, NIN, WinT, scr, it, F.lane);
            else p0_transpose_item(w_out, D, D, WoutT, scr, it - I_IN, F.lane);
        }
    }
    __syncthreads();
    for (int it = gw; it < 16 * 64 * 2; it += NGW) {
        const int g = it & 15, dtile = (it >> 4) & 63, kh = it >> 10, p = g & 1, c = F.lane & 31, h = F.lane >> 5;
        const float* arow = wq + (size_t)(dtile * 32 + c) * 2048 + g * 128 + 8 * h;
        bf16x8 ah[8], al[8];
#pragma unroll
        for (int ks = 0; ks < 8; ++ks) { const f32x4 a0 = *(const f32x4*)(arow + 16 * ks), a1 = *(const f32x4*)(arow + 16 * ks + 4); split8(a0, a1, ah[ks], al[ks]); }
#pragma unroll 1
        for (int kt = 0; kt < 2; ++kt) {
            const int k0 = (kh * 2 + kt) * 32;
            const float* brow = sk + (size_t)(p * 128 + k0 + c) * 128 + 8 * h;
            f32x16 acc;
#pragma unroll
            for (int i = 0; i < 16; ++i) acc[i] = 0.f;
#pragma unroll
            for (int ks = 0; ks < 8; ++ks) { const f32x4 b0 = *(const f32x4*)(brow + 16 * ks), b1 = *(const f32x4*)(brow + 16 * ks + 4); bf16x8 bh, bl; split8(b0, b1, bh, bl);
                acc = __builtin_amdgcn_mfma_f32_32x32x16_bf16(al[ks], bh, acc, 0, 0, 0); acc = __builtin_amdgcn_mfma_f32_32x32x16_bf16(ah[ks], bl, acc, 0, 0, 0);
                acc = __builtin_amdgcn_mfma_f32_32x32x16_bf16(ah[ks], bh, acc, 0, 0, 0); }
            bf16* orow = WeffT + (size_t)(g * 128 + k0 + c) * 2048 + dtile * 32 + 4 * h;
#pragma unroll
            for (int q = 0; q < 4; ++q) { const f32x4 gq = *(const f32x4*)(g2 + dtile * 32 + 4 * h + 8 * q);
                v2u o; o.x = cvtpk(acc[4 * q] * gq[0], acc[4 * q + 1] * gq[1]); o.y = cvtpk(acc[4 * q + 2] * gq[2], acc[4 * q + 3] * gq[3]); *(v2u*)(orow + 8 * q) = o; }
        }
    }
#if defined(TP_PHASE) && TP_PHASE == 12
    __syncthreads(); if (F.bid == 0 && F.tid == 0) tsp12[1] = wall_clock64() - tsp12[0];
#endif
    } else {
    for (int rep_ = 0; rep_ < REP_P0C; ++rep_) convert_rows(e_down, e_up, ED, EU, SD, SU, 0, CONV_SPLIT, gw, NGW, F.lane);
    for (int m = gw; m < T; m += NGW) rms_row_to_bf16(x + (size_t)m * D, g1, H + (size_t)m * D, F.lane);
    }
    }
}

constexpr int SGU_VS = 136;
__device__ __forceinline__ void p2_sgu(const Ctx& F, const bf16* Z, const float* ln_g, const float* ln_b, const float* w_s, const float* b_s, bf16* MIX) {
    LAS bf16* vnT = (LAS bf16*)(F.lds + RING_OFF);
    LAS float* ps = (LAS float*)(F.lds + RING_OFF + 128 * SGU_VS * 2);
    LAS float* pq = ps + 512;
    const int s = F.tid & 127, dq = F.tid >> 7;
    const int c = F.lane & 31, h = F.lane >> 5, tt = F.wave >> 1;
    for (int unit = F.bid; unit < 512; unit += F.G) {
        const int g = unit & 7, t0 = (unit >> 3) * 128;
        __syncthreads();
        float v[32];
        { const bf16* vr = Z + (size_t)(t0 + s) * NIN + 1024 + g * 128 + dq * 32;
#pragma unroll
          for (int j = 0; j < 4; ++j) { const v4u q = *(const v4u*)(vr + 8 * j);
#pragma unroll
              for (int e = 0; e < 4; ++e) { v[8 * j + 2 * e] = bflo(q[e]); v[8 * j + 2 * e + 1] = bfhi(q[e]); } } }
        float sm = 0.f;
#pragma unroll
        for (int j = 0; j < 32; ++j) sm += v[j];
        ps[dq * 128 + s] = sm;
        __syncthreads();
        const float mean = (ps[s] + ps[128 + s] + ps[256 + s] + ps[384 + s]) * (1.f / 128.f);
        float sq = 0.f;
#pragma unroll
        for (int j = 0; j < 32; ++j) { v[j] -= mean; sq += v[j] * v[j]; }
        pq[dq * 128 + s] = sq;
        __syncthreads();
        const float rstd = rsqrtf((pq[s] + pq[128 + s] + pq[256 + s] + pq[384 + s]) * (1.f / 128.f) + EPS);
#pragma unroll
        for (int j = 0; j < 32; ++j) { const int d = dq * 32 + j; vnT[d * SGU_VS + s] = (bf16)f2bf(v[j] * rstd * ln_g[g * 128 + d] + ln_b[g * 128 + d]); }
        __syncthreads();
        f32x16 acc[2];
#pragma unroll
        for (int a = 0; a < 2; ++a)
#pragma unroll
            for (int i = 0; i < 16; ++i) acc[a][i] = 0.f;
        const int trow = 32 * tt + c;
        const float* wrow = w_s + ((size_t)g * 128 + trow) * 128;
        const int dt0 = 2 * (F.wave & 1);
        for (int ks = 0; ks < 2 * (tt + 1); ++ks) {
            const int s0 = 16 * ks + 8 * h;
            const f32x4 w0 = *(const f32x4*)(wrow + s0), w1 = *(const f32x4*)(wrow + s0 + 4);
            float w[8] = {w0[0], w0[1], w0[2], w0[3], w1[0], w1[1], w1[2], w1[3]};
#pragma unroll
            for (int j = 0; j < 8; ++j) w[j] = (s0 + j <= trow) ? w[j] : 0.f;
            const bf16x8 bf = pack8(w[0], w[1], w[2], w[3], w[4], w[5], w[6], w[7]);
#pragma unroll
            for (int a = 0; a < 2; ++a) { const bf16x8 af = *(const LAS bf16x8*)(vnT + (32 * (dt0 + a) + c) * SGU_VS + s0);
                acc[a] = __builtin_amdgcn_mfma_f32_32x32x16_bf16(af, bf, acc[a], 0, 0, 0); }
        }
        const float bias = b_s[g * 128 + trow];
        const size_t tok = (size_t)(t0 + trow);
#pragma unroll
        for (int a = 0; a < 2; ++a)
#pragma unroll
            for (int q = 0; q < 4; ++q) { const int d0 = 32 * (dt0 + a) + 8 * q + 4 * h;
                const v2u uu = *(const v2u*)(Z + tok * NIN + g * 128 + d0);
                v2u o; o.x = cvtpk(bflo(uu.x) * (acc[a][4 * q] + bias), bfhi(uu.x) * (acc[a][4 * q + 1] + bias));
                o.y = cvtpk(bflo(uu.y) * (acc[a][4 * q + 2] + bias), bfhi(uu.y) * (acc[a][4 * q + 3] + bias));
                *(v2u*)(MIX + tok * D + g * 128 + d0) = o; }
    }
}
constexpr int ATT_KS = 72, ATT_VS = 264;
__device__ __forceinline__ void p2_attn(const Ctx& F, const bf16* Z, const float* sinks, bf16* MIX) {
    LAS bf16* Ks = (LAS bf16*)(F.lds + RING_OFF);
    LAS bf16* Vt = (LAS bf16*)(F.lds + RING_OFF + 256 * ATT_KS * 2);
    const int c = F.lane & 31, h = F.lane >> 5;
    for (int unit = F.bid; unit < 256; unit += F.G) {
        const int hg = unit & 1, hk = (unit >> 1) & 1, n = (unit >> 2) & 15, b = unit >> 6;
        __syncthreads();
        for (int e = F.tid; e < 256 * 8; e += NTHR) {
            const int j = e >> 3, ch = e & 7, pos = (n - 1) * 128 + j;
            v4u kv = (v4u){0u, 0u, 0u, 0u}, vv = (v4u){0u, 0u, 0u, 0u};
            if (pos >= 0) { const bf16* row = Z + ((size_t)b * SEQ + pos) * NIN; kv = *(const v4u*)(row + 3072 + hk * 64 + ch * 8); vv = *(const v4u*)(row + 3200 + hk * 64 + ch * 8); }
            *(LAS v4u*)(Ks + j * ATT_KS + ch * 8) = kv;
#pragma unroll
            for (int jj = 0; jj < 8; ++jj) Vt[(ch * 8 + jj) * ATT_VS + j] = (bf16)((vv[jj >> 1] >> (16 * (jj & 1))) & 0xffffu);
        }
        __syncthreads();
        for (int tk = 0; tk < 2; ++tk) {
            const int hq = hk * 8 + hg * 4 + (F.wave >> 1), i0 = 32 * (2 * (F.wave & 1) + tk);
            const size_t tok = (size_t)b * SEQ + n * 128 + i0 + c;
            const bf16* qrow = Z + tok * NIN + 2048 + hq * 64;
            bf16x8 qf[4];
#pragma unroll
            for (int ks = 0; ks < 4; ++ks) qf[ks] = *(const bf16x8*)(qrow + 16 * ks + 8 * h);
            f32x16 sT[5];
#pragma unroll
            for (int kt = 0; kt < 5; ++kt) {
#pragma unroll
                for (int i = 0; i < 16; ++i) sT[kt][i] = 0.f;
#pragma unroll
                for (int ks = 0; ks < 4; ++ks) { const bf16x8 kf = *(const LAS bf16x8*)(Ks + (i0 + 32 * kt + c) * ATT_KS + 16 * ks + 8 * h);
                    sT[kt] = __builtin_amdgcn_mfma_f32_32x32x16_bf16(kf, qf[ks], sT[kt], 0, 0, 0); }
            }
            const float sink = sinks[hq]; float m = sink;
#pragma unroll
            for (int kt = 0; kt < 5; ++kt) {
                const bool tile_ok = (n > 0) || (i0 + 32 * kt >= 128);
#pragma unroll
                for (int i = 0; i < 16; ++i) { const int jj = (i & 3) + 8 * (i >> 2) + 4 * h;
                    bool ok = tile_ok; if (kt == 0) ok = ok && (jj > c); if (kt == 4) ok = ok && (jj <= c);
                    const float x = ok ? sT[kt][i] * 0.125f : -INFINITY; sT[kt][i] = x; m = fmaxf(m, x); }
            }
            m = fmaxf(m, __shfl_xor(m, 32));
            float l = 0.f;
#pragma unroll
            for (int kt = 0; kt < 5; ++kt)
#pragma unroll
                for (int i = 0; i < 16; ++i) { const float p = __expf(sT[kt][i] - m); sT[kt][i] = p; l += p; }
            l += __shfl_xor(l, 32); l += __expf(sink - m);
            f32x16 o[2];
#pragma unroll
            for (int a = 0; a < 2; ++a)
#pragma unroll
                for (int i = 0; i < 16; ++i) o[a][i] = 0.f;
#pragma unroll
            for (int kt = 0; kt < 5; ++kt)
#pragma unroll
                for (int st = 0; st < 2; ++st) {
                    const bf16x8 pf = pack8(sT[kt][8 * st], sT[kt][8 * st + 1], sT[kt][8 * st + 2], sT[kt][8 * st + 3], sT[kt][8 * st + 4], sT[kt][8 * st + 5], sT[kt][8 * st + 6], sT[kt][8 * st + 7]);
                    const int key0 = i0 + 32 * kt + 16 * st + 4 * h;
#pragma unroll
                    for (int a = 0; a < 2; ++a) { const LAS bf16* vp = Vt + (32 * a + c) * ATT_VS + key0;
                        const v2u lo = *(const LAS v2u*)vp, hi = *(const LAS v2u*)(vp + 8);
                        const v4u vw = (v4u){lo.x, lo.y, hi.x, hi.y};
                        o[a] = __builtin_amdgcn_mfma_f32_32x32x16_bf16(__builtin_bit_cast(bf16x8, vw), pf, o[a], 0, 0, 0); }
                }
            const float inv = 1.f / l;
#pragma unroll
            for (int a = 0; a < 2; ++a)
#pragma unroll
                for (int q = 0; q < 4; ++q) { const int d0 = 32 * a + 8 * q + 4 * h;
                    v2u w; w.x = cvtpk(o[a][4 * q] * inv, o[a][4 * q + 1] * inv); w.y = cvtpk(o[a][4 * q + 2] * inv, o[a][4 * q + 3] * inv);
                    *(v2u*)(MIX + tok * D + 1024 + hq * 64 + d0) = w; }
        }
    }
}

typedef __bf16 bf16x2_t __attribute__((ext_vector_type(2)));
constexpr int P5_TOK = 32;
constexpr int P5_WL = 2048;
__device__ __forceinline__ unsigned fkey(float f) { const unsigned u = __float_as_uint(f); return (u & 0x80000000u) ? ~u : (u | 0x80000000u); }
__device__ __forceinline__ float dot2bf(unsigned a, unsigned b, float c) { return __builtin_amdgcn_fdot2_f32_bf16(__builtin_bit_cast(bf16x2_t, a), __builtin_bit_cast(bf16x2_t, b), c, false); }
template <int CTRL, int RM, bool BC> __device__ __forceinline__ float dpp_f(float v) { return __builtin_bit_cast(float, __builtin_amdgcn_update_dpp(0, __builtin_bit_cast(int, v), CTRL, RM, 0xf, BC)); }
struct WaveLds { LAS int* eid; LAS float* gate; LAS float* sv; LAS float* tv; LAS int* ti; LAS int* ctab; };
template <int CTRL> __device__ __forceinline__ unsigned dppx_u(unsigned v) { return (unsigned)__builtin_amdgcn_update_dpp(0, (int)v, CTRL, 0xf, 0xf, true); }
template <int CTRL> __device__ __forceinline__ float dppx_f(float v) { return __builtin_bit_cast(float, __builtin_amdgcn_update_dpp(0, __builtin_bit_cast(int, v), CTRL, 0xf, 0xf, true)); }
__device__ __forceinline__ unsigned umax(unsigned a, unsigned b) { return a > b ? a : b; }
__device__ __forceinline__ unsigned umin(unsigned a, unsigned b) { return a < b ? a : b; }
__device__ __forceinline__ unsigned row_allmax_u(unsigned m) {
    m = umax(m, dppx_u<0xB1>(m)); m = umax(m, dppx_u<0x4E>(m)); m = umax(m, dppx_u<0x141>(m)); m = umax(m, dppx_u<0x140>(m)); return m; }
__device__ __forceinline__ float row_allmax_f(float m) { m = fmaxf(m, dppx_f<0xB1>(m)); m = fmaxf(m, dppx_f<0x4E>(m)); m = fmaxf(m, dppx_f<0x141>(m)); m = fmaxf(m, dppx_f<0x140>(m)); return m; }
__device__ __forceinline__ float row_allsum_f(float m) { m += dppx_f<0xB1>(m); m += dppx_f<0x4E>(m); m += dppx_f<0x141>(m); m += dppx_f<0x140>(m); return m; }
#define P5_CE(a, b) do { const unsigned _h = umax(a, b), _l = umin(a, b); a = _h; b = _l; } while (0)
__device__ __forceinline__ int cand_pair(int c) {
    return c < 16 ? c : c < 24 ? (1 << 4) | (c - 16) : c < 29 ? (2 << 4) | (c - 24) : c < 33 ? (3 << 4) | (c - 29) : c < 36 ? (4 << 4) | (c - 33) : c < 38 ? (5 << 4) | (c - 36)
         : c < 40 ? (6 << 4) | (c - 38) : c < 42 ? (7 << 4) | (c - 40) : c < 50 ? ((c - 34) << 4) : 0xff;
}
__device__ __forceinline__ void p5_topk_fetch(const WaveLds& W, const float* src, int half, int lane) {
#pragma unroll
    for (int i = 0; i < 4; ++i) __builtin_amdgcn_global_load_lds((const unsigned*)(src + i * 256 + lane * 4), (LAS unsigned*)(W.sv + half * 1024 + i * 256), 16, 0, 0);
}
__device__ __forceinline__ void p5_topk_token(const WaveLds& W, const float* sc  , const float* sc_next, float rs  , int lane) {
    const int r = lane >> 4, l15 = lane & 15;
#pragma unroll 1
    for (int pp = 0; pp < 2; ++pp) {
        unsigned k[2][8]; unsigned top[2] = {0u, 0u};
        asm volatile("s_waitcnt vmcnt(0)" ::: "memory");
        { const float* nsrc = pp == 0 ? sc + 1024 : sc_next; if (nsrc != nullptr) p5_topk_fetch(W, nsrc, 1 - pp, lane); }
#pragma unroll
        for (int u = 0; u < 2; ++u) {
            const int L = 4 * (2 * pp + u) + r;
            const f32x4 v0 = *(const LAS f32x4*)(W.sv + L * 128 + 8 * l15) * rs, v1 = *(const LAS f32x4*)(W.sv + L * 128 + 8 * l15 + 4) * rs;
#pragma unroll
            for (int j = 0; j < 4; ++j) { k[u][j] = (fkey(v0[j]) & ~127u) | (unsigned)(127 - (8 * l15 + j)); k[u][4 + j] = (fkey(v1[j]) & ~127u) | (unsigned)(127 - (8 * l15 + 4 + j)); }
            P5_CE(k[u][0], k[u][1]); P5_CE(k[u][2], k[u][3]); P5_CE(k[u][4], k[u][5]); P5_CE(k[u][6], k[u][7]);
            P5_CE(k[u][0], k[u][2]); P5_CE(k[u][1], k[u][3]); P5_CE(k[u][4], k[u][6]); P5_CE(k[u][5], k[u][7]);
            P5_CE(k[u][1], k[u][2]); P5_CE(k[u][5], k[u][6]);
            P5_CE(k[u][0], k[u][4]); P5_CE(k[u][1], k[u][5]); P5_CE(k[u][2], k[u][6]); P5_CE(k[u][3], k[u][7]);
            P5_CE(k[u][2], k[u][4]); P5_CE(k[u][3], k[u][5]);
            P5_CE(k[u][1], k[u][2]); P5_CE(k[u][3], k[u][4]); P5_CE(k[u][5], k[u][6]);
        }
#pragma unroll 4
        for (int it = 0; it < 16; ++it) {
#pragma unroll
            for (int u = 0; u < 2; ++u) {
                const unsigned m = row_allmax_u(k[u][0]); const bool sel = k[u][0] == m;
                top[u] = (l15 == it) ? m : top[u];
#pragma unroll
                for (int j = 0; j < 7; ++j) k[u][j] = sel ? k[u][j + 1] : k[u][j];
                k[u][7] = sel ? 0u : k[u][7];
            }
        }
        LDS_WAIT(); __builtin_amdgcn_wave_barrier();
#pragma unroll
        for (int u = 0; u < 2; ++u) { const int L = 4 * (2 * pp + u) + r; const int idx = 127 - (int)(top[u] & 127u);
            W.tv[L * 16 + l15] = W.sv[L * 128 + idx] * rs; W.ti[L * 16 + l15] = idx; }
    }
    LDS_WAIT(); __builtin_amdgcn_wave_barrier();
    int cij[4];
#pragma unroll
    for (int j = 0; j < 4; ++j) cij[j] = cand_pair(4 * l15 + j);
    unsigned ck[2][4]; unsigned top2[2] = {0u, 0u};
#pragma unroll
    for (int u = 0; u < 2; ++u) {
        const int hd = 4 * u + r; const LAS float* tv0 = W.tv + (2 * hd) * 16; const LAS float* tv1 = tv0 + 16;
#pragma unroll
        for (int j = 0; j < 4; ++j) { const float cs = tv0[(cij[j] >> 4) & 15] + tv1[cij[j] & 15]; const int s = 4 * l15 + j;
            ck[u][j] = (s < 50) ? ((fkey(cs) & ~63u) | (unsigned)(63 - s)) : 0u; }
        P5_CE(ck[u][0], ck[u][1]); P5_CE(ck[u][2], ck[u][3]); P5_CE(ck[u][0], ck[u][2]); P5_CE(ck[u][1], ck[u][3]); P5_CE(ck[u][1], ck[u][2]);
    }
#pragma unroll 4
    for (int it = 0; it < 16; ++it) {
#pragma unroll
        for (int u = 0; u < 2; ++u) {
            const unsigned m = row_allmax_u(ck[u][0]); const bool sel = ck[u][0] == m;
            top2[u] = (l15 == it) ? m : top2[u];
            ck[u][0] = sel ? ck[u][1] : ck[u][0]; ck[u][1] = sel ? ck[u][2] : ck[u][1]; ck[u][2] = sel ? ck[u][3] : ck[u][2]; ck[u][3] = sel ? 0u : ck[u][3];
        }
    }
#pragma unroll
    for (int u = 0; u < 2; ++u) {
        const int hd = 4 * u + r; const LAS float* tv0 = W.tv + (2 * hd) * 16; const LAS float* tv1 = tv0 + 16; const LAS int* ti0 = W.ti + (2 * hd) * 16; const LAS int* ti1 = ti0 + 16;
        const int ij = W.ctab[63 - (int)(top2[u] & 63u)];
        const int i1 = (ij >> 4) & 15, j1 = ij & 15;
        const float vs = tv0[i1] + tv1[j1]; const int e = ti0[i1] * 128 + ti1[j1];
        const float mx = row_allmax_f(vs), ex = __expf(vs - mx), sm = row_allsum_f(ex);
        W.gate[hd * 16 + l15] = ex / sm; W.eid[hd * 16 + l15] = e;
    }
    LDS_WAIT(); __builtin_amdgcn_wave_barrier();
}
constexpr int P5_R = 9;
constexpr int P5_NSL = 8, P5_SLSH = 11;
#ifndef REP_TOPK
#define REP_TOPK 1
#endif
#ifndef REP_DS
#define REP_DS 1
#endif
constexpr int P5_WL2 = 20480;
struct SweepLds { LAS unsigned char* ring; LAS int* feid; LAS float* fcf; LAS float* raw; };
__device__ __forceinline__ int mbcnt64(unsigned long long m) { return __builtin_amdgcn_mbcnt_hi((unsigned)(m >> 32), __builtin_amdgcn_mbcnt_lo((unsigned)m, 0u)); }
template <int CTRL, int RM, bool BC> __device__ __forceinline__ int dpp_i(int v) { return __builtin_amdgcn_update_dpp(0, v, CTRL, RM, 0xf, BC); }
__device__ __forceinline__ float wave_total63(float v) {
    v += dpp_f<0x111, 0xf, true>(v); v += dpp_f<0x112, 0xf, true>(v); v += dpp_f<0x114, 0xf, true>(v); v += dpp_f<0x118, 0xf, true>(v);
    v += dpp_f<0x142, 0xa, false>(v); v += dpp_f<0x143, 0xc, false>(v); return v; }
__device__ __forceinline__ int wave_incl_scan(int v) {
    v += dpp_i<0x111, 0xf, true>(v); v += dpp_i<0x112, 0xf, true>(v); v += dpp_i<0x114, 0xf, true>(v); v += dpp_i<0x118, 0xf, true>(v);
    v += dpp_i<0x142, 0xa, false>(v); v += dpp_i<0x143, 0xc, false>(v); return v; }
#define P5_WRAP(x) ((x) + 1 == P5_R ? 0 : (x) + 1)
#define P5_ISSUE(tab, id_) do { const unsigned char* _gp = (tab) + (size_t)(id_) * ROWB + lane * 16; LAS unsigned char* _lp = L.ring + pslot * ROWB; \
    __builtin_amdgcn_global_load_lds((const unsigned*)_gp, (LAS unsigned*)_lp, 16, 0, 0);                         \
    __builtin_amdgcn_global_load_lds((const unsigned*)_gp, (LAS unsigned*)_lp, 16, 512, 0);                       \
    pslot = P5_WRAP(pslot); } while (0)
#define P5_ROWREAD(dst_, slot_) do { const LAS unsigned char* _rp = L.ring + (slot_) * ROWB + lane * 24; const v2u _a = *(const LAS v2u*)_rp, _b = *(const LAS v2u*)(_rp + 8), _c = *(const LAS v2u*)(_rp + 16); \
    dst_[0] = (int)_a.x; dst_[1] = (int)_a.y; dst_[2] = (int)_b.x; dst_[3] = (int)_b.y; dst_[4] = (int)_c.x; dst_[5] = (int)_c.y; } while (0)
typedef int v8i __attribute__((ext_vector_type(8)));
#define P5_V6(x_) ((v6u){(unsigned)x_[0], (unsigned)x_[1], (unsigned)x_[2], (unsigned)x_[3], (unsigned)x_[4], (unsigned)x_[5]})
#define P5_FEID(i_) __builtin_amdgcn_readfirstlane(L.feid[(i_) > 511 ? 511 : (i_)])
typedef _Float16 f16x32 __attribute__((ext_vector_type(32)));
typedef _Float16 f16x2v __attribute__((ext_vector_type(2)));
__device__ __forceinline__ void wave_total63x2(float& a, float& b) {
    a += dpp_f<0x111, 0xf, true>(a); b += dpp_f<0x111, 0xf, true>(b); a += dpp_f<0x112, 0xf, true>(a); b += dpp_f<0x112, 0xf, true>(b);
    a += dpp_f<0x114, 0xf, true>(a); b += dpp_f<0x114, 0xf, true>(b); a += dpp_f<0x118, 0xf, true>(a); b += dpp_f<0x118, 0xf, true>(b);
    a += dpp_f<0x142, 0xa, false>(a); b += dpp_f<0x142, 0xa, false>(b); a += dpp_f<0x143, 0xc, false>(a); b += dpp_f<0x143, 0xc, false>(b);
}
template <bool UP> __device__ __forceinline__ void p5_sweep(const SweepLds& L, const unsigned char* tab, unsigned (&hp)[4][16], const v8i (&hq)[4], const float (&hinv)[4], int lenv0, int lenv1, int lane) {
    const LAS int* cbits = (const LAS int*)L.fcf;
    int pslot = 0, cslot = 2, idx = 0;
    for (int i = 0; i < P5_R; ++i) { const int id = P5_FEID(i); P5_ISSUE(tab, id); }
    int nv0 = L.feid[P5_R], nv1 = L.feid[P5_R + 1];
    asm volatile("s_waitcnt vmcnt(14)" ::: "memory");
    v8i ra = {0, 0, 0, 0, 0, 0, 0, 0}, rb = {0, 0, 0, 0, 0, 0, 0, 0}; P5_ROWREAD(ra, 0); P5_ROWREAD(rb, 1);
    const bool dg0 = (lane & 3) == 0, dg1 = (lane & 3) == 1, dg2 = (lane & 3) == 2, dgv = ((lane & 15) >> 2) == (lane >> 4);
    int cav = 0, cbv = 0; if (UP) { cav = cbits[0]; cbv = cbits[1]; }
    for (int s = 0; s < P5_NSL; ++s) {
        const int lenv = s < 16 ? lenv0 : lenv1;
#pragma unroll
        for (int tok = 0; tok < 4; ++tok) {
            const int n = __builtin_amdgcn_readlane(lenv, (s & 15) * 4 + tok);
            int i = 0;
            for (; i + 1 < n; i += 2) {
                f16x32 xa, xb; f32x4 ma, mb;
                if (UP) { xa = __builtin_amdgcn_cvt_scalef32_pk32_f16_fp6(P5_V6(ra), 1.0f); xb = __builtin_amdgcn_cvt_scalef32_pk32_f16_fp6(P5_V6(rb), 1.0f); }
                else { const f32x4 z = {0.f, 0.f, 0.f, 0.f};
                    ma = __builtin_amdgcn_mfma_scale_f32_16x16x128_f8f6f4(ra, hq[tok], z, 2  , 2  , 0, 0, 0, 0);
                    mb = __builtin_amdgcn_mfma_scale_f32_16x16x128_f8f6f4(rb, hq[tok], z, 2, 2, 0, 0, 0, 0); }
                const f16x2v ca = __builtin_bit_cast(f16x2v, __builtin_amdgcn_readfirstlane(cav)), cb = __builtin_bit_cast(f16x2v, __builtin_amdgcn_readfirstlane(cbv));
                { const int id0 = __builtin_amdgcn_readfirstlane(nv0), id1 = __builtin_amdgcn_readfirstlane(nv1); P5_ISSUE(tab, id0); P5_ISSUE(tab, id1); }
                nv0 = L.feid[idx + 2 + P5_R > 511 ? 511 : idx + 2 + P5_R]; nv1 = L.feid[idx + 3 + P5_R > 511 ? 511 : idx + 3 + P5_R];
                if (UP) { cav = cbits[idx + 2 > 511 ? 511 : idx + 2]; cbv = cbits[idx + 3 > 511 ? 511 : idx + 3]; }
                asm volatile("s_waitcnt vmcnt(14)" ::: "memory");
                const int cs1 = P5_WRAP(cslot);
                P5_ROWREAD(ra, cslot); P5_ROWREAD(rb, cs1);
                cslot = P5_WRAP(cs1);
                __builtin_amdgcn_sched_barrier(0);
                if (!UP) {
                    float a0 = ma[0], a1 = ma[1], a2 = ma[2], a3 = ma[3], b0 = mb[0], b1 = mb[1], b2 = mb[2], b3 = mb[3];
                    asm volatile("" : "+v"(a0), "+v"(a1), "+v"(a2), "+v"(a3), "+v"(b0), "+v"(b1), "+v"(b2), "+v"(b3));
                    float ta = dg0 ? a0 : dg1 ? a1 : dg2 ? a2 : a3, tb = dg0 ? b0 : dg1 ? b1 : dg2 ? b2 : b3;
                    ta = dgv ? ta : 0.f; tb = dgv ? tb : 0.f; wave_total63x2(ta, tb);
                    L.raw[idx] = __builtin_bit_cast(float, __builtin_amdgcn_readlane(__builtin_bit_cast(int, ta), 63)) * hinv[tok];
                    L.raw[idx + 1] = __builtin_bit_cast(float, __builtin_amdgcn_readlane(__builtin_bit_cast(int, tb), 63)) * hinv[tok];
                } else {
#pragma unroll
                    for (int k = 0; k < 16; ++k) hp[tok][k] = __builtin_bit_cast(unsigned, __builtin_elementwise_fma((f16x2v){xa[2 * k], xa[2 * k + 1]}, ca, __builtin_bit_cast(f16x2v, hp[tok][k])));
                    __builtin_amdgcn_sched_barrier(0);
#pragma unroll
                    for (int k = 0; k < 16; ++k) hp[tok][k] = __builtin_bit_cast(unsigned, __builtin_elementwise_fma((f16x2v){xb[2 * k], xb[2 * k + 1]}, cb, __builtin_bit_cast(f16x2v, hp[tok][k])));
                }
                idx += 2;
            }
            if (i < n) {
                f16x32 xa; f32x4 ma;
                if (UP) xa = __builtin_amdgcn_cvt_scalef32_pk32_f16_fp6(P5_V6(ra), 1.0f);
                else { const f32x4 z = {0.f, 0.f, 0.f, 0.f}; ma = __builtin_amdgcn_mfma_scale_f32_16x16x128_f8f6f4(ra, hq[tok], z, 2, 2, 0, 0, 0, 0); }
                const f16x2v ca = __builtin_bit_cast(f16x2v, __builtin_amdgcn_readfirstlane(cav));
                ra = rb; cav = cbv;
                { const int id0 = __builtin_amdgcn_readfirstlane(nv0); P5_ISSUE(tab, id0); }
                nv0 = nv1; nv1 = L.feid[idx + 2 + P5_R > 511 ? 511 : idx + 2 + P5_R];
                if (UP) cbv = cbits[idx + 2 > 511 ? 511 : idx + 2];
                asm volatile("s_waitcnt vmcnt(14)" ::: "memory");
                P5_ROWREAD(rb, cslot);
                cslot = P5_WRAP(cslot);
                __builtin_amdgcn_sched_barrier(0);
                if (!UP) {
                    float a0 = ma[0], a1 = ma[1], a2 = ma[2], a3 = ma[3];
                    asm volatile("" : "+v"(a0), "+v"(a1), "+v"(a2), "+v"(a3));
                    float ta = dg0 ? a0 : dg1 ? a1 : dg2 ? a2 : a3; ta = wave_total63(dgv ? ta : 0.f);
                    L.raw[idx] = __builtin_bit_cast(float, __builtin_amdgcn_readlane(__builtin_bit_cast(int, ta), 63)) * hinv[tok];
                } else {
#pragma unroll
                    for (int k = 0; k < 16; ++k) hp[tok][k] = __builtin_bit_cast(unsigned, __builtin_elementwise_fma((f16x2v){xa[2 * k], xa[2 * k + 1]}, ca, __builtin_bit_cast(f16x2v, hp[tok][k])));
                }
                idx += 1;
            }
        }
    }
    asm volatile("s_waitcnt vmcnt(0)" ::: "memory");
}
__device__ __forceinline__ void p5_wave(LAS unsigned char* wl, const float* SC, const bf16* X1, const unsigned char* ED, const unsigned char* EU, const float* SD, const float* SU,
                                        const float* gf, float* out, int t0, int lane, const float* g2) {
    SweepLds L; L.ring = wl; L.feid = (LAS int*)(wl + 14336); L.fcf = (LAS float*)(wl + 14336 + 2048); L.raw = (LAS float*)(wl + 14336 + 4096);
    { LAS int* ctab = (LAS int*)(wl + 14336); ctab[lane] = cand_pair(lane); }
    unsigned hp[4][16]; float rsv[4]; v8i hq[4]; float hinv[4];
    {   f32x4 gl[8];
        int ls = lane; asm volatile("" : "+v"(ls));
#pragma unroll
        for (int i = 0; i < 8; ++i) gl[i] = *(const f32x4*)(g2 + i * 256 + ls * 4);
        v2u xq[4][8];
#pragma unroll
        for (int tk = 0; tk < 4; ++tk)
#pragma unroll
            for (int i = 0; i < 8; ++i) xq[tk][i] = *(const v2u*)(X1 + (size_t)(t0 + 8 * tk) * D + i * 256 + ls * 4);
#pragma unroll
        for (int tk = 0; tk < 4; ++tk) { float ss = 0.f;
#pragma unroll
            for (int i = 0; i < 8; ++i)
#pragma unroll
                for (int e = 0; e < 2; ++e) { const float a = bflo(xq[tk][i][e]), b = bfhi(xq[tk][i][e]); ss += a * a + b * b; }
            const float rs = __builtin_amdgcn_rsqf(wave_sum(ss) * (1.f / D) + EPS); rsv[tk] = rs;
            float hx[32]; float mx = 0.f;
#pragma unroll
            for (int i = 0; i < 8; ++i)
#pragma unroll
                for (int e = 0; e < 2; ++e) {
                    hx[4 * i + 2 * e] = bflo(xq[tk][i][e]) * rs * gl[i][2 * e]; hx[4 * i + 2 * e + 1] = bfhi(xq[tk][i][e]) * rs * gl[i][2 * e + 1];
                    mx = fmaxf(mx, fmaxf(fabsf(hx[4 * i + 2 * e]), fabsf(hx[4 * i + 2 * e + 1]))); }
#pragma unroll
            for (int o = 1; o < 64; o <<= 1) mx = fmaxf(mx, __shfl_xor(mx, o));
            const float hs = mx > 0.f ? 7.f / mx : 0.f; hinv[tk] = mx * (1.f / 7.f);
            bf16x32 hb;
#pragma unroll
            for (int k = 0; k < 32; ++k) hb[k] = (__bf16)(hx[k] * hs);
            const v6u pk = __builtin_amdgcn_cvt_scalef32_pk32_fp6_bf16(hb, 1.0f);
            hq[tk] = (v8i){(int)pk[0], (int)pk[1], (int)pk[2], (int)pk[3], (int)pk[4], (int)pk[5], 0, 0};
        }
    }
    LDS_WAIT(); __builtin_amdgcn_wave_barrier();
    for (int rep_ = 0; rep_ < REP_TOPK; ++rep_)
    for (int tk = 0; tk < 4; ++tk) {
        if (tk == 0) { WaveLds W0; W0.sv = (LAS float*)(wl + 4096); p5_topk_fetch(W0, SC + (size_t)t0 * 2048, 0, lane); }
        WaveLds W; W.eid = (LAS int*)(wl + 1024 * tk); W.gate = (LAS float*)(wl + 1024 * tk + 512);
        W.sv = (LAS float*)(wl + 4096); W.tv = (LAS float*)(wl + 12288); W.ti = (LAS int*)(wl + 13312); W.ctab = (LAS int*)(wl + 14336);
        p5_topk_token(W, SC + (size_t)(t0 + 8 * tk) * 2048, tk < 3 ? SC + (size_t)(t0 + 8 * tk + 8) * 2048 : nullptr, rsv[tk], lane);
    }
    int lenv0 = 0, lenv1 = 0;
#pragma unroll
    for (int tk = 0; tk < 4; ++tk) {
        const LAS int* ue = (const LAS int*)(wl + 1024 * tk); const int sl0 = ue[lane] >> P5_SLSH, sl1 = ue[lane + 64] >> P5_SLSH;
        for (int k = 0; k < P5_NSL; ++k) { const int c = __popcll(__ballot(sl0 == k)) + __popcll(__ballot(sl1 == k));
            if (lane == (k & 15) * 4 + tk) { if (k < 16) lenv0 = c; else lenv1 = c; } }
    }
    const int incl0 = wave_incl_scan(lenv0), tot0 = __builtin_amdgcn_readlane(incl0, 63);
    const int base0 = incl0 - lenv0, base1 = wave_incl_scan(lenv1) - lenv1 + tot0;
#pragma unroll
    for (int tk = 0; tk < 4; ++tk) {
        const LAS int* ue = (const LAS int*)(wl + 1024 * tk); const LAS float* ug = (const LAS float*)(wl + 1024 * tk + 512);
        const int e0 = ue[lane], e1 = ue[lane + 64], sl0 = e0 >> P5_SLSH, sl1 = e1 >> P5_SLSH; const float g0 = ug[lane], g1 = ug[lane + 64];
        int r0 = 0, r1 = 0;
        for (int k = 0; k < P5_NSL; ++k) { const unsigned long long m0 = __ballot(sl0 == k), m1 = __ballot(sl1 == k);
            if (sl0 == k) r0 = mbcnt64(m0);
            if (sl1 == k) r1 = __popcll(m0) + mbcnt64(m1); }
        const int b00 = __shfl(base0, (sl0 & 15) * 4 + tk), b01 = __shfl(base1, (sl0 & 15) * 4 + tk), b10 = __shfl(base0, (sl1 & 15) * 4 + tk), b11 = __shfl(base1, (sl1 & 15) * 4 + tk);
        const int p0 = (sl0 < 16 ? b00 : b01) + r0, p1 = (sl1 < 16 ? b10 : b11) + r1;
        L.feid[p0] = e0; L.fcf[p0] = g0; L.feid[p1] = e1; L.fcf[p1] = g1;
    }
    LDS_WAIT(); __builtin_amdgcn_wave_barrier();
    for (int rep_ = 0; rep_ < REP_DS; ++rep_) p5_sweep<false>(L, ED, hp, hq, hinv, lenv0, lenv1, lane);
    LDS_WAIT(); __builtin_amdgcn_wave_barrier();
    float cmax = 0.f;
    {   float sdv[8], suv[8], cv[8];
#pragma unroll
        for (int k = 0; k < 8; ++k) { const int id = L.feid[lane + 64 * k]; sdv[k] = SD[id]; suv[k] = SU[id]; }
#pragma unroll
        for (int k = 0; k < 8; ++k) { const int i = lane + 64 * k; cv[k] = gelu_erf(L.raw[i] * sdv[k]) * L.fcf[i] * suv[k]; cmax = fmaxf(cmax, fabsf(cv[k])); }
#pragma unroll
        for (int o = 1; o < 64; o <<= 1) cmax = fmaxf(cmax, __shfl_xor(cmax, o));
        const float cinv = cmax > 0.f ? 1.f / cmax : 0.f;
#pragma unroll
        for (int k = 0; k < 8; ++k) { const _Float16 h = (_Float16)(cv[k] * cinv); ((LAS unsigned*)L.fcf)[lane + 64 * k] = __builtin_bit_cast(unsigned, (f16x2v){h, h}); }
    }
    LDS_WAIT(); __builtin_amdgcn_wave_barrier();
    asm volatile("s_waitcnt vmcnt(0)" ::: "memory");
#pragma unroll
    for (int tk = 0; tk < 4; ++tk)
#pragma unroll
        for (int q = 0; q < 16; ++q) hp[tk][q] = 0u;
    p5_sweep<true>(L, EU, hp, hq, hinv, lenv0, lenv1, lane);
    int le = lane; asm volatile("" : "+v"(le));
#pragma unroll
    for (int tk = 0; tk < 4; ++tk) {
        const size_t ro = (size_t)(t0 + 8 * tk) * D; float ss = 0.f; float st[32];
#pragma unroll
        for (int i = 0; i < 8; ++i) { const v2u xa = __builtin_nontemporal_load((const v2u*)(X1 + ro + i * 256 + le * 4));
#pragma unroll
            for (int c = 0; c < 2; ++c) { const int k = 4 * i + 2 * c; const f16x2v a = __builtin_bit_cast(f16x2v, hp[tk][k >> 1]);
                st[k] = (float)a.x * cmax + bflo(xa[c]); st[k + 1] = (float)a.y * cmax + bfhi(xa[c]); ss += st[k] * st[k] + st[k + 1] * st[k + 1]; } }
        const float r = rsqrtf(wave_sum(ss) * (1.f / D) + EPS);
#pragma unroll
        for (int i = 0; i < 8; ++i) { const f32x4 g = *(const f32x4*)(gf + i * 256 + le * 4); f32x4 a;
#pragma unroll
            for (int c = 0; c < 4; ++c) a[c] = st[4 * i + c] * r * g[c];
            __builtin_nontemporal_store(a, (f32x4*)(out + ro + i * 256 + le * 4)); }
    }
}
__device__ __forceinline__ void p5_peer(const Ctx& F, const float* SC, const bf16* X1, const unsigned char* ED, const unsigned char* EU, const float* SD, const float* SU, const float* gf, float* out, const float* g2) {
    for (int tile = F.bid; tile < T / P5_TOK; tile += F.G)
        p5_wave(F.lds + F.wave * P5_WL2, SC, X1, ED, EU, SD, SU, gf, out, tile * P5_TOK + F.wave, F.lane, g2);
}

struct Args { const float* in[15]; float* out; unsigned char* ws; };
__global__ void __launch_bounds__(NTHR, 2) mega_fwd(Args args) {
    extern __shared__ __attribute__((aligned(16))) unsigned char lds_raw[];
    Ctx F; F.lds = (LAS unsigned char*)lds_raw; F.tid = threadIdx.x; F.lane = F.tid & 63; F.wave = __builtin_amdgcn_readfirstlane(F.tid >> 6); F.G = gridDim.x; F.bid = blockIdx.x;
    volatile LAS unsigned* MISC = (volatile LAS unsigned*)(F.lds + MISC_OFF);
    unsigned char* ws = args.ws; unsigned* ctl = (unsigned*)(ws + WS_CTL);
    const float* x = args.in[0]; const float* norm1_g = args.in[1]; const float* w_in = args.in[2]; const float* sgu_ln_g = args.in[3]; const float* sgu_ln_b = args.in[4];
    const float* w_spatial = args.in[5]; const float* b_spatial = args.in[6]; const float* attn_sinks = args.in[7]; const float* w_out = args.in[8]; const float* norm2_g = args.in[9];
    const float* w_query = args.in[10]; const float* sub_keys = args.in[11]; const float* expert_down = args.in[12]; const float* expert_up = args.in[13]; const float* norm_f_g = args.in[14];
    bf16* WinT = (bf16*)(ws + WS_WIN); bf16* WoutT = (bf16*)(ws + WS_WOUT); bf16* WeffT = (bf16*)(ws + WS_WEFF); bf16* H = (bf16*)(ws + WS_H);
    bf16* Z = (bf16*)(ws + WS_Z); bf16* MIX = (bf16*)(ws + WS_MIX); bf16* X1 = (bf16*)(ws + WS_X1); float* SC = (float*)(ws + WS_SC);
    unsigned char* ED = ws + WS_ED; unsigned char* EU = ws + WS_EU; float* SD = (float*)(ws + WS_SD); float* SU = (float*)(ws + WS_SU);
    for (int u = F.tid; u < (LDS_BYTES - LDSCTL_OFF) / 4; u += NTHR) ((LAS unsigned*)(F.lds + LDSCTL_OFF))[u] = 0u;
    __syncthreads();
    XcdBarrier bar = xcd_barrier_post(ctl + CW_BAR, MISC + 8);
#ifdef TP_PHASE
    volatile unsigned long long* tsp = (volatile unsigned long long*)(ws + WS_TP);
#define TP_BEGIN(k) do { if ((k) == TP_PHASE && F.bid == 0 && F.tid == 0) tsp[0] = wall_clock64(); } while (0)
#define TP_END(k) do { if ((k) == TP_PHASE && F.bid == 0 && F.tid == 0) tsp[1] = wall_clock64() - tsp[0]; } while (0)
#else
#define TP_BEGIN(k) do { } while (0)
#define TP_END(k) do { } while (0)
#endif
    TP_BEGIN(0);

    for (int rep = 0; rep < REP_P0; ++rep) p0_prologue(F, x, norm1_g, w_in, w_out, w_query, sub_keys, expert_down, expert_up, WinT, WoutT, WeffT, H, ED, EU, SD, SU, norm2_g);
    xcd_barrier(bar); TP_END(0); TP_BEGIN(1);
#if defined(TP_PHASE) && TP_PHASE == 11
    if (F.bid == F.G - 1 && F.tid == 0) tsp[0] = wall_clock64();
#endif
    for (int rep_ = 0; rep_ < REP_P1; ++rep_)
    {   pg8::Gemm g{H, WinT, T, NIN, D}; pg8::StaticOrder S; S.init(T, NIN, F.G, F.bid);
        pg8::EpiZ E{Z, NIN, 8};
        pg8::gemm_phase<pg8::EpiZ, pg8::StaticOrder, true, true>(F.lds + RING_OFF, g, S, E); }
    {
        const int nU = (T / 256) * (NIN / 256), maxu = (nU + F.G - 1) / F.G, nfull = nU - (maxu - 1) * F.G;
        const bool all = nfull == F.G; const int nidle = all ? F.G : F.G - nfull, q = all ? F.bid : F.bid - nfull;
        if (q >= 0) convert_rows(expert_down, expert_up, ED, EU, SD, SU, CONV_SPLIT, 2 * NE, q * NWAVES + F.wave, nidle * NWAVES, F.lane);
#if defined(TP_PHASE) && TP_PHASE == 11
        __syncthreads(); if (F.bid == F.G - 1 && F.tid == 0) tsp[1] = wall_clock64() - tsp[0];
#endif
    }
    xcd_barrier(bar); TP_END(1); TP_BEGIN(2);
    for (int rep = 0; rep < REP_P2; ++rep) { p2_sgu(F, Z, sgu_ln_g, sgu_ln_b, w_spatial, b_spatial, MIX); p2_attn(F, Z, attn_sinks, MIX); }
    {   pg8::Gemm g{MIX, WoutT, T, D, D}; pg8::StaticOrder S; S.init(T, D, F.G, F.bid);
        pg8::EpiX1 E{x, X1, D};
        pg8::f32x4 acc[2][2][4][2]; pg8::Unit u0; const bool has0 = S.next(0, u0);
        const int wr_ = F.wave >> 2, wc_ = F.wave & 3, fr_ = F.lane & 15, fq_ = F.lane >> 4;
        xcd_barrier_pre(bar, [&]() { if (has0) E.init(acc, u0, wr_, wc_, fr_, fq_); }); TP_END(2); TP_BEGIN(3);
        pg8::gemm_phase_acc<pg8::EpiX1, pg8::StaticOrder, true, true, true>(F.lds + RING_OFF, g, S, E, acc); }
    xcd_barrier(bar); TP_END(3); TP_BEGIN(4);
    {   pg8::Gemm g{X1, WeffT, T, D, D}; pg8::StaticOrder S; S.init(T, D, F.G, F.bid);
        pg8::EpiF32<false> E{nullptr, SC, D};
        pg8::gemm_phase<pg8::EpiF32<false>, pg8::StaticOrder, true, true>(F.lds + RING_OFF, g, S, E); }
    xcd_barrier(bar); TP_END(4); TP_BEGIN(5);
    for (int rep = 0; rep < REP_P5; ++rep) p5_peer(F, SC, X1, ED, EU, SD, SU, norm_f_g, args.out, norm2_g);
#ifdef TP_PHASE
    xcd_barrier(bar); TP_END(5);
    if (F.bid == 0 && F.tid == 0) { const unsigned long long t0 = wall_clock64(), w = (unsigned long long)TP_W * tsp[1]; while (wall_clock64() - t0 < w) __builtin_amdgcn_s_sleep(16); }
#endif
}

extern "C" void kernel_launch(void* const* d_in, const int* in_sizes, int n_in, void* d_out, int out_size, void* d_ws, size_t ws_size, hipStream_t stream) {
    static int grid = 0;
    if (grid == 0) {
        if (n_in != 15 || ws_size < WS_END) { fprintf(stderr, "kernel_launch: unexpected inputs / workspace\n"); grid = -1; return; }
        int dev = 0, cus = 0, per_cu = 0;
        if (hipGetDevice(&dev) != hipSuccess || hipDeviceGetAttribute(&cus, hipDeviceAttributeMultiprocessorCount, dev) != hipSuccess) { grid = -1; return; }
        if (hipFuncSetAttribute((const void*)mega_fwd, hipFuncAttributeMaxDynamicSharedMemorySize, LDS_BYTES) != hipSuccess) { fprintf(stderr, "kernel_launch: hipFuncSetAttribute failed\n"); grid = -1; return; }
        if (hipOccupancyMaxActiveBlocksPerMultiprocessor(&per_cu, (const void*)mega_fwd, NTHR, LDS_BYTES) != hipSuccess || per_cu < 1)
            fprintf(stderr, "kernel_launch: note: occupancy query reports %d workgroups per CU\n", per_cu);
        (void)hipGetLastError();
        grid = cus;
    }
    if (grid < 0) return;
    if (hipMemsetAsync((char*)d_ws + WS_CTL, 0, CTL_ZERO_BYTES, stream) != hipSuccess) return;
    Args a{};
    for (int i = 0; i < 15; ++i) a.in[i] = (const float*)d_in[i];
    a.out = (float*)d_out; a.ws = (unsigned char*)d_ws;
    hipLaunchKernelGGL(mega_fwd, dim3(grid), dim3(NTHR), LDS_BYTES, stream, a);
}
```

```cpp
#include <hip/hip_runtime.h>
#include <cstdio>
#include <cstdint>
#include <math.h>
namespace pg8 {
#define PG8_LAS __attribute__((address_space(3)))
typedef unsigned short bf16_t;
typedef short bf16x8 __attribute__((ext_vector_type(8)));
typedef float f32x4 __attribute__((ext_vector_type(4)));
typedef unsigned u32x4 __attribute__((ext_vector_type(4)));
constexpr int BM = 256, BK = 64, HALF = 128, HTB = HALF * BK * 2  , STAGE_BYTES = 8 * HTB, NXCD = 8, WGM = 8;

__host__ __device__ __forceinline__ int lds_byte(int r, int c) { const int st = (r >> 4) * 2 + (c >> 5), rr = r & 15, cc = c & 31, ob = rr * 64 + cc * 2; return st * 1024 + (ob ^ (((ob >> 9) & 1) << 5)); }
__host__ __device__ __forceinline__ void stage_rc(int b, int& R, int& C) { const int st = b / 1024, sb = b % 1024, swz = sb ^ (((sb >> 9) & 1) << 5); R = (st >> 1) * 16 + swz / 64; C = (st & 1) * 32 + (swz % 64) / 2; }
__host__ __device__ __forceinline__ int perm32(int rho) { const int n = rho >> 4, i = rho & 15; return 8 * (i >> 2) + 4 * n + (i & 3); }

struct Unit { int pm, pn; };
struct Gemm { const bf16_t* A; const bf16_t* Bt; int M, N, K; };

struct StaticOrder {
    int nM, nN, nwg, G, c;
    __host__ __device__ void init(int M, int N, int G_, int c_) { nM = M / BM; nN = N / BM; nwg = nM * nN; G = G_; c = c_; }
    __host__ __device__ bool next(int i, Unit& u) const {
        const long L = (long)i * G + c; if (L >= nwg) return false;
        int wgid = (int)L; { const int q = nwg / NXCD, r = nwg % NXCD, xcd = wgid % NXCD, off = wgid / NXCD; wgid = (xcd < r ? xcd * (q + 1) : r * (q + 1) + (xcd - r) * q) + off; }
        const int nig = WGM * nN, gid = wgid / nig, fm = gid * WGM, gsz = (nM - fm) < WGM ? (nM - fm) : WGM;
        u.pm = fm + ((wgid % nig) % gsz); u.pn = (wgid % nig) / gsz; return true;
    }
    __device__ __forceinline__ void a_ready(const Unit&) const {}
    __device__ __forceinline__ void done(const Unit&) const {}
};

__device__ __forceinline__ unsigned cvt_pk_bf16(float lo, float hi) { unsigned r; asm volatile("v_cvt_pk_bf16_f32 %0, %1, %2" : "=v"(r) : "v"(lo), "v"(hi)); return r; }
typedef float f32x2 __attribute__((ext_vector_type(2)));
__device__ __forceinline__ f32x2 gelu_pk(f32x2 v) {
    const f32x2 av = __builtin_elementwise_abs(v), d = av * 0.2316418882f + 1.0f;
    f32x2 t; t.x = __builtin_amdgcn_rcpf(d.x); t.y = __builtin_amdgcn_rcpf(d.y);
    f32x2 q = t * 0.5307027145f + (-0.7265760135f); q = q * t + 0.7107068705f; q = q * t + (-0.142248368f); q = q * t + 0.127414796f; q = q * t;
    const f32x2 s = (v * v) * (-0.72134752044f);
    f32x2 e; e.x = __builtin_amdgcn_exp2f(s.x); e.y = __builtin_amdgcn_exp2f(s.y);
    const f32x2 m = v * (q * e), r = v - m;
    f32x2 o; o.x = v.x < 0.f ? m.x : r.x; o.y = v.y < 0.f ? m.y : r.y; return o;
}
struct EpiZ {
    static constexpr bool PERM = true, AFTER_DRAIN = false;
    bf16_t* O; int ldc; int gelu_tiles;
    __device__ __forceinline__ void operator()(const f32x4 (&acc)[2][2][4][2], const Unit& u, int wr, int wc, int fr, int fq) const {
        const int row0 = u.pm * BM + wr * 64 + fr, col0 = u.pn * BM + wc * 32 + 8 * fq;
        const bool act = u.pn < gelu_tiles;
#pragma unroll
        for (int ai = 0; ai < 2; ++ai)
#pragma unroll
            for (int m = 0; m < 4; ++m) { bf16_t* rowp = O + (size_t)(row0 + ai * HALF + m * 16) * ldc + col0;
#pragma unroll
                for (int bj = 0; bj < 2; ++bj) { f32x4 v0 = acc[ai][bj][m][0], v1 = acc[ai][bj][m][1];
                    if (act) { f32x2 a = gelu_pk((f32x2){v0[0], v0[1]}), b = gelu_pk((f32x2){v0[2], v0[3]}), c = gelu_pk((f32x2){v1[0], v1[1]}), d = gelu_pk((f32x2){v1[2], v1[3]});
                        v0 = (f32x4){a.x, a.y, b.x, b.y}; v1 = (f32x4){c.x, c.y, d.x, d.y}; }
                    u32x4 w; w.x = cvt_pk_bf16(v0[0], v0[1]); w.y = cvt_pk_bf16(v0[2], v0[3]); w.z = cvt_pk_bf16(v1[0], v1[1]); w.w = cvt_pk_bf16(v1[2], v1[3]);
                    *(u32x4*)(rowp + bj * HALF) = w; } }
    }
};
template <bool RES> struct EpiF32 {
    static constexpr bool PERM = false, AFTER_DRAIN = false;
    const float* base; float* C; int ldc;
    __device__ __forceinline__ void operator()(const f32x4 (&acc)[2][2][4][2], const Unit& u, int wr, int wc, int fr, int fq) const {
        const int row0 = u.pm * BM + wr * 64 + fr, col0 = u.pn * BM + wc * 32 + 4 * fq;
#pragma unroll
        for (int ai = 0; ai < 2; ++ai)
#pragma unroll
            for (int m = 0; m < 4; ++m) { const size_t off = (size_t)(row0 + ai * HALF + m * 16) * ldc + col0;
#pragma unroll
                for (int bj = 0; bj < 2; ++bj)
#pragma unroll
                    for (int n = 0; n < 2; ++n) { const size_t o = off + bj * HALF + n * 16; f32x4 v = acc[ai][bj][m][n];
                        if (RES) v = v + *(const f32x4*)(base + o);
                        *(f32x4*)(C + o) = v; } }
    }
};
struct EpiX1 {
    static constexpr bool PERM = false, AFTER_DRAIN = false;
    const float* base; bf16_t* X1; int ldc;
    __device__ __forceinline__ void init(f32x4 (&acc)[2][2][4][2], const Unit& u, int wr, int wc, int fr, int fq) const {
        const int row0 = u.pm * BM + wr * 64 + fr, col0 = u.pn * BM + wc * 32 + 4 * fq;
#pragma unroll
        for (int ai = 0; ai < 2; ++ai)
#pragma unroll
            for (int m = 0; m < 4; ++m) { const size_t off = (size_t)(row0 + ai * HALF + m * 16) * ldc + col0;
#pragma unroll
                for (int bj = 0; bj < 2; ++bj)
#pragma unroll
                    for (int n = 0; n < 2; ++n) acc[ai][bj][m][n] = *(const f32x4*)(base + off + bj * HALF + n * 16); }
    }
    __device__ __forceinline__ void operator()(const f32x4 (&acc)[2][2][4][2], const Unit& u, int wr, int wc, int fr, int fq) const {
        const int row0 = u.pm * BM + wr * 64 + fr, col0 = u.pn * BM + wc * 32 + 4 * fq;
        typedef __bf16 bf2 __attribute__((ext_vector_type(2)));
        typedef unsigned u2 __attribute__((ext_vector_type(2)));
#pragma unroll
        for (int ai = 0; ai < 2; ++ai)
#pragma unroll
            for (int m = 0; m < 4; ++m) { const size_t off = (size_t)(row0 + ai * HALF + m * 16) * ldc + col0;
#pragma unroll
                for (int bj = 0; bj < 2; ++bj)
#pragma unroll
                    for (int n = 0; n < 2; ++n) { const f32x4 v = acc[ai][bj][m][n]; const f32x2 lo = {v[0], v[1]}, hi = {v[2], v[3]};
                        u2 pk; pk.x = __builtin_bit_cast(unsigned, __builtin_convertvector(lo, bf2)); pk.y = __builtin_bit_cast(unsigned, __builtin_convertvector(hi, bf2));
                        *(u2*)(X1 + off + bj * HALF + n * 16) = pk; } }
    }
};
template <class Epi, class Sched, bool ALIGN_EPI = false, bool SP2 = false, bool PRE = false>
__device__ __forceinline__ void gemm_phase_acc(PG8_LAS unsigned char* lds, const Gemm g, const Sched& S, const Epi& E, f32x4 (&acc)[2][2][4][2]) {
    const int tid = threadIdx.x, wid = __builtin_amdgcn_readfirstlane(tid >> 6), lane = tid & 63, wr = wid >> 2, wc = wid & 3, fr = lane & 15, fq = lane >> 4;
    const int K = g.K, nt = K / BK;
    unsigned voffA[2], voffB[2];
#pragma unroll
    for (int i = 0; i < 2; ++i) { int R, C; stage_rc(tid * 16 + i * 8192, R, C); const int Rb = Epi::PERM ? ((R & ~31) + perm32(R & 31)) : R;
        voffA[i] = (unsigned)(R * K + C) * 2u; voffB[i] = (unsigned)(Rb * K + C) * 2u; }
    const size_t kstep = (size_t)(BK * 2);
    const size_t hstep = (size_t)HALF * K * 2;
    const size_t tstep = 2 * hstep;
    const unsigned ldsw = (unsigned)wid * 1024u;
    const int aoff = lds_byte(wr * 64 + fr, fq * 8), boff = lds_byte(wc * 32 + fr, fq * 8);
#define PG8_SA(b, h) (((b) * 2 + (h)) * HTB)
#define PG8_SB(b, h) ((4 + (b) * 2 + (h)) * HTB)
#define PG8_STAGE(bufoff, gbase, voff) do { _Pragma("unroll") for (int _i = 0; _i < 2; ++_i) \
        __builtin_amdgcn_global_load_lds((const unsigned*)((const char*)(gbase) + (voff)[_i]), (PG8_LAS unsigned*)(lds + (bufoff) + ldsw + _i * 8192), 16, 0, 0); } while (0)
#define PG8_LDA(dst, b, h) do { _Pragma("unroll") for (int m = 0; m < 4; ++m) _Pragma("unroll") for (int k = 0; k < 2; ++k) dst[m][k] = *(const PG8_LAS bf16x8*)(lds + PG8_SA(b, h) + aoff + m * 2048 + k * 1024); } while (0)
#define PG8_LDB(dst, b, h) do { _Pragma("unroll") for (int n = 0; n < 2; ++n) _Pragma("unroll") for (int k = 0; k < 2; ++k) dst[n][k] = *(const PG8_LAS bf16x8*)(lds + PG8_SB(b, h) + boff + n * 2048 + k * 1024); } while (0)
#define PG8_MMA(ai, bj, At, Bt) do { __builtin_amdgcn_s_setprio(1); _Pragma("unroll") for (int m = 0; m < 4; ++m) _Pragma("unroll") for (int n = 0; n < 2; ++n) _Pragma("unroll") for (int k = 0; k < 2; ++k) \
        acc[ai][bj][m][n] = __builtin_amdgcn_mfma_f32_16x16x32_bf16(Bt[n][k], At[m][k], acc[ai][bj][m][n], 0, 0, 0); __builtin_amdgcn_s_setprio(0); } while (0)
#define PG8_WAIT_V(n) asm volatile("s_waitcnt vmcnt(" #n ")" ::: "memory")
#define PG8_WAIT_L(n) asm volatile("s_waitcnt lgkmcnt(" #n ")" ::: "memory")
#define PG8_BAR __builtin_amdgcn_s_barrier()
#define PG8_SCHED __builtin_amdgcn_sched_barrier(0)
    Unit cur, nxt; int ui = 0;
    if (!S.next(0, cur)) return;
    if constexpr (!PRE) {
#pragma unroll
    for (int a = 0; a < 2; ++a)
#pragma unroll
        for (int b = 0; b < 2; ++b)
#pragma unroll
            for (int m = 0; m < 4; ++m)
#pragma unroll
                for (int n = 0; n < 2; ++n) acc[a][b][m][n] = (f32x4){0.f, 0.f, 0.f, 0.f};
    }
    bf16x8 At[4][2], B0[2][2], B1[2][2];
    const char* cA = (const char*)g.A + (size_t)cur.pm * tstep; const char* cB = (const char*)g.Bt + (size_t)cur.pn * tstep;
    S.a_ready(cur);
    if constexpr (SP2) {
        PG8_STAGE(PG8_SB(0, 0), cB, voffB); PG8_STAGE(PG8_SB(0, 1), cB + hstep, voffB); PG8_STAGE(PG8_SA(0, 0), cA, voffA); PG8_STAGE(PG8_SA(0, 1), cA + hstep, voffA);
        if (wr == 1) PG8_BAR;
        PG8_WAIT_V(2); PG8_BAR;
        PG8_STAGE(PG8_SB(1, 0), cB + kstep, voffB); PG8_STAGE(PG8_SA(1, 0), cA + kstep, voffA); PG8_STAGE(PG8_SB(1, 1), cB + hstep + kstep, voffB);
        PG8_WAIT_V(6); PG8_BAR;
    } else {
        PG8_STAGE(PG8_SB(0, 0), cB, voffB); PG8_STAGE(PG8_SA(0, 0), cA, voffA); PG8_STAGE(PG8_SB(0, 1), cB + hstep, voffB); PG8_STAGE(PG8_SA(0, 1), cA + hstep, voffA);
        if (wr == 1) PG8_BAR;
        PG8_WAIT_V(4); PG8_BAR;
        PG8_STAGE(PG8_SB(1, 0), cB + kstep, voffB); PG8_STAGE(PG8_SA(1, 0), cA + kstep, voffA); PG8_STAGE(PG8_SB(1, 1), cB + hstep + kstep, voffB);
        PG8_WAIT_V(6); PG8_BAR;
    }
    for (;;) {
        const bool has_next = S.next(ui + 1, nxt);
        const char* nA = has_next ? (const char*)g.A + (size_t)nxt.pm * tstep : cA; const char* nB = has_next ? (const char*)g.Bt + (size_t)nxt.pn * tstep : cB;
        for (int t = 0; t < nt; t += 2) {
            const bool last = (t == nt - 2);
            const char* a1 = cA + (size_t)(t + 1) * kstep;
            const char* a2 = last ? nA : cA + (size_t)(t + 2) * kstep; const char* b2 = last ? nB : cB + (size_t)(t + 2) * kstep;
            const char* a3 = a2 + kstep; const char* b3 = b2 + kstep;
            if (last && has_next) S.a_ready(nxt);
            if constexpr (SP2) {
            PG8_LDB(B0, 0, 0); PG8_LDB(B1, 0, 1); PG8_SCHED; PG8_LDA(At, 0, 0); PG8_STAGE(PG8_SA(1, 1), a1 + hstep, voffA);
            PG8_WAIT_V(8); PG8_WAIT_L(0); PG8_BAR; PG8_MMA(0, 0, At, B0); PG8_MMA(0, 1, At, B1); PG8_BAR; PG8_SCHED;
            PG8_LDA(At, 0, 1); PG8_STAGE(PG8_SB(0, 0), b2, voffB); PG8_STAGE(PG8_SB(0, 1), b2 + hstep, voffB); PG8_STAGE(PG8_SA(0, 0), a2, voffA);
            PG8_WAIT_V(8); PG8_WAIT_L(0); PG8_BAR; PG8_MMA(1, 0, At, B0); PG8_MMA(1, 1, At, B1); PG8_BAR; PG8_SCHED;
            PG8_LDB(B0, 1, 0); PG8_LDB(B1, 1, 1); PG8_SCHED; PG8_LDA(At, 1, 0); PG8_STAGE(PG8_SA(0, 1), a2 + hstep, voffA);
            PG8_WAIT_V(8); PG8_WAIT_L(0); PG8_BAR; PG8_MMA(0, 0, At, B0); PG8_MMA(0, 1, At, B1); PG8_BAR; PG8_SCHED;
            PG8_LDA(At, 1, 1); PG8_STAGE(PG8_SB(1, 0), b3, voffB); PG8_STAGE(PG8_SB(1, 1), b3 + hstep, voffB); PG8_STAGE(PG8_SA(1, 0), a3, voffA);
            PG8_WAIT_V(8); PG8_WAIT_L(0); PG8_BAR; PG8_MMA(1, 0, At, B0); PG8_MMA(1, 1, At, B1); PG8_BAR; PG8_SCHED;
            } else {
            PG8_LDB(B0, 0, 0); PG8_SCHED; PG8_LDA(At, 0, 0); PG8_STAGE(PG8_SA(1, 1), a1 + hstep, voffA);
            PG8_WAIT_L(8); PG8_BAR; PG8_WAIT_L(0); PG8_MMA(0, 0, At, B0); PG8_BAR; PG8_SCHED;
            PG8_LDB(B1, 0, 1); PG8_STAGE(PG8_SB(0, 0), b2, voffB);
            PG8_BAR; PG8_WAIT_L(0); PG8_MMA(0, 1, At, B1); PG8_BAR;
            PG8_LDA(At, 0, 1); PG8_STAGE(PG8_SA(0, 0), a2, voffA);
            PG8_BAR; PG8_WAIT_L(0); PG8_MMA(1, 0, At, B0); PG8_BAR; PG8_SCHED;
            PG8_STAGE(PG8_SB(0, 1), b2 + hstep, voffB);
            PG8_WAIT_V(6); PG8_BAR; PG8_MMA(1, 1, At, B1); PG8_BAR;
            PG8_LDB(B0, 1, 0); PG8_SCHED; PG8_LDA(At, 1, 0); PG8_STAGE(PG8_SA(0, 1), a2 + hstep, voffA);
            PG8_WAIT_L(8); PG8_BAR; PG8_WAIT_L(0); PG8_MMA(0, 0, At, B0); PG8_BAR; PG8_SCHED;
            PG8_LDB(B1, 1, 1); PG8_STAGE(PG8_SB(1, 0), b3, voffB);
            PG8_BAR; PG8_WAIT_L(0); PG8_MMA(0, 1, At, B1); PG8_BAR;
            PG8_LDA(At, 1, 1); PG8_STAGE(PG8_SA(1, 0), a3, voffA);
            PG8_BAR; PG8_WAIT_L(0); PG8_MMA(1, 0, At, B0); PG8_BAR; PG8_SCHED;
            PG8_STAGE(PG8_SB(1, 1), b3 + hstep, voffB);
            PG8_WAIT_V(6); PG8_BAR; PG8_MMA(1, 1, At, B1); PG8_BAR;
            }
        }
        if constexpr (ALIGN_EPI) { if (wr == 0) PG8_BAR; }
        if constexpr (!Epi::AFTER_DRAIN) { E(acc, cur, wr, wc, fr, fq); S.done(cur); }
        if (!has_next) break;
        if constexpr (PRE) E.init(acc, nxt, wr, wc, fr, fq);
        else {
#pragma unroll
        for (int a = 0; a < 2; ++a)
#pragma unroll
            for (int b = 0; b < 2; ++b)
#pragma unroll
                for (int m = 0; m < 4; ++m)
#pragma unroll
                    for (int n = 0; n < 2; ++n) acc[a][b][m][n] = (f32x4){0.f, 0.f, 0.f, 0.f};
        }
        cur = nxt; cA = nA; cB = nB; ++ui;
        if constexpr (ALIGN_EPI) { if (wr == 1) PG8_BAR; }
    }
    PG8_WAIT_V(0);
    if constexpr (!ALIGN_EPI) { if (wr == 0) PG8_BAR; }
    PG8_BAR;
    if constexpr (Epi::AFTER_DRAIN) { E.fused(acc, cur, wr, wc, fr, fq, lds, wid, lane); S.done(cur); }
#undef PG8_SA
#undef PG8_SB
#undef PG8_STAGE
#undef PG8_LDA
#undef PG8_LDB
#undef PG8_MMA
#undef PG8_WAIT_V
#undef PG8_WAIT_L
#undef PG8_BAR
#undef PG8_SCHED
}
template <class Epi, class Sched, bool ALIGN_EPI = false, bool SP2 = false>
__device__ __forceinline__ void gemm_phase(PG8_LAS unsigned char* lds, const Gemm g, const Sched& S, const Epi& E) { f32x4 acc[2][2][4][2]; gemm_phase_acc<Epi, Sched, ALIGN_EPI, SP2, false>(lds, g, S, E, acc); }
}
#ifndef REP_P5
#define REP_P5 1
#endif
#ifndef REP_P0
#define REP_P0 1
#endif
#ifndef REP_P1
#define REP_P1 1
#endif
#ifndef REP_P4
#define REP_P4 1
#endif
#ifndef REP_P0B
#define REP_P0B 1
#endif
#ifndef REP_P0C
#define REP_P0C 1
#endif
#ifndef REP_P2
#define REP_P2 1
#endif
constexpr int T = 8192, D = 2048, NIN = 3328, SEQ = 2048, NE = 16384;
constexpr float EPS = 1e-6f;
constexpr int NWAVES = 8, NTHR = 512;
constexpr size_t MiB = 1u << 20;
constexpr size_t WS_CTL = 0, CTL_ZERO_BYTES = 1 * MiB;
constexpr size_t WS_WIN = 2 * MiB;
constexpr size_t WS_WOUT = 16 * MiB;
constexpr size_t WS_WEFF = 24 * MiB;
constexpr size_t WS_H = 32 * MiB;
constexpr size_t WS_Z = 64 * MiB;
constexpr size_t WS_MIX = 116 * MiB;
constexpr size_t WS_X1 = 148 * MiB;
constexpr size_t WS_SC = 212 * MiB;
constexpr size_t WS_ED = 284 * MiB;
constexpr size_t WS_EU = 316 * MiB;
constexpr int ROWB = 1536;
constexpr size_t WS_SD = 348 * MiB;
constexpr size_t WS_SU = 348 * MiB + 65536;
constexpr size_t WS_TP = 348 * MiB + 196608;
constexpr size_t WS_END = 349 * MiB;
constexpr int CW_TMO = 0, CW_BAR = 4096;
constexpr int RING_OFF = 0, RING_BYTES = 131072;
constexpr int LDSCTL_OFF = RING_BYTES, MISC_OFF = LDSCTL_OFF + 320;
constexpr int LDS_BYTES = 163840;

#define GAS __attribute__((address_space(1)))
#define LAS __attribute__((address_space(3)))
typedef unsigned short bf16;
typedef unsigned v4u __attribute__((ext_vector_type(4)));
typedef unsigned v2u __attribute__((ext_vector_type(2)));
typedef float f32x4 __attribute__((ext_vector_type(4)));
typedef GAS unsigned gu32;
#define LDS_WAIT() asm volatile("s_waitcnt lgkmcnt(0)" ::: "memory")
#define VM_WAIT() asm volatile("s_waitcnt vmcnt(0)" ::: "memory")
__device__ __forceinline__ unsigned f2bf(float f) { unsigned u = __builtin_bit_cast(unsigned, f); return (u + 0x7fffu + ((u >> 16) & 1u)) >> 16; }
__device__ __forceinline__ unsigned pk2(float lo, float hi) { return f2bf(lo) | (f2bf(hi) << 16); }
__device__ __forceinline__ float bf2f(bf16 h) { return __uint_as_float(((unsigned)h) << 16); }
__device__ __forceinline__ float bflo(unsigned w) { return __uint_as_float(w << 16); }
__device__ __forceinline__ float bfhi(unsigned w) { return __uint_as_float(w & 0xffff0000u); }
__device__ __forceinline__ float gelu_erf(float v) { return 0.5f * v * (1.0f + erff(v * 0.70710678118654752f)); }
__device__ __forceinline__ float wave_sum(float v) {
#pragma unroll
    for (int o = 1; o < 64; o <<= 1) v += __shfl_xor(v, o);
    return v;
}

#define XB_TMO      128
#define XB_XCNT(j)  (256  + 64 * (j))
#define XB_XSUB(j)  (1280 + 64 * (j))
#define XB_XGEN(j)  (2304 + 64 * (j))
#define XB_TOP      3328
#define XB_TOPGEN   3392
#define XCD_BAR_WORDS 3456
#define XB_SPIN_CAP (1u << 18)

__device__ __forceinline__ unsigned xb_ld(unsigned* p)              { return __hip_atomic_load(p, __ATOMIC_RELAXED, __HIP_MEMORY_SCOPE_AGENT); }
__device__ __forceinline__ unsigned xb_add(unsigned* p, unsigned v) { return __hip_atomic_fetch_add(p, v, __ATOMIC_RELAXED, __HIP_MEMORY_SCOPE_AGENT); }
__device__ __forceinline__ unsigned xb_xcc_id() { return (unsigned)__builtin_amdgcn_s_getreg((3 << 11) | 20) & 0xFu; }
#define XB_SPIN(cond, bar) do { unsigned _sp = 0; while (cond) { __builtin_amdgcn_s_sleep(1); \
    if ((++_sp & 255u) == 0u) { if (xb_ld(&(bar)[XB_TMO])) break; if (_sp > XB_SPIN_CAP) { atomicAdd(&(bar)[XB_TMO], 1u); break; } } } } while (0)

struct XcdBarrier {
    unsigned* bar; unsigned x;
    volatile LAS unsigned* st;
};

__device__ __forceinline__ XcdBarrier xcd_barrier_post(unsigned* bar, volatile LAS unsigned* st) {
    XcdBarrier b; b.bar = bar; b.x = xb_xcc_id(); b.st = st;
    if (threadIdx.x == 0) (void)xb_add(&bar[XB_XCNT(b.x)], 1u);
    return b;
}
__device__ __forceinline__ void xcd_barrier_complete(unsigned* bar, unsigned x, unsigned& nloc, unsigned& nx) {
    const unsigned G = gridDim.x * gridDim.y * gridDim.z;
    unsigned sum, cnt, mine, sp = 0u;
    for (;;) {
        sum = 0u; cnt = 0u; mine = 0u;
#pragma unroll
        for (unsigned j = 0; j < 16; ++j) { const unsigned c = xb_ld(&bar[XB_XCNT(j)]); sum += c; cnt += (c > 0u) ? 1u : 0u; mine = (j == x) ? c : mine; }
        if (sum == G) break;
        __builtin_amdgcn_s_sleep(1);
        if ((++sp & 255u) == 0u) { if (xb_ld(&bar[XB_TMO])) break; if (sp > XB_SPIN_CAP) { atomicAdd(&bar[XB_TMO], 1u); break; } }
    }
    nloc = mine > 0u ? mine : 1u; nx = cnt > 0u ? cnt : 1u;
}

__device__ __forceinline__ void xcd_barrier_t0(const XcdBarrier& b) {
    {
        unsigned* bar = b.bar;
        __builtin_amdgcn_s_waitcnt(0);
        unsigned nloc = b.st[0], nx = b.st[1];
        if (nloc == 0u) { xcd_barrier_complete(bar, b.x, nloc, nx); b.st[0] = nloc; b.st[1] = nx; }
        const unsigned old = xb_add(&bar[XB_XSUB(b.x)], 1u);
        const unsigned gen = old / nloc;
        if (old + 1u == (gen + 1u) * nloc) {
            __builtin_amdgcn_fence(__ATOMIC_RELEASE, "agent");
            asm volatile("s_waitcnt vmcnt(0)" ::: "memory");
            const unsigned og = xb_add(&bar[XB_TOP], 1u);
            const unsigned tg = og / nx;
            if (og + 1u == (tg + 1u) * nx) xb_add(&bar[XB_TOPGEN], 1u);
            else XB_SPIN(xb_ld(&bar[XB_TOPGEN]) == tg, bar);
            __builtin_amdgcn_fence(__ATOMIC_ACQUIRE, "agent");
            xb_add(&bar[XB_XGEN(b.x)], 1u);
            asm volatile("s_waitcnt vmcnt(0)" ::: "memory");
        } else {
            XB_SPIN(xb_ld(&bar[XB_XGEN(b.x)]) == gen, bar);
            __builtin_amdgcn_fence(__ATOMIC_ACQUIRE, "agent");
            asm volatile("s_waitcnt vmcnt(0)" ::: "memory");
        }
    }
}
__device__ __forceinline__ void xcd_barrier(const XcdBarrier& b) {
    asm volatile("s_waitcnt vmcnt(0)" ::: "memory");
    __syncthreads();
    if (threadIdx.x == 0) xcd_barrier_t0(b);
    __syncthreads();
}
template <class Pre> __device__ __forceinline__ void xcd_barrier_pre(const XcdBarrier& b, const Pre& pre) {
    asm volatile("s_waitcnt vmcnt(0)" ::: "memory");
    __syncthreads();
    const int w_ = __builtin_amdgcn_readfirstlane((int)threadIdx.x >> 6);
    if (w_ != 0) pre();
    if (threadIdx.x == 0) xcd_barrier_t0(b);
    __syncthreads();
    if (w_ == 0) pre();
}

struct Ctx { LAS unsigned char* lds; int tid, lane, wave, G, bid; };

__device__ __forceinline__ void p0_transpose_item(const float* W, int K, int N, bf16* WT, LAS float* scr, int item, int lane) {
    const int nblk = N / 32, kb = item / nblk, nb = item % nblk, k0 = 64 * kb, n0 = 32 * nb;
    float wv[32];
#pragma unroll
    for (int i = 0; i < 32; ++i) wv[i] = W[(size_t)(k0 + 2 * i + (lane >> 5)) * N + n0 + (lane & 31)];
#pragma unroll
    for (int i = 0; i < 32; ++i) scr[(2 * i + (lane >> 5)) * 33 + (lane & 31)] = wv[i];
    LDS_WAIT(); asm volatile("" ::: "memory");
    const int c = lane & 7;
#pragma unroll
    for (int j = 0; j < 4; ++j) { const int n = (lane >> 3) + 8 * j; const LAS float* s = scr + (8 * c) * 33 + n;
        v4u o; o.x = pk2(s[0 * 33], s[1 * 33]); o.y = pk2(s[2 * 33], s[3 * 33]); o.z = pk2(s[4 * 33], s[5 * 33]); o.w = pk2(s[6 * 33], s[7 * 33]);
        *(v4u*)(WT + (size_t)(n0 + n) * K + k0 + 8 * c) = o; }
    LDS_WAIT(); asm volatile("" ::: "memory");
}
__device__ __forceinline__ void rms_row_to_bf16(const float* xr, const float* g, bf16* orow, int lane) {
    f32x4 v[8]; float s = 0.f;
#pragma unroll
    for (int j = 0; j < 8; ++j) { v[j] = *(const f32x4*)(xr + j * 256 + lane * 4); s += (v[j].x * v[j].x + v[j].y * v[j].y) + (v[j].z * v[j].z + v[j].w * v[j].w); }
    const float r = rsqrtf(wave_sum(s) * (1.f / D) + EPS);
#pragma unroll
    for (int j = 0; j < 8; ++j) { const f32x4 gg = *(const f32x4*)(g + j * 256 + lane * 4);
        v2u o; o.x = pk2(v[j].x * r * gg.x, v[j].y * r * gg.y); o.y = pk2(v[j].z * r * gg.z, v[j].w * r * gg.w);
        *(v2u*)(orow + j * 256 + lane * 4) = o; }
}
typedef float f32x2 __attribute__((ext_vector_type(2)));
typedef __bf16 bf16x2v __attribute__((ext_vector_type(2)));
__device__ __forceinline__ unsigned cvtpk(float lo, float hi) { const f32x2 v = {lo, hi}; return __builtin_bit_cast(unsigned, __builtin_convertvector(v, bf16x2v)); }
typedef short bf16x8 __attribute__((ext_vector_type(8)));
typedef float f32x16 __attribute__((ext_vector_type(16)));
__device__ __forceinline__ bf16x8 pack8(float a0, float a1, float a2, float a3, float a4, float a5, float a6, float a7) {
    v4u w; w.x = cvtpk(a0, a1); w.y = cvtpk(a2, a3); w.z = cvtpk(a4, a5); w.w = cvtpk(a6, a7); return __builtin_bit_cast(bf16x8, w); }
__device__ __forceinline__ void split8(const f32x4 a0, const f32x4 a1, bf16x8& hi, bf16x8& lo) {
    hi = pack8(a0[0], a0[1], a0[2], a0[3], a1[0], a1[1], a1[2], a1[3]);
    const v4u w = __builtin_bit_cast(v4u, hi);
    lo = pack8(a0[0] - bflo(w[0]), a0[1] - bfhi(w[0]), a0[2] - bflo(w[1]), a0[3] - bfhi(w[1]), a1[0] - bflo(w[2]), a1[1] - bfhi(w[2]), a1[2] - bflo(w[3]), a1[3] - bfhi(w[3]));
}
typedef __bf16 bf16x32 __attribute__((ext_vector_type(32)));
typedef unsigned v6u __attribute__((ext_vector_type(6)));
typedef float f32x32 __attribute__((ext_vector_type(32)));
__device__ __forceinline__ void p0_rows_to_fp6(const float* ra, const float* rb, unsigned char* da, unsigned char* db, float* ia, float* ib, int lane) {
    f32x4 va[8], vb[8]; float ma = 0.f, mb = 0.f;
#pragma unroll
    for (int i = 0; i < 8; ++i) { va[i] = __builtin_nontemporal_load((const f32x4*)(ra + i * 256 + lane * 4)); vb[i] = __builtin_nontemporal_load((const f32x4*)(rb + i * 256 + lane * 4)); }
#pragma unroll
    for (int i = 0; i < 8; ++i) { const f32x4 t = va[i], u = vb[i];
        ma = fmaxf(fmaxf(ma, fmaxf(fabsf(t.x), fabsf(t.y))), fmaxf(fabsf(t.z), fabsf(t.w))); mb = fmaxf(fmaxf(mb, fmaxf(fabsf(u.x), fabsf(u.y))), fmaxf(fabsf(u.z), fabsf(u.w))); }
#pragma unroll
    for (int o = 1; o < 64; o <<= 1) { ma = fmaxf(ma, __shfl_xor(ma, o)); mb = fmaxf(mb, __shfl_xor(mb, o)); }
    const float sa = ma > 0.f ? 7.f / ma : 0.f, sb = mb > 0.f ? 7.f / mb : 0.f;
    bf16x32 xa, xb;
#pragma unroll
    for (int k = 0; k < 32; ++k) { xa[k] = (__bf16)(va[k >> 2][k & 3] * sa); xb[k] = (__bf16)(vb[k >> 2][k & 3] * sb); }
    const v6u pa = __builtin_amdgcn_cvt_scalef32_pk32_fp6_bf16(xa, 1.0f), pb = __builtin_amdgcn_cvt_scalef32_pk32_fp6_bf16(xb, 1.0f);
#pragma unroll
    for (int q = 0; q < 3; ++q) { *(v2u*)(da + 24 * lane + 8 * q) = (v2u){pa[2 * q], pa[2 * q + 1]}; *(v2u*)(db + 24 * lane + 8 * q) = (v2u){pb[2 * q], pb[2 * q + 1]}; }
    if (lane == 0) { *ia = ma * (1.f / 7.f); *ib = mb * (1.f / 7.f); }
}
constexpr int CONV_SPLIT = 12800;
__device__ __forceinline__ void convert_rows(const float* e_down, const float* e_up, unsigned char* ED, unsigned char* EU, float* SD, float* SU, int r_lo, int r_hi, int w, int nw, int lane) {
    for (int r = r_lo + 2 * w; r < r_hi; r += 2 * nw) {
        const bool up = r >= NE; const int row = up ? r - NE : r;
        const float* s = (up ? e_up : e_down) + (size_t)row * D; unsigned char* d = (up ? EU : ED) + (size_t)row * ROWB; float* iv = (up ? SU : SD) + row;
        p0_rows_to_fp6(s, s + D, d, d + ROWB, iv, iv + 1, lane);
    }
}
__device__ __forceinline__ void p0_prologue(const Ctx& F, const float* x, const float* g1, const float* w_in, const float* w_out, const float* wq, const float* sk,
                                            const float* e_down, const float* e_up, bf16* WinT, bf16* WoutT, bf16* WeffT, bf16* H, unsigned char* ED, unsigned char* EU, float* SD, float* SU, const float* g2) {
    const int gw = F.bid * NWAVES + F.wave, NGW = F.G * NWAVES;
#if defined(TP_PHASE) && TP_PHASE == 12
    volatile unsigned long long* tsp12 = (volatile unsigned long long*)((unsigned char*)SD + 196608);
    if (F.bid == 0 && F.tid == 0) tsp12[0] = wall_clock64();
#endif
    for (int ph = 0; ph < 2; ++ph) {
    if ((ph == 0) == (((F.bid >> 3) & 1) == 0)) {
    {
        LAS float* scr = (LAS float*)(F.lds + RING_OFF + F.wave * 16384);
        constexpr int I_IN = (D / 64) * (NIN / 32), I_OUT = (D / 64) * (D / 32);
        for (int it = gw; it < I_IN + I_OUT; it += NGW) {
            if (it < I_IN) p0_transpose_item(w_in, D, NIN, WinT, scr, it, F.lane);
            else p0_transpose_item(w_out, D, D, WoutT, scr, it - I_IN, F.lane);
        }
    }
    __syncthreads();
    for (int it = gw; it < 16 * 64 * 2; it += NGW) {
        const int g = it & 15, dtile = (it >> 4) & 63, kh = it >> 10, p = g & 1, c = F.lane & 31, h = F.lane >> 5;
        const float* arow = wq + (size_t)(dtile * 32 + c) * 2048 + g * 128 + 8 * h;
        bf16x8 ah[8], al[8];
#pragma unroll
        for (int ks = 0; ks < 8; ++ks) { const f32x4 a0 = *(const f32x4*)(arow + 16 * ks), a1 = *(const f32x4*)(arow + 16 * ks + 4); split8(a0, a1, ah[ks], al[ks]); }
#pragma unroll 1
        for (int kt = 0; kt < 2; ++kt) {
            const int k0 = (kh * 2 + kt) * 32;
            const float* brow = sk + (size_t)(p * 128 + k0 + c) * 128 + 8 * h;
            f32x16 acc;
#pragma unroll
            for (int i = 0; i < 16; ++i) acc[i] = 0.f;
#pragma unroll
            for (int ks = 0; ks < 8; ++ks) { const f32x4 b0 = *(const f32x4*)(brow + 16 * ks), b1 = *(const f32x4*)(brow + 16 * ks + 4); bf16x8 bh, bl; split8(b0, b1, bh, bl);
                acc = __builtin_amdgcn_mfma_f32_32x32x16_bf16(al[ks], bh, acc, 0, 0, 0); acc = __builtin_amdgcn_mfma_f32_32x32x16_bf16(ah[ks], bl, acc, 0, 0, 0);
                acc = __builtin_amdgcn_mfma_f32_32x32x16_bf16(ah[ks], bh, acc, 0, 0, 0); }
            bf16* orow = WeffT + (size_t)(g * 128 + k0 + c) * 2048 + dtile * 32 + 4 * h;
#pragma unroll
            for (int q = 0; q < 4; ++q) { const f32x4 gq = *(const f32x4*)(g2 + dtile * 32 + 4 * h + 8 * q);
                v2u o; o.x = cvtpk(acc[4 * q] * gq[0], acc[4 * q + 1] * gq[1]); o.y = cvtpk(acc[4 * q + 2] * gq[2], acc[4 * q + 3] * gq[3]); *(v2u*)(orow + 8 * q) = o; }
        }
    }
#if defined(TP_PHASE) && TP_PHASE == 12
    __syncthreads(); if (F.bid == 0 && F.tid == 0) tsp12[1] = wall_clock64() - tsp12[0];
#endif
    } else {
    for (int rep_ = 0; rep_ < REP_P0C; ++rep_) convert_rows(e_down, e_up, ED, EU, SD, SU, 0, CONV_SPLIT, gw, NGW, F.lane);
    for (int m = gw; m < T; m += NGW) rms_row_to_bf16(x + (size_t)m * D, g1, H + (size_t)m * D, F.lane);
    }
    }
}

constexpr int SGU_VS = 136;
__device__ __forceinline__ void p2_sgu(const Ctx& F, const bf16* Z, const float* ln_g, const float* ln_b, const float* w_s, const float* b_s, bf16* MIX) {
    LAS bf16* vnT = (LAS bf16*)(F.lds + RING_OFF);
    LAS float* ps = (LAS float*)(F.lds + RING_OFF + 128 * SGU_VS * 2);
    LAS float* pq = ps + 512;
    const int s = F.tid & 127, dq = F.tid >> 7;
    const int c = F.lane & 31, h = F.lane >> 5, tt = F.wave >> 1;
    for (int unit = F.bid; unit < 512; unit += F.G) {
        const int g = unit & 7, t0 = (unit >> 3) * 128;
        __syncthreads();
        float v[32];
        { const bf16* vr = Z + (size_t)(t0 + s) * NIN + 1024 + g * 128 + dq * 32;
#pragma unroll
          for (int j = 0; j < 4; ++j) { const v4u q = *(const v4u*)(vr + 8 * j);
#pragma unroll
              for (int e = 0; e < 4; ++e) { v[8 * j + 2 * e] = bflo(q[e]); v[8 * j + 2 * e + 1] = bfhi(q[e]); } } }
        float sm = 0.f;
#pragma unroll
        for (int j = 0; j < 32; ++j) sm += v[j];
        ps[dq * 128 + s] = sm;
        __syncthreads();
        const float mean = (ps[s] + ps[128 + s] + ps[256 + s] + ps[384 + s]) * (1.f / 128.f);
        float sq = 0.f;
#pragma unroll
        for (int j = 0; j < 32; ++j) { v[j] -= mean; sq += v[j] * v[j]; }
        pq[dq * 128 + s] = sq;
        __syncthreads();
        const float rstd = rsqrtf((pq[s] + pq[128 + s] + pq[256 + s] + pq[384 + s]) * (1.f / 128.f) + EPS);
#pragma unroll
        for (int j = 0; j < 32; ++j) { const int d = dq * 32 + j; vnT[d * SGU_VS + s] = (bf16)f2bf(v[j] * rstd * ln_g[g * 128 + d] + ln_b[g * 128 + d]); }
        __syncthreads();
        f32x16 acc[2];
#pragma unroll
        for (int a = 0; a < 2; ++a)
#pragma unroll
            for (int i = 0; i < 16; ++i) acc[a][i] = 0.f;
        const int trow = 32 * tt + c;
        const float* wrow = w_s + ((size_t)g * 128 + trow) * 128;
        const int dt0 = 2 * (F.wave & 1);
        for (int ks = 0; ks < 2 * (tt + 1); ++ks) {
            const int s0 = 16 * ks + 8 * h;
            const f32x4 w0 = *(const f32x4*)(wrow + s0), w1 = *(const f32x4*)(wrow + s0 + 4);
            float w[8] = {w0[0], w0[1], w0[2], w0[3], w1[0], w1[1], w1[2], w1[3]};
#pragma unroll
            for (int j = 0; j < 8; ++j) w[j] = (s0 + j <= trow) ? w[j] : 0.f;
            const bf16x8 bf = pack8(w[0], w[1], w[2], w[3], w[4], w[5], w[6], w[7]);
#pragma unroll
            for (int a = 0; a < 2; ++a) { const bf16x8 af = *(const LAS bf16x8*)(vnT + (32 * (dt0 + a) + c) * SGU_VS + s0);
                acc[a] = __builtin_amdgcn_mfma_f32_32x32x16_bf16(af, bf, acc[a], 0, 0, 0); }
        }
        const float bias = b_s[g * 128 + trow];
        const size_t tok = (size_t)(t0 + trow);
#pragma unroll
        for (int a = 0; a < 2; ++a)
#pragma unroll
            for (int q = 0; q < 4; ++q) { const int d0 = 32 * (dt0 + a) + 8 * q + 4 * h;
                const v2u uu = *(const v2u*)(Z + tok * NIN + g * 128 + d0);
                v2u o; o.x = cvtpk(bflo(uu.x) * (acc[a][4 * q] + bias), bfhi(uu.x) * (acc[a][4 * q + 1] + bias));
                o.y = cvtpk(bflo(uu.y) * (acc[a][4 * q + 2] + bias), bfhi(uu.y) * (acc[a][4 * q + 3] + bias));
                *(v2u*)(MIX + tok * D + g * 128 + d0) = o; }
    }
}
constexpr int ATT_KS = 72, ATT_VS = 264;
__device__ __forceinline__ void p2_attn(const Ctx& F, const bf16* Z, const float* sinks, bf16* MIX) {
    LAS bf16* Ks = (LAS bf16*)(F.lds + RING_OFF);
    LAS bf16* Vt = (LAS bf16*)(F.lds + RING_OFF + 256 * ATT_KS * 2);
    const int c = F.lane & 31, h = F.lane >> 5;
    for (int unit = F.bid; unit < 256; unit += F.G) {
        const int hg = unit & 1, hk = (unit >> 1) & 1, n = (unit >> 2) & 15, b = unit >> 6;
        __syncthreads();
        for (int e = F.tid; e < 256 * 8; e += NTHR) {
            const int j = e >> 3, ch = e & 7, pos = (n - 1) * 128 + j;
            v4u kv = (v4u){0u, 0u, 0u, 0u}, vv = (v4u){0u, 0u, 0u, 0u};
            if (pos >= 0) { const bf16* row = Z + ((size_t)b * SEQ + pos) * NIN; kv = *(const v4u*)(row + 3072 + hk * 64 + ch * 8); vv = *(const v4u*)(row + 3200 + hk * 64 + ch * 8); }
            *(LAS v4u*)(Ks + j * ATT_KS + ch * 8) = kv;
#pragma unroll
            for (int jj = 0; jj < 8; ++jj) Vt[(ch * 8 + jj) * ATT_VS + j] = (bf16)((vv[jj >> 1] >> (16 * (jj & 1))) & 0xffffu);
        }
        __syncthreads();
        for (int tk = 0; tk < 2; ++tk) {
            const int hq = hk * 8 + hg * 4 + (F.wave >> 1), i0 = 32 * (2 * (F.wave & 1) + tk);
            const size_t tok = (size_t)b * SEQ + n * 128 + i0 + c;
            const bf16* qrow = Z + tok * NIN + 2048 + hq * 64;
            bf16x8 qf[4];
#pragma unroll
            for (int ks = 0; ks < 4; ++ks) qf[ks] = *(const bf16x8*)(qrow + 16 * ks + 8 * h);
            f32x16 sT[5];
#pragma unroll
            for (int kt = 0; kt < 5; ++kt) {
#pragma unroll
                for (int i = 0; i < 16; ++i) sT[kt][i] = 0.f;
#pragma unroll
                for (int ks = 0; ks < 4; ++ks) { const bf16x8 kf = *(const LAS bf16x8*)(Ks + (i0 + 32 * kt + c) * ATT_KS + 16 * ks + 8 * h);
                    sT[kt] = __builtin_amdgcn_mfma_f32_32x32x16_bf16(kf, qf[ks], sT[kt], 0, 0, 0); }
            }
            const float sink = sinks[hq]; float m = sink;
#pragma unroll
            for (int kt = 0; kt < 5; ++kt) {
                const bool tile_ok = (n > 0) || (i0 + 32 * kt >= 128);
#pragma unroll
                for (int i = 0; i < 16; ++i) { const int jj = (i & 3) + 8 * (i >> 2) + 4 * h;
                    bool ok = tile_ok; if (kt == 0) ok = ok && (jj > c); if (kt == 4) ok = ok && (jj <= c);
                    const float x = ok ? sT[kt][i] * 0.125f : -INFINITY; sT[kt][i] = x; m = fmaxf(m, x); }
            }
            m = fmaxf(m, __shfl_xor(m, 32));
            float l = 0.f;
#pragma unroll
            for (int kt = 0; kt < 5; ++kt)
#pragma unroll
                for (int i = 0; i < 16; ++i) { const float p = __expf(sT[kt][i] - m); sT[kt][i] = p; l += p; }
            l += __shfl_xor(l, 32); l += __expf(sink - m);
            f32x16 o[2];
#pragma unroll
            for (int a = 0; a < 2; ++a)
#pragma unroll
                for (int i = 0; i < 16; ++i) o[a][i] = 0.f;
#pragma unroll
            for (int kt = 0; kt < 5; ++kt)
#pragma unroll
                for (int st = 0; st < 2; ++st) {
                    const bf16x8 pf = pack8(sT[kt][8 * st], sT[kt][8 * st + 1], sT[kt][8 * st + 2], sT[kt][8 * st + 3], sT[kt][8 * st + 4], sT[kt][8 * st + 5], sT[kt][8 * st + 6], sT[kt][8 * st + 7]);
                    const int key0 = i0 + 32 * kt + 16 * st + 4 * h;
#pragma unroll
                    for (int a = 0; a < 2; ++a) { const LAS bf16* vp = Vt + (32 * a + c) * ATT_VS + key0;
                        const v2u lo = *(const LAS v2u*)vp, hi = *(const LAS v2u*)(vp + 8);
                        const v4u vw = (v4u){lo.x, lo.y, hi.x, hi.y};
                        o[a] = __builtin_amdgcn_mfma_f32_32x32x16_bf16(__builtin_bit_cast(bf16x8, vw), pf, o[a], 0, 0, 0); }
                }
            const float inv = 1.f / l;
#pragma unroll
            for (int a = 0; a < 2; ++a)
#pragma unroll
                for (int q = 0; q < 4; ++q) { const int d0 = 32 * a + 8 * q + 4 * h;
                    v2u w; w.x = cvtpk(o[a][4 * q] * inv, o[a][4 * q + 1] * inv); w.y = cvtpk(o[a][4 * q + 2] * inv, o[a][4 * q + 3] * inv);
                    *(v2u*)(MIX + tok * D + 1024 + hq * 64 + d0) = w; }
        }
    }
}

typedef __bf16 bf16x2_t __attribute__((ext_vector_type(2)));
constexpr int P5_TOK = 32;
constexpr int P5_WL = 2048;
__device__ __forceinline__ unsigned fkey(float f) { const unsigned u = __float_as_uint(f); return (u & 0x80000000u) ? ~u : (u | 0x80000000u); }
__device__ __forceinline__ float dot2bf(unsigned a, unsigned b, float c) { return __builtin_amdgcn_fdot2_f32_bf16(__builtin_bit_cast(bf16x2_t, a), __builtin_bit_cast(bf16x2_t, b), c, false); }
template <int CTRL, int RM, bool BC> __device__ __forceinline__ float dpp_f(float v) { return __builtin_bit_cast(float, __builtin_amdgcn_update_dpp(0, __builtin_bit_cast(int, v), CTRL, RM, 0xf, BC)); }
struct WaveLds { LAS int* eid; LAS float* gate; LAS float* sv; LAS float* tv; LAS int* ti; LAS int* ctab; };
template <int CTRL> __device__ __forceinline__ unsigned dppx_u(unsigned v) { return (unsigned)__builtin_amdgcn_update_dpp(0, (int)v, CTRL, 0xf, 0xf, true); }
template <int CTRL> __device__ __forceinline__ float dppx_f(float v) { return __builtin_bit_cast(float, __builtin_amdgcn_update_dpp(0, __builtin_bit_cast(int, v), CTRL, 0xf, 0xf, true)); }
__device__ __forceinline__ unsigned umax(unsigned a, unsigned b) { return a > b ? a : b; }
__device__ __forceinline__ unsigned umin(unsigned a, unsigned b) { return a < b ? a : b; }
__device__ __forceinline__ unsigned row_allmax_u(unsigned m) {
    m = umax(m, dppx_u<0xB1>(m)); m = umax(m, dppx_u<0x4E>(m)); m = umax(m, dppx_u<0x141>(m)); m = umax(m, dppx_u<0x140>(m)); return m; }
__device__ __forceinline__ float row_allmax_f(float m) { m = fmaxf(m, dppx_f<0xB1>(m)); m = fmaxf(m, dppx_f<0x4E>(m)); m = fmaxf(m, dppx_f<0x141>(m)); m = fmaxf(m, dppx_f<0x140>(m)); return m; }
__device__ __forceinline__ float row_allsum_f(float m) { m += dppx_f<0xB1>(m); m += dppx_f<0x4E>(m); m += dppx_f<0x141>(m); m += dppx_f<0x140>(m); return m; }
#define P5_CE(a, b) do { const unsigned _h = umax(a, b), _l = umin(a, b); a = _h; b = _l; } while (0)
__device__ __forceinline__ int cand_pair(int c) {
    return c < 16 ? c : c < 24 ? (1 << 4) | (c - 16) : c < 29 ? (2 << 4) | (c - 24) : c < 33 ? (3 << 4) | (c - 29) : c < 36 ? (4 << 4) | (c - 33) : c < 38 ? (5 << 4) | (c - 36)
         : c < 40 ? (6 << 4) | (c - 38) : c < 42 ? (7 << 4) | (c - 40) : c < 50 ? ((c - 34) << 4) : 0xff;
}
__device__ __forceinline__ void p5_topk_fetch(const WaveLds& W, const float* src, int half, int lane) {
#pragma unroll
    for (int i = 0; i < 4; ++i) __builtin_amdgcn_global_load_lds((const unsigned*)(src + i * 256 + lane * 4), (LAS unsigned*)(W.sv + half * 1024 + i * 256), 16, 0, 0);
}
__device__ __forceinline__ void p5_topk_token(const WaveLds& W, const float* sc  , const float* sc_next, float rs  , int lane) {
    const int r = lane >> 4, l15 = lane & 15;
#pragma unroll 1
    for (int pp = 0; pp < 2; ++pp) {
        unsigned k[2][8]; unsigned top[2] = {0u, 0u};
        asm volatile("s_waitcnt vmcnt(0)" ::: "memory");
        { const float* nsrc = pp == 0 ? sc + 1024 : sc_next; if (nsrc != nullptr) p5_topk_fetch(W, nsrc, 1 - pp, lane); }
#pragma unroll
        for (int u = 0; u < 2; ++u) {
            const int L = 4 * (2 * pp + u) + r;
            const f32x4 v0 = *(const LAS f32x4*)(W.sv + L * 128 + 8 * l15) * rs, v1 = *(const LAS f32x4*)(W.sv + L * 128 + 8 * l15 + 4) * rs;
#pragma unroll
            for (int j = 0; j < 4; ++j) { k[u][j] = (fkey(v0[j]) & ~127u) | (unsigned)(127 - (8 * l15 + j)); k[u][4 + j] = (fkey(v1[j]) & ~127u) | (unsigned)(127 - (8 * l15 + 4 + j)); }
            P5_CE(k[u][0], k[u][1]); P5_CE(k[u][2], k[u][3]); P5_CE(k[u][4], k[u][5]); P5_CE(k[u][6], k[u][7]);
            P5_CE(k[u][0], k[u][2]); P5_CE(k[u][1], k[u][3]); P5_CE(k[u][4], k[u][6]); P5_CE(k[u][5], k[u][7]);
            P5_CE(k[u][1], k[u][2]); P5_CE(k[u][5], k[u][6]);
            P5_CE(k[u][0], k[u][4]); P5_CE(k[u][1], k[u][5]); P5_CE(k[u][2], k[u][6]); P5_CE(k[u][3], k[u][7]);
            P5_CE(k[u][2], k[u][4]); P5_CE(k[u][3], k[u][5]);
            P5_CE(k[u][1], k[u][2]); P5_CE(k[u][3], k[u][4]); P5_CE(k[u][5], k[u][6]);
        }
#pragma unroll 4
        for (int it = 0; it < 16; ++it) {
#pragma unroll
            for (int u = 0; u < 2; ++u) {
                const unsigned m = row_allmax_u(k[u][0]); const bool sel = k[u][0] == m;
                top[u] = (l15 == it) ? m : top[u];
#pragma unroll
                for (int j = 0; j < 7; ++j) k[u][j] = sel ? k[u][j + 1] : k[u][j];
                k[u][7] = sel ? 0u : k[u][7];
            }
        }
        LDS_WAIT(); __builtin_amdgcn_wave_barrier();
#pragma unroll
        for (int u = 0; u < 2; ++u) { const int L = 4 * (2 * pp + u) + r; const int idx = 127 - (int)(top[u] & 127u);
            W.tv[L * 16 + l15] = W.sv[L * 128 + idx] * rs; W.ti[L * 16 + l15] = idx; }
    }
    LDS_WAIT(); __builtin_amdgcn_wave_barrier();
    int cij[4];
#pragma unroll
    for (int j = 0; j < 4; ++j) cij[j] = cand_pair(4 * l15 + j);
    unsigned ck[2][4]; unsigned top2[2] = {0u, 0u};
#pragma unroll
    for (int u = 0; u < 2; ++u) {
        const int hd = 4 * u + r; const LAS float* tv0 = W.tv + (2 * hd) * 16; const LAS float* tv1 = tv0 + 16;
#pragma unroll
        for (int j = 0; j < 4; ++j) { const float cs = tv0[(cij[j] >> 4) & 15] + tv1[cij[j] & 15]; const int s = 4 * l15 + j;
            ck[u][j] = (s < 50) ? ((fkey(cs) & ~63u) | (unsigned)(63 - s)) : 0u; }
        P5_CE(ck[u][0], ck[u][1]); P5_CE(ck[u][2], ck[u][3]); P5_CE(ck[u][0], ck[u][2]); P5_CE(ck[u][1], ck[u][3]); P5_CE(ck[u][1], ck[u][2]);
    }
#pragma unroll 4
    for (int it = 0; it < 16; ++it) {
#pragma unroll
        for (int u = 0; u < 2; ++u) {
            const unsigned m = row_allmax_u(ck[u][0]); const bool sel = ck[u][0] == m;
            top2[u] = (l15 == it) ? m : top2[u];
            ck[u][0] = sel ? ck[u][1] : ck[u][0]; ck[u][1] = sel ? ck[u][2] : ck[u][1]; ck[u][2] = sel ? ck[u][3] : ck[u][2]; ck[u][3] = sel ? 0u : ck[u][3];
        }
    }
#pragma unroll
    for (int u = 0; u < 2; ++u) {
        const int hd = 4 * u + r; const LAS float* tv0 = W.tv + (2 * hd) * 16; const LAS float* tv1 = tv0 + 16; const LAS int* ti0 = W.ti + (2 * hd) * 16; const LAS int* ti1 = ti0 + 16;
        const int ij = W.ctab[63 - (int)(top2[u] & 63u)];
        const int i1 = (ij >> 4) & 15, j1 = ij & 15;
        const float vs = tv0[i1] + tv1[j1]; const int e = ti0[i1] * 128 + ti1[j1];
        const float mx = row_allmax_f(vs), ex = __expf(vs - mx), sm = row_allsum_f(ex);
        W.gate[hd * 16 + l15] = ex / sm; W.eid[hd * 16 + l15] = e;
    }
    LDS_WAIT(); __builtin_amdgcn_wave_barrier();
}
constexpr int P5_R = 9;
constexpr int P5_NSL = 8, P5_SLSH = 11;
#ifndef REP_TOPK
#define REP_TOPK 1
#endif
#ifndef REP_DS
#define REP_DS 1
#endif
constexpr int P5_WL2 = 20480;
struct SweepLds { LAS unsigned char* ring; LAS int* feid; LAS float* fcf; LAS float* raw; };
__device__ __forceinline__ int mbcnt64(unsigned long long m) { return __builtin_amdgcn_mbcnt_hi((unsigned)(m >> 32), __builtin_amdgcn_mbcnt_lo((unsigned)m, 0u)); }
template <int CTRL, int RM, bool BC> __device__ __forceinline__ int dpp_i(int v) { return __builtin_amdgcn_update_dpp(0, v, CTRL, RM, 0xf, BC); }
__device__ __forceinline__ float wave_total63(float v) {
    v += dpp_f<0x111, 0xf, true>(v); v += dpp_f<0x112, 0xf, true>(v); v += dpp_f<0x114, 0xf, true>(v); v += dpp_f<0x118, 0xf, true>(v);
    v += dpp_f<0x142, 0xa, false>(v); v += dpp_f<0x143, 0xc, false>(v); return v; }
__device__ __forceinline__ int wave_incl_scan(int v) {
    v += dpp_i<0x111, 0xf, true>(v); v += dpp_i<0x112, 0xf, true>(v); v += dpp_i<0x114, 0xf, true>(v); v += dpp_i<0x118, 0xf, true>(v);
    v += dpp_i<0x142, 0xa, false>(v); v += dpp_i<0x143, 0xc, false>(v); return v; }
#define P5_WRAP(x) ((x) + ROWB == P5_R * ROWB ? 0 : (x) + ROWB)
#define P5_ISSUE(tab, id_) do { const unsigned char* _gp = (tab) + (size_t)(id_) * ROWB + lane * 16; LAS unsigned char* _lp = L.ring + pslot; \
    __builtin_amdgcn_global_load_lds((const unsigned*)_gp, (LAS unsigned*)_lp, 16, 0, 0);                         \
    __builtin_amdgcn_global_load_lds((const unsigned*)_gp, (LAS unsigned*)_lp, 16, 512, 0);                       \
    pslot = P5_WRAP(pslot); } while (0)
#define P5_ROWREAD(dst_, slot_) do { const LAS unsigned char* _rp = L.ring + (slot_) + lane * 24; const v2u _a = *(const LAS v2u*)_rp, _b = *(const LAS v2u*)(_rp + 8), _c = *(const LAS v2u*)(_rp + 16); \
    dst_[0] = (int)_a.x; dst_[1] = (int)_a.y; dst_[2] = (int)_b.x; dst_[3] = (int)_b.y; dst_[4] = (int)_c.x; dst_[5] = (int)_c.y; } while (0)
typedef int v8i __attribute__((ext_vector_type(8)));
#define P5_V6(x_) ((v6u){(unsigned)x_[0], (unsigned)x_[1], (unsigned)x_[2], (unsigned)x_[3], (unsigned)x_[4], (unsigned)x_[5]})
#define P5_FEID(i_) __builtin_amdgcn_readfirstlane(L.feid[(i_)])
typedef _Float16 f16x32 __attribute__((ext_vector_type(32)));
typedef _Float16 f16x2v __attribute__((ext_vector_type(2)));
__device__ __forceinline__ void wave_total63x2(float& a, float& b) {
    a += dpp_f<0x111, 0xf, true>(a); b += dpp_f<0x111, 0xf, true>(b); a += dpp_f<0x112, 0xf, true>(a); b += dpp_f<0x112, 0xf, true>(b);
    a += dpp_f<0x114, 0xf, true>(a); b += dpp_f<0x114, 0xf, true>(b); a += dpp_f<0x118, 0xf, true>(a); b += dpp_f<0x118, 0xf, true>(b);
    a += dpp_f<0x142, 0xa, false>(a); b += dpp_f<0x142, 0xa, false>(b); a += dpp_f<0x143, 0xc, false>(a); b += dpp_f<0x143, 0xc, false>(b);
}
template <bool UP> __device__ __forceinline__ void p5_sweep(const SweepLds& L, const unsigned char* tab, unsigned (&hp)[4][16], const v8i (&hq)[4], const float (&hinv)[4], int lenv0, int lenv1, int lane) {
    const LAS int* cbits = (const LAS int*)L.fcf;
    int pslot = 0, cslot = 2 * ROWB, idx = 0;
    for (int i = 0; i < P5_R; ++i) { const int id = P5_FEID(i); P5_ISSUE(tab, id); }
    int nv0 = L.feid[P5_R], nv1 = L.feid[P5_R + 1];
    asm volatile("s_waitcnt vmcnt(14)" ::: "memory");
    v8i ra = {0, 0, 0, 0, 0, 0, 0, 0}, rb = {0, 0, 0, 0, 0, 0, 0, 0}; P5_ROWREAD(ra, 0); P5_ROWREAD(rb, ROWB);
    const bool dg0 = (lane & 3) == 0, dg1 = (lane & 3) == 1, dg2 = (lane & 3) == 2, dgv = ((lane & 15) >> 2) == (lane >> 4);
    int cav = 0, cbv = 0; if (UP) { cav = cbits[0]; cbv = cbits[1]; }
    for (int s = 0; s < P5_NSL; ++s) {
        const int lenv = s < 16 ? lenv0 : lenv1;
#pragma unroll
        for (int tok = 0; tok < 4; ++tok) {
            const int n = __builtin_amdgcn_readlane(lenv, (s & 15) * 4 + tok);
            int i = 0;
            for (; i + 1 < n; i += 2) {
                f16x32 xa, xb; f32x4 ma, mb;
                if (UP) { xa = __builtin_amdgcn_cvt_scalef32_pk32_f16_fp6(P5_V6(ra), 1.0f); xb = __builtin_amdgcn_cvt_scalef32_pk32_f16_fp6(P5_V6(rb), 1.0f); }
                else { const f32x4 z = {0.f, 0.f, 0.f, 0.f};
                    ma = __builtin_amdgcn_mfma_scale_f32_16x16x128_f8f6f4(ra, hq[tok], z, 2  , 2  , 0, 0, 0, 0);
                    mb = __builtin_amdgcn_mfma_scale_f32_16x16x128_f8f6f4(rb, hq[tok], z, 2, 2, 0, 0, 0, 0); }
                const f16x2v ca = __builtin_bit_cast(f16x2v, __builtin_amdgcn_readfirstlane(cav)), cb = __builtin_bit_cast(f16x2v, __builtin_amdgcn_readfirstlane(cbv));
                { const int id0 = __builtin_amdgcn_readfirstlane(nv0), id1 = __builtin_amdgcn_readfirstlane(nv1); P5_ISSUE(tab, id0); P5_ISSUE(tab, id1); }
                nv0 = L.feid[idx + 2 + P5_R]; nv1 = L.feid[idx + 3 + P5_R];
                if (UP) { cav = cbits[idx + 2]; cbv = cbits[idx + 3]; }
                asm volatile("s_waitcnt vmcnt(14)" ::: "memory");
                const int cs1 = P5_WRAP(cslot);
                P5_ROWREAD(ra, cslot); P5_ROWREAD(rb, cs1);
                cslot = P5_WRAP(cs1);
                __builtin_amdgcn_sched_barrier(0);
                if (!UP) {
                    float a0 = ma[0], a1 = ma[1], a2 = ma[2], a3 = ma[3], b0 = mb[0], b1 = mb[1], b2 = mb[2], b3 = mb[3];
                    asm volatile("" : "+v"(a0), "+v"(a1), "+v"(a2), "+v"(a3), "+v"(b0), "+v"(b1), "+v"(b2), "+v"(b3));
                    float ta = dg0 ? a0 : dg1 ? a1 : dg2 ? a2 : a3, tb = dg0 ? b0 : dg1 ? b1 : dg2 ? b2 : b3;
                    ta = dgv ? ta : 0.f; tb = dgv ? tb : 0.f; wave_total63x2(ta, tb);
                    L.raw[idx] = __builtin_bit_cast(float, __builtin_amdgcn_readlane(__builtin_bit_cast(int, ta), 63)) * hinv[tok];
                    L.raw[idx + 1] = __builtin_bit_cast(float, __builtin_amdgcn_readlane(__builtin_bit_cast(int, tb), 63)) * hinv[tok];
                } else {
#pragma unroll
                    for (int k = 0; k < 16; ++k) hp[tok][k] = __builtin_bit_cast(unsigned, __builtin_elementwise_fma((f16x2v){xa[2 * k], xa[2 * k + 1]}, ca, __builtin_bit_cast(f16x2v, hp[tok][k])));
                    __builtin_amdgcn_sched_barrier(0);
#pragma unroll
                    for (int k = 0; k < 16; ++k) hp[tok][k] = __builtin_bit_cast(unsigned, __builtin_elementwise_fma((f16x2v){xb[2 * k], xb[2 * k + 1]}, cb, __builtin_bit_cast(f16x2v, hp[tok][k])));
                }
                idx += 2;
            }
            if (i < n) {
                f16x32 xa; f32x4 ma;
                if (UP) xa = __builtin_amdgcn_cvt_scalef32_pk32_f16_fp6(P5_V6(ra), 1.0f);
                else { const f32x4 z = {0.f, 0.f, 0.f, 0.f}; ma = __builtin_amdgcn_mfma_scale_f32_16x16x128_f8f6f4(ra, hq[tok], z, 2, 2, 0, 0, 0, 0); }
                const f16x2v ca = __builtin_bit_cast(f16x2v, __builtin_amdgcn_readfirstlane(cav));
                ra = rb; cav = cbv;
                { const int id0 = __builtin_amdgcn_readfirstlane(nv0); P5_ISSUE(tab, id0); }
                nv0 = nv1; nv1 = L.feid[idx + 2 + P5_R];
                if (UP) cbv = cbits[idx + 2];
                asm volatile("s_waitcnt vmcnt(14)" ::: "memory");
                P5_ROWREAD(rb, cslot);
                cslot = P5_WRAP(cslot);
                __builtin_amdgcn_sched_barrier(0);
                if (!UP) {
                    float a0 = ma[0], a1 = ma[1], a2 = ma[2], a3 = ma[3];
                    asm volatile("" : "+v"(a0), "+v"(a1), "+v"(a2), "+v"(a3));
                    float ta = dg0 ? a0 : dg1 ? a1 : dg2 ? a2 : a3; ta = wave_total63(dgv ? ta : 0.f);
                    L.raw[idx] = __builtin_bit_cast(float, __builtin_amdgcn_readlane(__builtin_bit_cast(int, ta), 63)) * hinv[tok];
                } else {
#pragma unroll
                    for (int k = 0; k < 16; ++k) hp[tok][k] = __builtin_bit_cast(unsigned, __builtin_elementwise_fma((f16x2v){xa[2 * k], xa[2 * k + 1]}, ca, __builtin_bit_cast(f16x2v, hp[tok][k])));
                }
                idx += 1;
            }
        }
    }
    asm volatile("s_waitcnt vmcnt(0)" ::: "memory");
}
__device__ __forceinline__ void p5_wave(LAS unsigned char* wl, const float* SC, const bf16* X1, const unsigned char* ED, const unsigned char* EU, const float* SD, const float* SU,
                                        const float* gf, float* out, int t0, int lane, const float* g2) {
    SweepLds L; L.ring = wl; L.feid = (LAS int*)(wl + 14336 - 64);     L.fcf = (LAS float*)(wl + 14336 + 2048); L.raw = (LAS float*)(wl + 14336 + 4096);
    { LAS int* ctab = (LAS int*)(wl + 14336); ctab[lane] = cand_pair(lane); }
    unsigned hp[4][16]; float rsv[4]; v8i hq[4]; float hinv[4];
    {   f32x4 gl[8];
        int ls = lane; asm volatile("" : "+v"(ls));
#pragma unroll
        for (int i = 0; i < 8; ++i) gl[i] = *(const f32x4*)(g2 + i * 256 + ls * 4);
        v2u xq[4][8];
#pragma unroll
        for (int tk = 0; tk < 4; ++tk)
#pragma unroll
            for (int i = 0; i < 8; ++i) xq[tk][i] = *(const v2u*)(X1 + (size_t)(t0 + 8 * tk) * D + i * 256 + ls * 4);
#pragma unroll
        for (int tk = 0; tk < 4; ++tk) { float ss = 0.f;
#pragma unroll
            for (int i = 0; i < 8; ++i)
#pragma unroll
                for (int e = 0; e < 2; ++e) { const float a = bflo(xq[tk][i][e]), b = bfhi(xq[tk][i][e]); ss += a * a + b * b; }
            const float rs = __builtin_amdgcn_rsqf(wave_sum(ss) * (1.f / D) + EPS); rsv[tk] = rs;
            float hx[32]; float mx = 0.f;
#pragma unroll
            for (int i = 0; i < 8; ++i)
#pragma unroll
                for (int e = 0; e < 2; ++e) {
                    hx[4 * i + 2 * e] = bflo(xq[tk][i][e]) * rs * gl[i][2 * e]; hx[4 * i + 2 * e + 1] = bfhi(xq[tk][i][e]) * rs * gl[i][2 * e + 1];
                    mx = fmaxf(mx, fmaxf(fabsf(hx[4 * i + 2 * e]), fabsf(hx[4 * i + 2 * e + 1]))); }
#pragma unroll
            for (int o = 1; o < 64; o <<= 1) mx = fmaxf(mx, __shfl_xor(mx, o));
            const float hs = mx > 0.f ? 7.f / mx : 0.f; hinv[tk] = mx * (1.f / 7.f);
            bf16x32 hb;
#pragma unroll
            for (int k = 0; k < 32; ++k) hb[k] = (__bf16)(hx[k] * hs);
            const v6u pk = __builtin_amdgcn_cvt_scalef32_pk32_fp6_bf16(hb, 1.0f);
            hq[tk] = (v8i){(int)pk[0], (int)pk[1], (int)pk[2], (int)pk[3], (int)pk[4], (int)pk[5], 0, 0};
        }
    }
    LDS_WAIT(); __builtin_amdgcn_wave_barrier();
    for (int rep_ = 0; rep_ < REP_TOPK; ++rep_)
    for (int tk = 0; tk < 4; ++tk) {
        if (tk == 0) { WaveLds W0; W0.sv = (LAS float*)(wl + 4096); p5_topk_fetch(W0, SC + (size_t)t0 * 2048, 0, lane); }
        WaveLds W; W.eid = (LAS int*)(wl + 1024 * tk); W.gate = (LAS float*)(wl + 1024 * tk + 512);
        W.sv = (LAS float*)(wl + 4096); W.tv = (LAS float*)(wl + 12288); W.ti = (LAS int*)(wl + 13312); W.ctab = (LAS int*)(wl + 14336);
        p5_topk_token(W, SC + (size_t)(t0 + 8 * tk) * 2048, tk < 3 ? SC + (size_t)(t0 + 8 * tk + 8) * 2048 : nullptr, rsv[tk], lane);
    }
    int lenv0 = 0, lenv1 = 0;
#pragma unroll
    for (int tk = 0; tk < 4; ++tk) {
        const LAS int* ue = (const LAS int*)(wl + 1024 * tk); const int sl0 = ue[lane] >> P5_SLSH, sl1 = ue[lane + 64] >> P5_SLSH;
        for (int k = 0; k < P5_NSL; ++k) { const int c = __popcll(__ballot(sl0 == k)) + __popcll(__ballot(sl1 == k));
            if (lane == (k & 15) * 4 + tk) { if (k < 16) lenv0 = c; else lenv1 = c; } }
    }
    const int incl0 = wave_incl_scan(lenv0), tot0 = __builtin_amdgcn_readlane(incl0, 63);
    const int base0 = incl0 - lenv0, base1 = wave_incl_scan(lenv1) - lenv1 + tot0;
#pragma unroll
    for (int tk = 0; tk < 4; ++tk) {
        const LAS int* ue = (const LAS int*)(wl + 1024 * tk); const LAS float* ug = (const LAS float*)(wl + 1024 * tk + 512);
        const int e0 = ue[lane], e1 = ue[lane + 64], sl0 = e0 >> P5_SLSH, sl1 = e1 >> P5_SLSH; const float g0 = ug[lane], g1 = ug[lane + 64];
        int r0 = 0, r1 = 0;
        for (int k = 0; k < P5_NSL; ++k) { const unsigned long long m0 = __ballot(sl0 == k), m1 = __ballot(sl1 == k);
            if (sl0 == k) r0 = mbcnt64(m0);
            if (sl1 == k) r1 = __popcll(m0) + mbcnt64(m1); }
        const int b00 = __shfl(base0, (sl0 & 15) * 4 + tk), b01 = __shfl(base1, (sl0 & 15) * 4 + tk), b10 = __shfl(base0, (sl1 & 15) * 4 + tk), b11 = __shfl(base1, (sl1 & 15) * 4 + tk);
        const int p0 = (sl0 < 16 ? b00 : b01) + r0, p1 = (sl1 < 16 ? b10 : b11) + r1;
        L.feid[p0] = e0; L.fcf[p0] = g0; L.feid[p1] = e1; L.fcf[p1] = g1;
    }
    if (lane < 16) L.feid[512 + lane] = 0;
    LDS_WAIT(); __builtin_amdgcn_wave_barrier();
    for (int rep_ = 0; rep_ < REP_DS; ++rep_) p5_sweep<false>(L, ED, hp, hq, hinv, lenv0, lenv1, lane);
    LDS_WAIT(); __builtin_amdgcn_wave_barrier();
    float cmax = 0.f;
    {   float sdv[8], suv[8], cv[8];
#pragma unroll
        for (int k = 0; k < 8; ++k) { const int id = L.feid[lane + 64 * k]; sdv[k] = SD[id]; suv[k] = SU[id]; }
#pragma unroll
        for (int k = 0; k < 8; ++k) { const int i = lane + 64 * k; cv[k] = gelu_erf(L.raw[i] * sdv[k]) * L.fcf[i] * suv[k]; cmax = fmaxf(cmax, fabsf(cv[k])); }
#pragma unroll
        for (int o = 1; o < 64; o <<= 1) cmax = fmaxf(cmax, __shfl_xor(cmax, o));
        const float cinv = cmax > 0.f ? 1.f / cmax : 0.f;
#pragma unroll
        for (int k = 0; k < 8; ++k) { const _Float16 h = (_Float16)(cv[k] * cinv); ((LAS unsigned*)L.fcf)[lane + 64 * k] = __builtin_bit_cast(unsigned, (f16x2v){h, h}); }
    }
    LDS_WAIT(); __builtin_amdgcn_wave_barrier();
    asm volatile("s_waitcnt vmcnt(0)" ::: "memory");
#pragma unroll
    for (int tk = 0; tk < 4; ++tk)
#pragma unroll
        for (int q = 0; q < 16; ++q) hp[tk][q] = 0u;
    p5_sweep<true>(L, EU, hp, hq, hinv, lenv0, lenv1, lane);
    int le = lane; asm volatile("" : "+v"(le));
#pragma unroll
    for (int tk = 0; tk < 4; ++tk) {
        const size_t ro = (size_t)(t0 + 8 * tk) * D; float ss = 0.f; float st[32];
#pragma unroll
        for (int i = 0; i < 8; ++i) { const v2u xa = __builtin_nontemporal_load((const v2u*)(X1 + ro + i * 256 + le * 4));
#pragma unroll
            for (int c = 0; c < 2; ++c) { const int k = 4 * i + 2 * c; const f16x2v a = __builtin_bit_cast(f16x2v, hp[tk][k >> 1]);
                st[k] = (float)a.x * cmax + bflo(xa[c]); st[k + 1] = (float)a.y * cmax + bfhi(xa[c]); ss += st[k] * st[k] + st[k + 1] * st[k + 1]; } }
        const float r = rsqrtf(wave_sum(ss) * (1.f / D) + EPS);
#pragma unroll
        for (int i = 0; i < 8; ++i) { const f32x4 g = *(const f32x4*)(gf + i * 256 + le * 4); f32x4 a;
#pragma unroll
            for (int c = 0; c < 4; ++c) a[c] = st[4 * i + c] * r * g[c];
            __builtin_nontemporal_store(a, (f32x4*)(out + ro + i * 256 + le * 4)); }
    }
}
__device__ __forceinline__ void p5_peer(const Ctx& F, const float* SC, const bf16* X1, const unsigned char* ED, const unsigned char* EU, const float* SD, const float* SU, const float* gf, float* out, const float* g2) {
    for (int tile = F.bid; tile < T / P5_TOK; tile += F.G)
        p5_wave(F.lds + F.wave * P5_WL2, SC, X1, ED, EU, SD, SU, gf, out, tile * P5_TOK + F.wave, F.lane, g2);
}

struct Args { const float* in[15]; float* out; unsigned char* ws; };
__global__ void __launch_bounds__(NTHR, 2) mega_fwd(Args args) {
    extern __shared__ __attribute__((aligned(16))) unsigned char lds_raw[];
    Ctx F; F.lds = (LAS unsigned char*)lds_raw; F.tid = threadIdx.x; F.lane = F.tid & 63; F.wave = __builtin_amdgcn_readfirstlane(F.tid >> 6); F.G = gridDim.x; F.bid = blockIdx.x;
    volatile LAS unsigned* MISC = (volatile LAS unsigned*)(F.lds + MISC_OFF);
    unsigned char* ws = args.ws; unsigned* ctl = (unsigned*)(ws + WS_CTL);
    const float* x = args.in[0]; const float* norm1_g = args.in[1]; const float* w_in = args.in[2]; const float* sgu_ln_g = args.in[3]; const float* sgu_ln_b = args.in[4];
    const float* w_spatial = args.in[5]; const float* b_spatial = args.in[6]; const float* attn_sinks = args.in[7]; const float* w_out = args.in[8]; const float* norm2_g = args.in[9];
    const float* w_query = args.in[10]; const float* sub_keys = args.in[11]; const float* expert_down = args.in[12]; const float* expert_up = args.in[13]; const float* norm_f_g = args.in[14];
    bf16* WinT = (bf16*)(ws + WS_WIN); bf16* WoutT = (bf16*)(ws + WS_WOUT); bf16* WeffT = (bf16*)(ws + WS_WEFF); bf16* H = (bf16*)(ws + WS_H);
    bf16* Z = (bf16*)(ws + WS_Z); bf16* MIX = (bf16*)(ws + WS_MIX); bf16* X1 = (bf16*)(ws + WS_X1); float* SC = (float*)(ws + WS_SC);
    unsigned char* ED = ws + WS_ED; unsigned char* EU = ws + WS_EU; float* SD = (float*)(ws + WS_SD); float* SU = (float*)(ws + WS_SU);
    for (int u = F.tid; u < (LDS_BYTES - LDSCTL_OFF) / 4; u += NTHR) ((LAS unsigned*)(F.lds + LDSCTL_OFF))[u] = 0u;
    __syncthreads();
    XcdBarrier bar = xcd_barrier_post(ctl + CW_BAR, MISC + 8);
#ifdef TP_PHASE
    volatile unsigned long long* tsp = (volatile unsigned long long*)(ws + WS_TP);
#define TP_BEGIN(k) do { if ((k) == TP_PHASE && F.bid == 0 && F.tid == 0) tsp[0] = wall_clock64(); } while (0)
#define TP_END(k) do { if ((k) == TP_PHASE && F.bid == 0 && F.tid == 0) tsp[1] = wall_clock64() - tsp[0]; } while (0)
#else
#define TP_BEGIN(k) do { } while (0)
#define TP_END(k) do { } while (0)
#endif
    TP_BEGIN(0);

    for (int rep = 0; rep < REP_P0; ++rep) p0_prologue(F, x, norm1_g, w_in, w_out, w_query, sub_keys, expert_down, expert_up, WinT, WoutT, WeffT, H, ED, EU, SD, SU, norm2_g);
    xcd_barrier(bar); TP_END(0); TP_BEGIN(1);
#if defined(TP_PHASE) && TP_PHASE == 11
    if (F.bid == F.G - 1 && F.tid == 0) tsp[0] = wall_clock64();
#endif
    for (int rep_ = 0; rep_ < REP_P1; ++rep_)
    {   pg8::Gemm g{H, WinT, T, NIN, D}; pg8::StaticOrder S; S.init(T, NIN, F.G, F.bid);
        pg8::EpiZ E{Z, NIN, 8};
        pg8::gemm_phase<pg8::EpiZ, pg8::StaticOrder, true, true>(F.lds + RING_OFF, g, S, E); }
    {
        const int nU = (T / 256) * (NIN / 256), maxu = (nU + F.G - 1) / F.G, nfull = nU - (maxu - 1) * F.G;
        const bool all = nfull == F.G; const int nidle = all ? F.G : F.G - nfull, q = all ? F.bid : F.bid - nfull;
        if (q >= 0) convert_rows(expert_down, expert_up, ED, EU, SD, SU, CONV_SPLIT, 2 * NE, q * NWAVES + F.wave, nidle * NWAVES, F.lane);
#if defined(TP_PHASE) && TP_PHASE == 11
        __syncthreads(); if (F.bid == F.G - 1 && F.tid == 0) tsp[1] = wall_clock64() - tsp[0];
#endif
    }
    xcd_barrier(bar); TP_END(1); TP_BEGIN(2);
    for (int rep = 0; rep < REP_P2; ++rep) { p2_sgu(F, Z, sgu_ln_g, sgu_ln_b, w_spatial, b_spatial, MIX); p2_attn(F, Z, attn_sinks, MIX); }
    {   pg8::Gemm g{MIX, WoutT, T, D, D}; pg8::StaticOrder S; S.init(T, D, F.G, F.bid);
        pg8::EpiX1 E{x, X1, D};
        pg8::f32x4 acc[2][2][4][2]; pg8::Unit u0; const bool has0 = S.next(0, u0);
        const int wr_ = F.wave >> 2, wc_ = F.wave & 3, fr_ = F.lane & 15, fq_ = F.lane >> 4;
        xcd_barrier_pre(bar, [&]() { if (has0) E.init(acc, u0, wr_, wc_, fr_, fq_); }); TP_END(2); TP_BEGIN(3);
        pg8::gemm_phase_acc<pg8::EpiX1, pg8::StaticOrder, true, true, true>(F.lds + RING_OFF, g, S, E, acc); }
    xcd_barrier(bar); TP_END(3); TP_BEGIN(4);
    {   pg8::Gemm g{X1, WeffT, T, D, D}; pg8::StaticOrder S; S.init(T, D, F.G, F.bid);
        pg8::EpiF32<false> E{nullptr, SC, D};
        pg8::gemm_phase<pg8::EpiF32<false>, pg8::StaticOrder, true, true>(F.lds + RING_OFF, g, S, E); }
    xcd_barrier(bar); TP_END(4); TP_BEGIN(5);
    for (int rep = 0; rep < REP_P5; ++rep) p5_peer(F, SC, X1, ED, EU, SD, SU, norm_f_g, args.out, norm2_g);
#ifdef TP_PHASE
    xcd_barrier(bar); TP_END(5);
    if (F.bid == 0 && F.tid == 0) { const unsigned long long t0 = wall_clock64(), w = (unsigned long long)TP_W * tsp[1]; while (wall_clock64() - t0 < w) __builtin_amdgcn_s_sleep(16); }
#endif
}

extern "C" void kernel_launch(void* const* d_in, const int* in_sizes, int n_in, void* d_out, int out_size, void* d_ws, size_t ws_size, hipStream_t stream) {
    static int grid = 0;
    if (grid == 0) {
        if (n_in != 15 || ws_size < WS_END) { fprintf(stderr, "kernel_launch: unexpected inputs / workspace\n"); grid = -1; return; }
        int dev = 0, cus = 0, per_cu = 0;
        if (hipGetDevice(&dev) != hipSuccess || hipDeviceGetAttribute(&cus, hipDeviceAttributeMultiprocessorCount, dev) != hipSuccess) { grid = -1; return; }
        if (hipFuncSetAttribute((const void*)mega_fwd, hipFuncAttributeMaxDynamicSharedMemorySize, LDS_BYTES) != hipSuccess) { fprintf(stderr, "kernel_launch: hipFuncSetAttribute failed\n"); grid = -1; return; }
        if (hipOccupancyMaxActiveBlocksPerMultiprocessor(&per_cu, (const void*)mega_fwd, NTHR, LDS_BYTES) != hipSuccess || per_cu < 1)
            fprintf(stderr, "kernel_launch: note: occupancy query reports %d workgroups per CU\n", per_cu);
        (void)hipGetLastError();
        grid = cus;
    }
    if (grid < 0) return;
    if (hipMemsetAsync((char*)d_ws + WS_CTL, 0, CTL_ZERO_BYTES, stream) != hipSuccess) return;
    Args a{};
    for (int i = 0; i < 15; ++i) a.in[i] = (const float*)d_in[i];
    a.out = (float*)d_out; a.ws = (unsigned char*)d_ws;
    hipLaunchKernelGGL(mega_fwd, dim3(grid), dim3(NTHR), LDS_BYTES, stream, a);
}
```
